# Optimizing an MI355X kernel written in HIP

```python
import math
import jax, jax.numpy as jnp
from jax import lax
import numpy as np

D_MODEL = 1024
BATCH = 32
SEQ = 2048
DEPTH = 1

MEM_LEN = 256
DIFF_HEADS = 4
DIFF_HEAD_DIM = 64
DIFF_WIDTH = DIFF_HEADS * 2 * DIFF_HEAD_DIM
MOBA_HEADS = 8
MOBA_HEAD_DIM = 64
MOBA_WIDTH = MOBA_HEADS * MOBA_HEAD_DIM
MIX_WIDTH = DIFF_WIDTH + MOBA_WIDTH
MOBA_BLOCK = 256
MOBA_TOPK = 3
Q_BLOCK = 128
ROPE_THETA = 500000.0
ROT_DIM = 64 // 4
MEM_HEADS = 4
MEM_HEAD_DIM = D_MODEL // MEM_HEADS
N_EXPERTS = 32
TOP_K = 4
D_FF = D_MODEL
SWIGLU_ALPHA = 1.702
SWIGLU_LIMIT = 7.0
LN_EPS = 1e-5
RMS_EPS = 1e-5
DEEPNORM_ALPHA = (2.0 * DEPTH) ** 0.25
DEEPNORM_BETA = (8.0 * DEPTH) ** -0.25

kernel_name = "hybrid_diffattn_moba_memxattn_moe_deepnorm"


def layer_norm(x, g, b):
    xf = x.astype(jnp.float32)
    mu = jnp.mean(xf, axis=-1, keepdims=True)
    var = jnp.mean(jnp.square(xf - mu), axis=-1, keepdims=True)
    return ((xf - mu) * lax.rsqrt(var + LN_EPS) * g + b).astype(x.dtype)


def rms_norm(x, g):
    xf = x.astype(jnp.float32)
    return (xf * lax.rsqrt(jnp.mean(xf * xf, axis=-1, keepdims=True) + RMS_EPS) * g).astype(x.dtype)


def rope_tables(seq):
    inv_freq = ROPE_THETA ** (-jnp.arange(0, ROT_DIM, 2, dtype=jnp.float32) / ROT_DIM)
    ang = jnp.arange(seq, dtype=jnp.float32)[:, None] * inv_freq[None, :]
    return jnp.cos(ang), jnp.sin(ang)


def apply_partial_rope(x, cos, sin):
    half = cos.shape[-1]
    bshape = (cos.shape[0],) + (1,) * (x.ndim - 3) + (half,)
    c = cos.reshape(bshape).astype(x.dtype)
    s = sin.reshape(bshape).astype(x.dtype)
    x1, x2, rest = x[..., :half], x[..., half:2 * half], x[..., 2 * half:]
    return jnp.concatenate([x1 * c - x2 * s, x2 * c + x1 * s, rest], axis=-1)


def differential_attention(q, k, v, lam, lambda_init, subln_g):
    B, S = q.shape[0], q.shape[1]
    nqb = S // Q_BLOCK
    scale = DIFF_HEAD_DIM ** -0.5
    q_blocks = q.reshape(B, nqb, Q_BLOCK, DIFF_HEADS, 2, DIFF_HEAD_DIM).swapaxes(0, 1)
    kpos = jnp.arange(S)

    def one_block(args):
        qi, i = args
        qpos = i * Q_BLOCK + jnp.arange(Q_BLOCK)
        s = jnp.einsum('bqhcd,bkhcd->bhcqk', qi, k).astype(jnp.float32) * scale
        s = jnp.where(kpos[None, :] <= qpos[:, None], s, -jnp.inf)
        p = jax.nn.softmax(s, axis=-1)
        a = p[:, :, 0] - lam * p[:, :, 1]
        return jnp.einsum('bhqk,bkhe->bqhe', a.astype(v.dtype), v)

    o = lax.map(one_block, (q_blocks, jnp.arange(nqb)))
    o = o.swapaxes(0, 1).reshape(B, S, DIFF_HEADS, 2 * DIFF_HEAD_DIM)
    o = rms_norm(o, subln_g) * (1.0 - lambda_init)
    return o.reshape(B, S, DIFF_WIDTH)


def moba_attention(q, k, v):
    B, S, H, d = q.shape
    scale = d ** -0.5
    s_pad = -(-S // MOBA_BLOCK) * MOBA_BLOCK
    nb = s_pad // MOBA_BLOCK
    n_sel = min(MOBA_TOPK, nb)
    pad = ((0, 0), (0, s_pad - S), (0, 0), (0, 0))
    kb = jnp.pad(k, pad).reshape(B, nb, MOBA_BLOCK, H, d).transpose(0, 3, 1, 2, 4)
    vb = jnp.pad(v, pad).reshape(B, nb, MOBA_BLOCK, H, d).transpose(0, 3, 1, 2, 4)
    k_mean = jnp.mean(kb.astype(jnp.float32), axis=3)
    qh = q.transpose(0, 2, 1, 3)
    gate = jnp.einsum('bhsd,bhnd->bhsn', qh.astype(jnp.float32), k_mean)
    fully_past = jnp.arange(nb)[None, :] < (jnp.arange(S) // MOBA_BLOCK)[:, None]
    gate = jnp.where(fully_past, gate, -jnp.inf)
    _, sel = lax.top_k(gate, n_sel)
    n_chunks = S // Q_BLOCK

    def per_batch(args):
        q_b, kb_b, vb_b, sel_b = args

        def per_chunk(c):
            q0 = c * Q_BLOCK
            qc = lax.dynamic_slice_in_dim(q_b, q0, Q_BLOCK, axis=1)
            sc = lax.dynamic_slice_in_dim(sel_b, q0, Q_BLOCK, axis=1)
            qpos = q0 + jnp.arange(Q_BLOCK)
            own_blk = q0 // MOBA_BLOCK
            k_sel = jax.vmap(lambda kbh, sh: kbh[sh])(kb_b, sc)
            v_sel = jax.vmap(lambda vbh, sh: vbh[sh])(vb_b, sc)
            s_sel = jnp.einsum('hqd,hqnld->hqnl', qc, k_sel).astype(jnp.float32) * scale
            slot_valid = jnp.arange(n_sel) < own_blk
            s_sel = jnp.where(slot_valid[None, None, :, None], s_sel, -jnp.inf)
            k_own = lax.dynamic_index_in_dim(kb_b, own_blk, axis=1, keepdims=False)
            v_own = lax.dynamic_index_in_dim(vb_b, own_blk, axis=1, keepdims=False)
            s_own = jnp.einsum('hqd,hld->hql', qc, k_own).astype(jnp.float32) * scale
            kpos_own = own_blk * MOBA_BLOCK + jnp.arange(MOBA_BLOCK)
            s_own = jnp.where(kpos_own[None, None, :] <= qpos[None, :, None], s_own, -jnp.inf)
            s_all = jnp.concatenate([s_sel.reshape(H, Q_BLOCK, n_sel * MOBA_BLOCK), s_own], axis=-1)
            p = jax.nn.softmax(s_all, axis=-1).astype(v_b_dtype)
            p_sel = p[..., :n_sel * MOBA_BLOCK].reshape(H, Q_BLOCK, n_sel, MOBA_BLOCK)
            p_own = p[..., n_sel * MOBA_BLOCK:]
            return (jnp.einsum('hqnl,hqnld->hqd', p_sel, v_sel)
                    + jnp.einsum('hql,hld->hqd', p_own, v_own))

        o = lax.map(per_chunk, jnp.arange(n_chunks))
        return o.transpose(1, 0, 2, 3).reshape(H, S, d)

    v_b_dtype = v.dtype
    o = lax.map(per_batch, (qh, kb, vb, sel))
    return o.transpose(0, 2, 1, 3).reshape(B, S, MOBA_WIDTH)


def hybrid_mixer(h, w_in, lq1, lk1, lq2, lk2, subln_g, w_out, lambda_init, cos, sin):
    B, S, _ = h.shape
    proj = h @ w_in
    cuts = [DIFF_WIDTH, 2 * DIFF_WIDTH, 3 * DIFF_WIDTH,
            3 * DIFF_WIDTH + MOBA_WIDTH, 3 * DIFF_WIDTH + 2 * MOBA_WIDTH]
    dq, dk, dv, mq, mk, mv = jnp.split(proj, cuts, axis=-1)
    dq = apply_partial_rope(dq.reshape(B, S, DIFF_HEADS, 2, DIFF_HEAD_DIM), cos, sin)
    dk = apply_partial_rope(dk.reshape(B, S, DIFF_HEADS, 2, DIFF_HEAD_DIM), cos, sin)
    dv = dv.reshape(B, S, DIFF_HEADS, 2 * DIFF_HEAD_DIM)
    lam = (jnp.exp(jnp.sum(lq1.astype(jnp.float32) * lk1.astype(jnp.float32)))
           - jnp.exp(jnp.sum(lq2.astype(jnp.float32) * lk2.astype(jnp.float32))) + lambda_init)
    out_a = differential_attention(dq, dk, dv, lam, lambda_init, subln_g)
    mq = apply_partial_rope(mq.reshape(B, S, MOBA_HEADS, MOBA_HEAD_DIM), cos, sin)
    mk = apply_partial_rope(mk.reshape(B, S, MOBA_HEADS, MOBA_HEAD_DIM), cos, sin)
    mv = mv.reshape(B, S, MOBA_HEADS, MOBA_HEAD_DIM)
    out_b = moba_attention(mq, mk, mv)
    return jnp.concatenate([out_a, out_b], axis=-1) @ w_out


def memory_cross_attention(h, mem_n, w_q, w_kv, w_o):
    B, S, D = h.shape
    M = mem_n.shape[1]
    q = (h @ w_q).reshape(B, S, MEM_HEADS, MEM_HEAD_DIM)
    k, v = jnp.split(mem_n @ w_kv, 2, axis=-1)
    k = k.reshape(B, M, MEM_HEADS, MEM_HEAD_DIM)
    v = v.reshape(B, M, MEM_HEADS, MEM_HEAD_DIM)
    s = jnp.einsum('bshd,bmhd->bhsm', q, k).astype(jnp.float32) * (MEM_HEAD_DIM ** -0.5)
    p = jax.nn.softmax(s, axis=-1).astype(v.dtype)
    o = jnp.einsum('bhsm,bmhd->bshd', p, v).reshape(B, S, D)
    return o @ w_o


def clamped_swiglu(hidden):
    glu, lin = hidden[..., ::2], hidden[..., 1::2]
    glu = jnp.minimum(glu, SWIGLU_LIMIT)
    lin = jnp.clip(lin, -SWIGLU_LIMIT, SWIGLU_LIMIT)
    return glu * jax.nn.sigmoid(SWIGLU_ALPHA * glu) * (lin + 1.0)


def moe_ffn(h, w_router, b_router, w_mlp1, b_mlp1, w_mlp2, b_mlp2):
    B, S, D = h.shape
    xt = h.reshape(B * S, D)
    logits = (xt @ w_router + b_router).astype(jnp.float32)
    top_val, top_idx = lax.top_k(logits, TOP_K)
    top_w = jax.nn.softmax(top_val, axis=-1)
    combine = jnp.einsum('tk,tke->te', top_w,
                         jax.nn.one_hot(top_idx, N_EXPERTS, dtype=jnp.float32)).astype(h.dtype)
    y = jnp.zeros_like(xt)
    for e in range(N_EXPERTS):
        hid = clamped_swiglu(xt @ w_mlp1[e] + b_mlp1[e])
        y = y + combine[:, e:e + 1] * (hid @ w_mlp2[e] + b_mlp2[e])
    return y.reshape(B, S, D)


def setup_inputs(seed: int = 0) -> dict:
    key = jax.random.key(seed)
    ks = jax.random.split(key, 30)
    f32 = jnp.float32
    L, D = DEPTH, D_MODEL

    def nrm(k, shape, scale):
        return jax.random.normal(k, shape, f32) * scale

    x = nrm(ks[0], (BATCH, SEQ, D), 1.0)
    mem = nrm(ks[1], (BATCH, MEM_LEN, D), 1.0)
    w_in = jnp.concatenate([
        nrm(ks[2], (L, D, 2 * DIFF_WIDTH), D ** -0.5),
        nrm(ks[3], (L, D, DIFF_WIDTH), D ** -0.5 * DEEPNORM_BETA),
        nrm(ks[4], (L, D, 2 * MOBA_WIDTH), D ** -0.5),
        nrm(ks[5], (L, D, MOBA_WIDTH), D ** -0.5 * DEEPNORM_BETA)], axis=-1)
    diff_lambda_q1 = nrm(ks[6], (L, DIFF_HEAD_DIM), 0.1)
    diff_lambda_k1 = nrm(ks[7], (L, DIFF_HEAD_DIM), 0.1)
    diff_lambda_q2 = nrm(ks[8], (L, DIFF_HEAD_DIM), 0.1)
    diff_lambda_k2 = nrm(ks[9], (L, DIFF_HEAD_DIM), 0.1)
    diff_subln_g = 1.0 + nrm(ks[10], (L, 2 * DIFF_HEAD_DIM), 0.05)
    w_mix_out = nrm(ks[11], (L, MIX_WIDTH, D), MIX_WIDTH ** -0.5 * DEEPNORM_BETA)
    ln1_g = 1.0 + nrm(ks[12], (L, D), 0.05)
    ln1_b = nrm(ks[13], (L, D), 0.02)
    mem_ln_g = 1.0 + nrm(ks[14], (D,), 0.05)
    mem_ln_b = nrm(ks[15], (D,), 0.02)
    w_mem_q = nrm(ks[16], (L, D, D), D ** -0.5)
    w_mem_kv = jnp.concatenate([nrm(ks[17], (L, D, D), D ** -0.5),
                                nrm(ks[18], (L, D, D), D ** -0.5 * DEEPNORM_BETA)], axis=-1)
    w_mem_o = nrm(ks[19], (L, D, D), D ** -0.5 * DEEPNORM_BETA)
    ln2_g = 1.0 + nrm(ks[20], (L, D), 0.05)
    ln2_b = nrm(ks[21], (L, D), 0.02)
    w_router = nrm(ks[22], (L, D, N_EXPERTS), D ** -0.5)
    b_router = nrm(ks[23], (L, N_EXPERTS), 0.01)
    w_mlp1 = nrm(ks[24], (L, N_EXPERTS, D, 2 * D_FF), D ** -0.5)
    b_mlp1 = nrm(ks[25], (L, N_EXPERTS, 2 * D_FF), 0.01)
    w_mlp2 = nrm(ks[26], (L, N_EXPERTS, D_FF, D), D_FF ** -0.5 * DEEPNORM_BETA)
    b_mlp2 = nrm(ks[27], (L, N_EXPERTS, D), 0.01)
    ln3_g = 1.0 + nrm(ks[28], (L, D), 0.05)
    ln3_b = nrm(ks[29], (L, D), 0.02)
    return {"x": x, "mem": mem, "w_in": w_in,
            "diff_lambda_q1": diff_lambda_q1, "diff_lambda_k1": diff_lambda_k1,
            "diff_lambda_q2": diff_lambda_q2, "diff_lambda_k2": diff_lambda_k2,
            "diff_subln_g": diff_subln_g, "w_mix_out": w_mix_out, "ln1_g": ln1_g, "ln1_b": ln1_b,
            "mem_ln_g": mem_ln_g, "mem_ln_b": mem_ln_b, "w_mem_q": w_mem_q, "w_mem_kv": w_mem_kv,
            "w_mem_o": w_mem_o, "ln2_g": ln2_g, "ln2_b": ln2_b, "w_router": w_router,
            "b_router": b_router, "w_mlp1": w_mlp1, "b_mlp1": b_mlp1, "w_mlp2": w_mlp2,
            "b_mlp2": b_mlp2, "ln3_g": ln3_g, "ln3_b": ln3_b}


def reference(x, mem, w_in, diff_lambda_q1, diff_lambda_k1, diff_lambda_q2, diff_lambda_k2,
              diff_subln_g, w_mix_out, ln1_g, ln1_b, mem_ln_g, mem_ln_b, w_mem_q, w_mem_kv,
              w_mem_o, ln2_g, ln2_b, w_router, b_router, w_mlp1, b_mlp1, w_mlp2, b_mlp2,
              ln3_g, ln3_b):
    S = x.shape[1]
    cos, sin = rope_tables(S)
    mem_n = layer_norm(mem, mem_ln_g, mem_ln_b)
    h = x
    for l in range(DEPTH):
        lambda_init = 0.8 - 0.6 * math.exp(-0.3 * l)
        mix = hybrid_mixer(h, w_in[l], diff_lambda_q1[l], diff_lambda_k1[l], diff_lambda_q2[l],
                           diff_lambda_k2[l], diff_subln_g[l], w_mix_out[l], lambda_init, cos, sin)
        h = layer_norm(DEEPNORM_ALPHA * h + mix, ln1_g[l], ln1_b[l])
        xatt = memory_cross_attention(h, mem_n, w_mem_q[l], w_mem_kv[l], w_mem_o[l])
        h = layer_norm(DEEPNORM_ALPHA * h + xatt, ln2_g[l], ln2_b[l])
        ffn = moe_ffn(h, w_router[l], b_router[l], w_mlp1[l], b_mlp1[l], w_mlp2[l], b_mlp2[l])
        h = layer_norm(DEEPNORM_ALPHA * h + ffn, ln3_g[l], ln3_b[l])
    return h
```

```cpp
#include <hip/hip_runtime.h>
#include <hip/hip_bf16.h>
#include <cmath>
#include <cstdio>
#include <cstdint>

#ifndef ONE_LAUNCH
#define ONE_LAUNCH 1
#endif

constexpr int BATCH = 32, SEQ = 2048, D = 1024, T = BATCH * SEQ;
constexpr int MEML = 256, TM = BATCH * MEML;
constexpr int NPROJ = 3072;
constexpr int NEXP = 32, TOPK = 4, DFF = 1024;
constexpr float ALPHA = 1.189207115002721f;
constexpr float LN_EPS = 1e-5f;
constexpr int NTHR = 512, NWAVES = 8;

#define GAS __attribute__((address_space(1)))
#define LAS __attribute__((address_space(3)))
typedef LAS float lfloat;
typedef float f32x4 __attribute__((ext_vector_type(4)));
#define WSYNC() asm volatile("s_waitcnt lgkmcnt(0)" ::: "memory")

constexpr size_t MiB = 1u << 20;
constexpr size_t WS_CTL = 0, CTL_ZERO_BYTES = 1 * MiB;
constexpr size_t WS_ROPE = 1 * MiB;
constexpr size_t WS_KMEAN = 2 * MiB;
constexpr size_t WS_LNZ = 10 * MiB, LNZ_BYTES = 2 * MiB;
constexpr float FXS = 16777216.0f, FXI = 1.0f / 16777216.0f;
__device__ __forceinline__ void fx_add(long long* p, float v) { atomicAdd((unsigned long long*)p, (unsigned long long)(long long)rintf(v * FXS)); }
__device__ __forceinline__ float fx_get(const long long* p) { return (float)(*p) * FXI; }
constexpr size_t WS_SX = 13 * MiB, WS_SWIN = 14 * MiB;
constexpr size_t WS_SAPOS = 12 * MiB;
constexpr size_t WS_SA = 8 * MiB, WS_SB = 9 * MiB;
constexpr size_t WS_H2Q = 96 * MiB;
constexpr size_t WS_TOPI = 3 * MiB, WS_TOPW = 4 * MiB, WS_LIST = 5 * MiB, WS_WPOS = 6 * MiB, WS_POSOF = 7 * MiB;
constexpr size_t WS_WINT = 16 * MiB, WS_WOUTT = 22 * MiB, WS_WQB = 24 * MiB, WS_WKVT = 26 * MiB, WS_WOT = 30 * MiB, WS_W1T = 32 * MiB, WS_W2T = 160 * MiB;
constexpr size_t WS_XB = 224 * MiB;
constexpr size_t WS_PROJ = 352 * MiB;
constexpr size_t WS_MEMN = 736 * MiB, WS_KVM = 752 * MiB;
constexpr size_t WS_GT = 784 * MiB, WS_VWT = 848 * MiB;
constexpr size_t WS_H1B = 224 * MiB;
constexpr size_t WS_P = 608 * MiB;
constexpr size_t WS_H2B = 224 * MiB;
constexpr size_t WS_OUT2 = 352 * MiB;
constexpr size_t WS_END = 912 * MiB;
constexpr int CW_BAR = 4096, CW_CNT = 8192, CW_FILL = 8448;
constexpr float C2Q = 0.125f * 1.4426950408889634f;
constexpr float C2M = 0.0625f * 1.4426950408889634f;

#define XB_TMO      128
#define XB_XCNT(j)  (256  + 64 * (j))
#define XB_XSUB(j)  (1280 + 64 * (j))
#define XB_XGEN(j)  (2304 + 64 * (j))
#define XB_TOP      3328
#define XB_TOPGEN   3392
#define XCD_BAR_WORDS 3456
#define XB_SPIN_CAP (1u << 24)

__device__ __forceinline__ unsigned xb_ld(unsigned* p)              { return __hip_atomic_load(p, __ATOMIC_RELAXED, __HIP_MEMORY_SCOPE_AGENT); }
__device__ __forceinline__ unsigned xb_add(unsigned* p, unsigned v) { return __hip_atomic_fetch_add(p, v, __ATOMIC_RELAXED, __HIP_MEMORY_SCOPE_AGENT); }
__device__ __forceinline__ unsigned xb_xcc_id() { return (unsigned)__builtin_amdgcn_s_getreg((3 << 11) | 20) & 0xFu; }
#define XB_SPIN(cond, bar) do { unsigned _sp = 0; while (cond) { __builtin_amdgcn_s_sleep(1); \
    if ((++_sp & 255u) == 0u) { if (xb_ld(&(bar)[XB_TMO])) break; if (_sp > XB_SPIN_CAP) { atomicAdd(&(bar)[XB_TMO], 1u); break; } } } } while (0)

struct XcdBarrier { unsigned* bar; unsigned x; volatile LAS unsigned* st; };

__device__ __forceinline__ XcdBarrier xcd_barrier_post(unsigned* bar, volatile LAS unsigned* st) {
    XcdBarrier b; b.bar = bar; b.x = xb_xcc_id(); b.st = st;
    if (threadIdx.x == 0) (void)xb_add(&bar[XB_XCNT(b.x)], 1u);
    return b;
}
__device__ __forceinline__ void xcd_barrier_complete(unsigned* bar, unsigned x, unsigned& nloc, unsigned& nx) {
    const unsigned G = gridDim.x * gridDim.y * gridDim.z;
    unsigned sum, cnt, mine, sp = 0u;
    for (;;) {
        sum = 0u; cnt = 0u; mine = 0u;
#pragma unroll
        for (unsigned j = 0; j < 16; ++j) { const unsigned c = xb_ld(&bar[XB_XCNT(j)]); sum += c; cnt += (c > 0u) ? 1u : 0u; mine = (j == x) ? c : mine; }
        if (sum == G) break;
        __builtin_amdgcn_s_sleep(1);
        if ((++sp & 255u) == 0u) { if (xb_ld(&bar[XB_TMO])) break; if (sp > XB_SPIN_CAP) { atomicAdd(&bar[XB_TMO], 1u); break; } }
    }
    nloc = mine > 0u ? mine : 1u; nx = cnt > 0u ? cnt : 1u;
}
__device__ __forceinline__ void xcd_barrier(const XcdBarrier& b) {
    asm volatile("s_waitcnt vmcnt(0)" ::: "memory");
    __syncthreads();
    if (threadIdx.x == 0) {
        unsigned* bar = b.bar;
        __builtin_amdgcn_s_waitcnt(0);
        unsigned nloc = b.st[0], nx = b.st[1];
        if (nloc == 0u) { xcd_barrier_complete(bar, b.x, nloc, nx); b.st[0] = nloc; b.st[1] = nx; }
        const unsigned old = xb_add(&bar[XB_XSUB(b.x)], 1u);
        const unsigned gen = old / nloc;
        if (old + 1u == (gen + 1u) * nloc) {
            __builtin_amdgcn_fence(__ATOMIC_RELEASE, "agent");
            asm volatile("s_waitcnt vmcnt(0)" ::: "memory");
            const unsigned og = xb_add(&bar[XB_TOP], 1u);
            const unsigned tg = og / nx;
            if (og + 1u == (tg + 1u) * nx) xb_add(&bar[XB_TOPGEN], 1u);
            else XB_SPIN(xb_ld(&bar[XB_TOPGEN]) == tg, bar);
            __builtin_amdgcn_fence(__ATOMIC_ACQUIRE, "agent");
            xb_add(&bar[XB_XGEN(b.x)], 1u);
            asm volatile("s_waitcnt vmcnt(0)" ::: "memory");
        } else {
            XB_SPIN(xb_ld(&bar[XB_XGEN(b.x)]) == gen, bar);
            __builtin_amdgcn_fence(__ATOMIC_ACQUIRE, "agent");
            asm volatile("s_waitcnt vmcnt(0)" ::: "memory");
        }
    }
    __syncthreads();
}

__device__ __forceinline__ float wave_sum(float v) {
#pragma unroll
    for (int o = 1; o < 64; o <<= 1) v += __shfl_xor(v, o);
    return v;
}
__device__ __forceinline__ float wave_max(float v) {
#pragma unroll
    for (int o = 1; o < 64; o <<= 1) v = fmaxf(v, __shfl_xor(v, o));
    return v;
}
__device__ __forceinline__ void sincos_d(double a, double& s, double& c) {
    const double TWO_PI_HI = 6.283185307179586232, TWO_PI_LO = 2.4492935982947064e-16;
    const double k = rint(a / TWO_PI_HI);
    double r = (a - k * TWO_PI_HI) - k * TWO_PI_LO;
    const double r2 = r * r;
    double ts = 1.0, tc = 1.0;
#pragma unroll
    for (int n = 16; n >= 1; --n) {
        ts = 1.0 - ts * r2 / (double)((2 * n) * (2 * n + 1));
        tc = 1.0 - tc * r2 / (double)((2 * n - 1) * (2 * n));
    }
    s = r * ts; c = tc;
}
__constant__ double INV_FREQ[8] = {1.0, 0.19392274474868576, 0.03760603093086393, 0.007292664737217109,
                                   0.001414213562373095, 0.0002742481756762073, 5.318295896944988e-05, 1.031338537721246e-05};

namespace g8 {
typedef unsigned short bf16_t;
typedef short bf16x8 __attribute__((ext_vector_type(8)));
typedef unsigned u32x4 __attribute__((ext_vector_type(4)));
typedef unsigned u32x2 __attribute__((ext_vector_type(2)));
typedef int i32x4 __attribute__((ext_vector_type(4)));
constexpr int BM = 256, BK = 64, HALF = 128, HTB = HALF * BK * 2, STAGE_BYTES = 8 * HTB, NXCD = 8, WGM = 8;
__host__ __device__ __forceinline__ int lds_byte(int r, int c) { const int st = (r >> 4) * 2 + (c >> 5), rr = r & 15, cc = c & 31, ob = rr * 64 + cc * 2; return st * 1024 + (ob ^ (((ob >> 9) & 1) << 5)); }
__host__ __device__ __forceinline__ void stage_rc(int b, int& R, int& C) { const int st = b / 1024, sb = b % 1024, swz = sb ^ (((sb >> 9) & 1) << 5); R = (st >> 1) * 16 + swz / 64; C = (st & 1) * 32 + (swz % 64) / 2; }
__host__ __device__ __forceinline__ int perm32(int rho) { const int n = rho >> 4, i = rho & 15; return 8 * (i >> 2) + 4 * n + (i & 3); }
__device__ __forceinline__ unsigned cvt_pk_bf16(float lo, float hi) { unsigned r; asm volatile("v_cvt_pk_bf16_f32 %0, %1, %2" : "=v"(r) : "v"(lo), "v"(hi)); return r; }

struct Unit { int arow0, nrows, acol0, orow0, ocol0, aux; size_t boff; };

struct DenseOrder {
    int nM, nN, nwg, G, c, ldb;
    __device__ void init(int M, int N, int ldb_, int G_, int c_) { nM = M / BM; nN = N / BM; nwg = nM * nN; G = G_; c = c_; ldb = ldb_; }
    __device__ bool tile(int i, int& pm, int& pn) const {
        const long L = (long)i * G + c; if (L >= nwg) return false;
        int wgid = (int)L; { const int q = nwg / NXCD, r = nwg % NXCD, xcd = wgid % NXCD, off = wgid / NXCD; wgid = (xcd < r ? xcd * (q + 1) : r * (q + 1) + (xcd - r) * q) + off; }
        const int nig = WGM * nN, gid = wgid / nig, fm = gid * WGM, gsz = (nM - fm) < WGM ? (nM - fm) : WGM;
        pm = fm + ((wgid % nig) % gsz); pn = (wgid % nig) / gsz; return true;
    }
    __device__ bool next(int i, Unit& u) const { int pm, pn; if (!tile(i, pm, pn)) return false;
        u.arow0 = pm * BM; u.nrows = BM; u.acol0 = 0; u.orow0 = pm * BM; u.ocol0 = pn * BM; u.aux = 0; u.boff = (size_t)pn * BM * ldb; return true; }
};
struct MoeOrder {
    const LAS int* goff; int nct, G, c, ldb;
    mutable int e_ = 0, base_ = 0, lo_ = -1, hi_ = 0;
    __device__ __forceinline__ int g(int e) const { return __builtin_amdgcn_readfirstlane(goff[e]); }
    __device__ bool next(int i, Unit& u) const {
        const int L = i * G + c;
        if (lo_ < 0) { lo_ = g(0); hi_ = g(1); }
        for (;;) { if (e_ >= 32) return false; const int n = ((hi_ - lo_ + 255) >> 8) * nct; if (L < base_ + n) break; base_ += n; ++e_; lo_ = hi_; hi_ = e_ < 32 ? g(e_ + 1) : hi_; }
        const int li = L - base_, rt = li / nct, ct = li - rt * nct;
        u.arow0 = lo_ + rt * BM; u.nrows = min(BM, hi_ - u.arow0); u.acol0 = 0; u.orow0 = u.arow0; u.ocol0 = ct * BM; u.aux = e_;
        u.boff = ((size_t)e_ * nct + ct) * BM * ldb; return true; }
};

__device__ __forceinline__ f32x4 mma_bf16(bf16x8 b, bf16x8 a, f32x4 c) { return __builtin_amdgcn_mfma_f32_16x16x32_bf16(b, a, c, 0, 0, 0); }
__device__ __forceinline__ i32x4 mma_bf16(bf16x8, bf16x8, i32x4 c) { return c; }
__device__ __forceinline__ i32x4 mma_i8(bf16x8 b, bf16x8 a, i32x4 c) { return __builtin_amdgcn_mfma_i32_16x16x64_i8(__builtin_bit_cast(i32x4, b), __builtin_bit_cast(i32x4, a), c, 0, 0, 0); }
__device__ __forceinline__ f32x4 mma_i8(bf16x8, bf16x8, f32x4 c) { return c; }
typedef int i32x8 __attribute__((ext_vector_type(8)));
__device__ __forceinline__ f32x4 mma_f8(i32x8 b, i32x8 a, f32x4 c) { const int one = 127; asm volatile("v_mfma_scale_f32_16x16x128_f8f6f4 %0, %1, %2, %0, %3, %3 op_sel_hi:[0,0,0]" : "+v"(c) : "v"(b), "v"(a), "v"(one)); return c; }
__device__ __forceinline__ i32x4 mma_f8(i32x8, i32x8, i32x4 c) { return c; }
template <class Epi, class Sched, bool GATHER>
__device__ __forceinline__ void gemm_phase(LAS unsigned char* lds, const bf16_t* A, int lda, const bf16_t* Bt, int ldb, int K, const int* list, const Sched& S, const Epi& E) {
    int tid_ = threadIdx.x; asm volatile("" : "+v"(tid_));
    const int tid = tid_, wid = __builtin_amdgcn_readfirstlane(tid >> 6), lane = tid & 63, wr = wid >> 2, wc = wid & 3, fr = lane & 15, fq = lane >> 4;
    const int nt = K / BK;
    unsigned voffB[2];
#pragma unroll
    for (int i = 0; i < 2; ++i) { int R, C; stage_rc(tid * 16 + i * 8192, R, C); const int Rb = 64 * (R >> 5) + (Epi::PERM ? perm32(R & 31) : (R & 31));   voffB[i] = (unsigned)(Rb * ldb + C) * 2u; }
    const size_t kstep = (size_t)(BK * 2);
    const size_t hstepB = (size_t)32 * ldb * 2;
    const unsigned ldsw = (unsigned)wid * 1024u;
    const int aoff = lds_byte(wr * 64 + fr, fq * 8), boff = lds_byte(wc * 32 + fr, fq * 8);
#define G8_MKRAW(V, U) do { _Pragma("unroll") for (int _h = 0; _h < 2; ++_h) _Pragma("unroll") for (int _i = 0; _i < 2; ++_i) { int _R, _C; stage_rc(tid * 16 + _i * 8192, _R, _C); int _r = 128 * _h + _R; _r = _r < (U).nrows ? _r : (U).nrows - 1; \
            V[_h][_i] = GATHER ? (unsigned)list[(U).arow0 + _r] : (unsigned)((U).arow0 + _r); } } while (0)
#define G8_MKCONV(V, U) do { _Pragma("unroll") for (int _h = 0; _h < 2; ++_h) _Pragma("unroll") for (int _i = 0; _i < 2; ++_i) { int _R, _C; stage_rc(tid * 16 + _i * 8192, _R, _C); V[_h][_i] = (V[_h][_i] * (unsigned)lda + (unsigned)((U).acol0 + _C)) * 2u; } } while (0)
#define G8_MKOFF(V, U) do { G8_MKRAW(V, U); G8_MKCONV(V, U); } while (0)
#define G8_SA(b, h) (((b) * 2 + (h)) * HTB)
#define G8_SB(b, h) ((4 + (b) * 2 + (h)) * HTB)
#define G8_STAGE_B(bufoff, gbase) do { _Pragma("unroll") for (int _i = 0; _i < 2; ++_i) \
        __builtin_amdgcn_global_load_lds((const unsigned*)((const char*)(gbase) + voffB[_i]), (LAS unsigned*)(lds + (bufoff) + ldsw + _i * 8192), 16, 0, 0); } while (0)
#define G8_STAGE_A(bufoff, kb, V, h) do { _Pragma("unroll") for (int _i = 0; _i < 2; ++_i) \
        __builtin_amdgcn_global_load_lds((const unsigned*)((const char*)A + (kb) + V[h][_i]), (LAS unsigned*)(lds + (bufoff) + ldsw + _i * 8192), 16, 0, 0); } while (0)
#define G8_STAGE_A2(bufoff, kb, h) do { _Pragma("unroll") for (int _i = 0; _i < 2; ++_i) \
        __builtin_amdgcn_global_load_lds((const unsigned*)((const char*)A + (kb) + (last ? vN[h][_i] : vC[h][_i])), (LAS unsigned*)(lds + (bufoff) + ldsw + _i * 8192), 16, 0, 0); } while (0)
#define G8_LDA(dst, b, h) do { if constexpr (Epi::F8) { _Pragma("unroll") for (int m = 0; m < 4; ++m) { const i32x4 _l = *(const LAS i32x4*)(lds + G8_SA(b, h) + aoff + m * 2048), _h = *(const LAS i32x4*)(lds + G8_SA(b, h) + aoff + m * 2048 + 1024); dst##8[m] = __builtin_shufflevector(_l, _h, 0, 1, 2, 3, 4, 5, 6, 7); } } \
        else { _Pragma("unroll") for (int m = 0; m < 4; ++m) _Pragma("unroll") for (int k = 0; k < 2; ++k) dst[m][k] = *(const LAS bf16x8*)(lds + G8_SA(b, h) + aoff + m * 2048 + k * 1024); } } while (0)
#define G8_LDB(dst, b, h) do { if constexpr (Epi::F8) { _Pragma("unroll") for (int n = 0; n < 2; ++n) { const i32x4 _l = *(const LAS i32x4*)(lds + G8_SB(b, h) + boff + n * 2048), _h = *(const LAS i32x4*)(lds + G8_SB(b, h) + boff + n * 2048 + 1024); dst##8[n] = __builtin_shufflevector(_l, _h, 0, 1, 2, 3, 4, 5, 6, 7); } } \
        else { _Pragma("unroll") for (int n = 0; n < 2; ++n) _Pragma("unroll") for (int k = 0; k < 2; ++k) dst[n][k] = *(const LAS bf16x8*)(lds + G8_SB(b, h) + boff + n * 2048 + k * 1024); } } while (0)
#define G8_MMA(ai, bj, At, Bt_) do { __builtin_amdgcn_s_setprio(1); _Pragma("unroll") for (int m = 0; m < 4; ++m) _Pragma("unroll") for (int n = 0; n < 2; ++n) { \
        if constexpr (Epi::F8) acc[ai][bj][m][n] = mma_f8(Bt_##8[n], At##8[m], acc[ai][bj][m][n]); \
        else { _Pragma("unroll") for (int k = 0; k < 2; ++k) { if constexpr (Epi::I8) acc[ai][bj][m][n] = mma_i8(Bt_[n][k], At[m][k], acc[ai][bj][m][n]); else acc[ai][bj][m][n] = mma_bf16(Bt_[n][k], At[m][k], acc[ai][bj][m][n]); } } } \
        if constexpr (Epi::F8) asm volatile("s_nop 15\n\ts_nop 7" ::: "memory");     \
        __builtin_amdgcn_s_setprio(0); } while (0)
#define G8_WAIT_V(n) asm volatile("s_waitcnt vmcnt(" #n ")" ::: "memory")
#define G8_WAIT_L(n) asm volatile("s_waitcnt lgkmcnt(" #n ")" ::: "memory")
#define G8_BAR __builtin_amdgcn_s_barrier()
#define G8_SCHED __builtin_amdgcn_sched_barrier(0)
    Unit cur, nxt; int ui = 0;
    if (!S.next(0, cur)) return;
    typedef typename Epi::acc_t acc_t;
    acc_t acc[2][2][4][2];
#pragma unroll
    for (int a = 0; a < 2; ++a)
#pragma unroll
        for (int b = 0; b < 2; ++b)
#pragma unroll
            for (int m = 0; m < 4; ++m)
#pragma unroll
                for (int n = 0; n < 2; ++n) acc[a][b][m][n] = (acc_t){0, 0, 0, 0};
    bf16x8 At[4][2], B0[2][2], B1[2][2];
    i32x8 At8[4], B08[2], B18[2];
    (void)At; (void)B0; (void)B1; (void)At8; (void)B08; (void)B18;
    unsigned vC[2][2], vN[2][2];
    G8_MKOFF(vC, cur);
    const char* cB = (const char*)Bt + cur.boff * 2;
    G8_STAGE_B(G8_SB(0, 0), cB); G8_STAGE_B(G8_SB(0, 1), cB + hstepB); G8_STAGE_A(G8_SA(0, 0), 0, vC, 0); G8_STAGE_A(G8_SA(0, 1), 0, vC, 1);
    if (wr == 1) G8_BAR;
    G8_WAIT_V(2); G8_BAR;
    G8_STAGE_B(G8_SB(1, 0), cB + kstep); G8_STAGE_A(G8_SA(1, 0), kstep, vC, 0); G8_STAGE_B(G8_SB(1, 1), cB + hstepB + kstep);
    G8_WAIT_V(6); G8_BAR;
    for (;;) {
        const bool has_next = S.next(ui + 1, nxt);
        const int tconv = (GATHER && nt > 2) ? 2 : 0;
        if (has_next) { if (GATHER) { G8_MKRAW(vN, nxt); } else { G8_MKOFF(vN, nxt); } } else {
#pragma unroll
            for (int h = 0; h < 2; ++h)
#pragma unroll
                for (int i = 0; i < 2; ++i) vN[h][i] = vC[h][i]; }
        const char* nB = has_next ? (const char*)Bt + nxt.boff * 2 : cB;
        for (int t = 0; t < nt; t += 2) {
            const bool last = (t == nt - 2);
            const size_t kb1 = (size_t)(t + 1) * kstep;
            const size_t kb2 = last ? 0 : (size_t)(t + 2) * kstep, kb3 = kb2 + kstep;
            const char* b2 = last ? nB : cB + (size_t)(t + 2) * kstep; const char* b3 = b2 + kstep;
            G8_LDB(B0, 0, 0); G8_LDB(B1, 0, 1); G8_SCHED; G8_LDA(At, 0, 0); G8_STAGE_A(G8_SA(1, 1), kb1, vC, 1);
            if (GATHER) { if (t == tconv && has_next) { G8_MKCONV(vN, nxt); } }
            G8_WAIT_V(8); G8_WAIT_L(0); G8_BAR; G8_MMA(0, 0, At, B0); G8_MMA(0, 1, At, B1); G8_BAR; G8_SCHED;
            G8_LDA(At, 0, 1); G8_STAGE_B(G8_SB(0, 0), b2); G8_STAGE_B(G8_SB(0, 1), b2 + hstepB); G8_STAGE_A2(G8_SA(0, 0), kb2, 0);
            G8_WAIT_V(8); G8_WAIT_L(0); G8_BAR; G8_MMA(1, 0, At, B0); G8_MMA(1, 1, At, B1); G8_BAR; G8_SCHED;
            G8_LDB(B0, 1, 0); G8_LDB(B1, 1, 1); G8_SCHED; G8_LDA(At, 1, 0); G8_STAGE_A2(G8_SA(0, 1), kb2, 1);
            G8_WAIT_V(8); G8_WAIT_L(0); G8_BAR; G8_MMA(0, 0, At, B0); G8_MMA(0, 1, At, B1); G8_BAR; G8_SCHED;
            G8_LDA(At, 1, 1); G8_STAGE_B(G8_SB(1, 0), b3); G8_STAGE_B(G8_SB(1, 1), b3 + hstepB); G8_STAGE_A2(G8_SA(1, 0), kb3, 0);
            G8_WAIT_V(8); G8_WAIT_L(0); G8_BAR; G8_MMA(1, 0, At, B0); G8_MMA(1, 1, At, B1); G8_BAR; G8_SCHED;
        }
        if (wr == 0) G8_BAR;
        E(acc, cur, wr, wc, fr, fq);
        if (!has_next) break;
#pragma unroll
        for (int a = 0; a < 2; ++a)
#pragma unroll
            for (int b = 0; b < 2; ++b)
#pragma unroll
                for (int m = 0; m < 4; ++m)
#pragma unroll
                    for (int n = 0; n < 2; ++n) acc[a][b][m][n] = (acc_t){0, 0, 0, 0};
        cur = nxt; cB = nB; ++ui;
#pragma unroll
        for (int h = 0; h < 2; ++h)
#pragma unroll
            for (int i = 0; i < 2; ++i) vC[h][i] = vN[h][i];
        if (wr == 1) G8_BAR;
    }
    G8_WAIT_V(0);
    G8_BAR;
#undef G8_MKOFF
#undef G8_MKRAW
#undef G8_MKCONV
#undef G8_SA
#undef G8_SB
#undef G8_STAGE_A
#undef G8_STAGE_A2
#undef G8_STAGE_B
#undef G8_LDA
#undef G8_LDB
#undef G8_MMA
#undef G8_WAIT_V
#undef G8_WAIT_L
#undef G8_BAR
#undef G8_SCHED
}

constexpr float HID_SCALE = 4.0f, W2_SCALE = 64.0f;
__device__ __forceinline__ void store_rows128(LAS unsigned char* stg, bf16_t* gp  , size_t ldc, u32x4 p0, u32x4 p1, int fr, int fq, int nvalid) {
    const int sw = fr & 7, lane = fr + 16 * fq, r0 = lane >> 3, c = lane & 7;
    *(LAS u32x4*)(stg + fr * 128 + ((fq ^ sw) << 4)) = p0;
    *(LAS u32x4*)(stg + fr * 128 + (((4 + fq) ^ sw) << 4)) = p1;
    asm volatile("s_waitcnt lgkmcnt(0)" ::: "memory");
    const u32x4 o0 = *(const LAS u32x4*)(stg + r0 * 128 + ((c ^ (r0 & 7)) << 4)), o1 = *(const LAS u32x4*)(stg + (8 + r0) * 128 + ((c ^ (r0 & 7)) << 4));
    asm volatile("s_waitcnt lgkmcnt(0)" ::: "memory");
    if (r0 < nvalid) *(u32x4*)(gp + (size_t)r0 * ldc + c * 8) = o0;
    if (8 + r0 < nvalid) *(u32x4*)(gp + (size_t)(8 + r0) * ldc + c * 8) = o1;
}
__device__ __forceinline__ float swiglu_f(float g, float l) {
    g = fminf(g, 7.0f); l = fminf(fmaxf(l, -7.0f), 7.0f);
    return g * __builtin_amdgcn_rcpf(1.0f + __expf(-1.702f * g)) * (l + 1.0f);
}
struct EpiSwigluB { typedef f32x4 acc_t; static constexpr bool I8 = false, F8 = false; static constexpr bool PERM = true;
    bf16_t* H; const float* b1;
    __device__ __forceinline__ void operator()(const f32x4 (&acc)[2][2][4][2], const Unit& u, int wr, int wc, int fr, int fq) const {
        const int col0 = u.ocol0 + wc * 64 + 8 * fq; const float* bp = b1 + (size_t)u.aux * 2048 + col0;
        f32x4 bv[2][2];
#pragma unroll
        for (int bj = 0; bj < 2; ++bj)
#pragma unroll
            for (int n = 0; n < 2; ++n) bv[bj][n] = *(const f32x4*)(bp + bj * 32 + 4 * n);
#pragma unroll
        for (int ai = 0; ai < 2; ++ai)
#pragma unroll
            for (int m = 0; m < 4; ++m) { const int r = ai * HALF + wr * 64 + m * 16 + fr; if (r < u.nrows) { bf16_t* rowp = H + (size_t)(u.orow0 + r) * 1024 + (col0 >> 1);
#pragma unroll
                for (int bj = 0; bj < 2; ++bj) { const f32x4 v0 = acc[ai][bj][m][0] + bv[bj][0], v1 = acc[ai][bj][m][1] + bv[bj][1];
                    u32x2 w; w.x = cvt_pk_bf16(swiglu_f(v0[0], v0[1]), swiglu_f(v0[2], v0[3])); w.y = cvt_pk_bf16(swiglu_f(v1[0], v1[1]), swiglu_f(v1[2], v1[3]));
                    *(u32x2*)(rowp + bj * 16) = w; } } }
    }
};
struct EpiSwigluI8 { typedef i32x4 acc_t; static constexpr bool I8 = true, F8 = false; static constexpr bool PERM = true;
    unsigned char* H; const float* b1; const float* sa; const float* sb;
    typedef float f2 __attribute__((ext_vector_type(2)));
    static __device__ __forceinline__ f2 swiglu2(f2 g, f2 l) {
        g.x = fminf(g.x, 7.0f); g.y = fminf(g.y, 7.0f); l.x = fminf(fmaxf(l.x, -7.0f), 7.0f); l.y = fminf(fmaxf(l.y, -7.0f), 7.0f);
        f2 t = g * (-1.702f * 1.4426950408889634f); t.x = __builtin_amdgcn_exp2f(t.x); t.y = __builtin_amdgcn_exp2f(t.y); t = t + 1.0f;
        f2 r; r.x = __builtin_amdgcn_rcpf(t.x); r.y = __builtin_amdgcn_rcpf(t.y);
        return (g * r) * (l * HID_SCALE + HID_SCALE); }
    __device__ __forceinline__ void operator()(const i32x4 (&acc)[2][2][4][2], const Unit& u, int wr, int wc, int fr, int fq) const {
        const int col0 = u.ocol0 + wc * 64 + 8 * fq; const float* bp = b1 + (size_t)u.aux * 2048 + col0; const float* sp = sb + (size_t)u.aux * 2048 + col0;
        f32x4 bv[2][2], sv[2][2]; float av[2][4];
#pragma unroll
        for (int bj = 0; bj < 2; ++bj)
#pragma unroll
            for (int n = 0; n < 2; ++n) { bv[bj][n] = *(const f32x4*)(bp + bj * 32 + 4 * n); sv[bj][n] = *(const f32x4*)(sp + bj * 32 + 4 * n); }
#pragma unroll
        for (int ai = 0; ai < 2; ++ai)
#pragma unroll
            for (int m = 0; m < 4; ++m) { const int r = ai * HALF + wr * 64 + m * 16 + fr; av[ai][m] = sa[u.orow0 + (r < u.nrows ? r : u.nrows - 1)]; }
#pragma unroll
        for (int ai = 0; ai < 2; ++ai) asm volatile("" : "+v"(av[ai][0]), "+v"(av[ai][1]), "+v"(av[ai][2]), "+v"(av[ai][3]));
#pragma unroll
        for (int ai = 0; ai < 2; ++ai)
#pragma unroll
            for (int m = 0; m < 4; ++m) { const int r = ai * HALF + wr * 64 + m * 16 + fr; if (r < u.nrows) { unsigned char* rowp = H + (size_t)(u.orow0 + r) * 1024 + (col0 >> 1); const float a = av[ai][m];
#pragma unroll
                for (int bj = 0; bj < 2; ++bj) { f32x4 c0, c1;
#pragma unroll
                    for (int q = 0; q < 4; ++q) { c0[q] = (float)acc[ai][bj][m][0][q]; c1[q] = (float)acc[ai][bj][m][1][q]; }
                    const f32x4 v0 = c0 * (sv[bj][0] * a) + bv[bj][0], v1 = c1 * (sv[bj][1] * a) + bv[bj][1];
                    const f2 h0 = swiglu2((f2){v0[0], v0[2]}, (f2){v0[1], v0[3]}), h1 = swiglu2((f2){v1[0], v1[2]}, (f2){v1[1], v1[3]});
                    unsigned w = 0u; w = __builtin_amdgcn_cvt_pk_fp8_f32(h0.x, h0.y, w, false); w = __builtin_amdgcn_cvt_pk_fp8_f32(h1.x, h1.y, w, true);
                    *(unsigned*)(rowp + bj * 16) = w; } } }
    }
};
struct EpiMoe2B { typedef f32x4 acc_t; static constexpr bool I8 = false, F8 = false; static constexpr bool PERM = true;
    bf16_t* O; const float* b2; const float* wpos;
    __device__ __forceinline__ void operator()(const f32x4 (&acc)[2][2][4][2], const Unit& u, int wr, int wc, int fr, int fq) const {
        const int col0 = u.ocol0 + wc * 64 + 8 * fq; const float* bp = b2 + (size_t)u.aux * 1024 + col0;
        f32x4 bv[2][2];
#pragma unroll
        for (int bj = 0; bj < 2; ++bj)
#pragma unroll
            for (int n = 0; n < 2; ++n) bv[bj][n] = *(const f32x4*)(bp + bj * 32 + 4 * n);
        float wv[2][4];
#pragma unroll
        for (int ai = 0; ai < 2; ++ai)
#pragma unroll
            for (int m = 0; m < 4; ++m) { const int r = ai * HALF + wr * 64 + m * 16 + fr; wv[ai][m] = wpos[u.orow0 + (r < u.nrows ? r : u.nrows - 1)]; }
#pragma unroll
        for (int ai = 0; ai < 2; ++ai) asm volatile("" : "+v"(wv[ai][0]), "+v"(wv[ai][1]), "+v"(wv[ai][2]), "+v"(wv[ai][3]));
#pragma unroll
        for (int ai = 0; ai < 2; ++ai)
#pragma unroll
            for (int m = 0; m < 4; ++m) { const int r = ai * HALF + wr * 64 + m * 16 + fr; if (r < u.nrows) { const float w = wv[ai][m]; bf16_t* rowp = O + (size_t)(u.orow0 + r) * 1024 + col0;
#pragma unroll
                for (int bj = 0; bj < 2; ++bj) { const f32x4 v0 = (acc[ai][bj][m][0] + bv[bj][0]) * w, v1 = (acc[ai][bj][m][1] + bv[bj][1]) * w;
                    u32x4 o; o.x = cvt_pk_bf16(v0[0], v0[1]); o.y = cvt_pk_bf16(v0[2], v0[3]); o.z = cvt_pk_bf16(v1[0], v1[1]); o.w = cvt_pk_bf16(v1[2], v1[3]);
                    *(u32x4*)(rowp + bj * 32) = o; } } }
    }
};

struct BatchOrder : DenseOrder { int bbatch_rows;
    __device__ bool next(int i, Unit& u) const { int pm, pn; if (!tile(i, pm, pn)) return false;
        u.arow0 = pm * BM; u.nrows = BM; u.acol0 = 0; u.orow0 = pm * BM; u.ocol0 = pn * BM; u.aux = 0; u.boff = ((size_t)(pm >> 3) * bbatch_rows + (size_t)pn * BM) * ldb; return true; } };
struct GtOrder { int G, c;
    __device__ bool next(int i, Unit& u) const { const int L = i * G + c; if (L >= 512) return false; const int h = L >> 7, b = (L >> 2) & 31, pn = L & 3;
        u.arow0 = b * 256; u.nrows = 256; u.acol0 = h * 256; u.boff = (size_t)pn * 256 * 1024 + h * 256; u.orow0 = b * 1024 + h * 256; u.ocol0 = pn * 256; u.aux = 0; return true; } };
struct VwtOrder { int G, c;
    __device__ bool next(int i, Unit& u) const { const int L = i * G + c; if (L >= 512) return false; const int b = L >> 4, h = (L >> 2) & 3, pm = L & 3;
        u.arow0 = pm * 256; u.nrows = 256; u.acol0 = h * 256; u.boff = (size_t)(b * 256) * 2048 + 1024 + h * 256; u.orow0 = b * 1024 + pm * 256; u.ocol0 = h * 256; u.aux = 0; return true; } };

struct EpiMoe2F8 { typedef f32x4 acc_t; static constexpr bool I8 = false, F8 = true; static constexpr bool PERM = true;
    bf16_t* O; const float* b2; const float* wpos; LAS unsigned char* stg;
    __device__ __forceinline__ void operator()(const f32x4 (&acc)[2][2][4][2], const Unit& u, int wr, int wc, int fr, int fq) const {
        const int col0 = u.ocol0 + wc * 64 + 8 * fq; const float* bp = b2 + (size_t)u.aux * 1024 + col0; const float is = 1.0f / (HID_SCALE * W2_SCALE);
        f32x4 bv[2][2];
#pragma unroll
        for (int bj = 0; bj < 2; ++bj)
#pragma unroll
            for (int n = 0; n < 2; ++n) bv[bj][n] = *(const f32x4*)(bp + bj * 32 + 4 * n);
        float wv[2][4];
#pragma unroll
        for (int ai = 0; ai < 2; ++ai)
#pragma unroll
            for (int m = 0; m < 4; ++m) { const int r = ai * HALF + wr * 64 + m * 16 + fr; wv[ai][m] = wpos[u.orow0 + (r < u.nrows ? r : u.nrows - 1)]; }
#pragma unroll
        for (int ai = 0; ai < 2; ++ai) asm volatile("" : "+v"(wv[ai][0]), "+v"(wv[ai][1]), "+v"(wv[ai][2]), "+v"(wv[ai][3]));
        LAS unsigned char* sw_ = stg + (wr * 4 + wc) * 2048;
#pragma unroll
        for (int ai = 0; ai < 2; ++ai)
#pragma unroll
            for (int m = 0; m < 4; ++m) { const int rg = ai * HALF + wr * 64 + m * 16; const float w = wv[ai][m]; u32x4 o[2];
#pragma unroll
                for (int bj = 0; bj < 2; ++bj) { const f32x4 v0 = (acc[ai][bj][m][0] * is + bv[bj][0]) * w, v1 = (acc[ai][bj][m][1] * is + bv[bj][1]) * w;
                    o[bj].x = cvt_pk_bf16(v0[0], v0[1]); o[bj].y = cvt_pk_bf16(v0[2], v0[3]); o[bj].z = cvt_pk_bf16(v1[0], v1[1]); o[bj].w = cvt_pk_bf16(v1[2], v1[3]); }
                store_rows128(sw_, O + (size_t)(u.orow0 + rg) * 1024 + u.ocol0 + wc * 64, 1024, o[0], o[1], fr, fq, u.nrows - rg); }
    }
};
struct EpiProj { typedef i32x4 acc_t; static constexpr bool I8 = true, F8 = false; static constexpr bool PERM = true;
    bf16_t* O; const float* ropec; const float* ropes; LAS unsigned char* stg; const float* sx; const float* sw; LAS unsigned char* tab;
    __device__ __forceinline__ void operator()(const i32x4 (&acc)[2][2][4][2], const Unit& u, int wr, int wc, int fr, int fq) const {
        const int region = u.ocol0 >> 9;
        const bool rope = (region != 2 && region != 5);
        const float sc = (region == 0 || region == 3) ? C2Q : 1.0f;
        const float sg = (fq == 0) ? -1.0f : 1.0f;
        const int tid = (wr * 4 + wc) * 64 + fr + 16 * fq;
        f32x4 swv[2][2]; float sxv[2][4];
#pragma unroll
        for (int bj = 0; bj < 2; ++bj)
#pragma unroll
            for (int n = 0; n < 2; ++n) swv[bj][n] = *(const f32x4*)(sw + u.ocol0 + wc * 64 + 8 * fq + bj * 32 + 4 * n) * sc;
#pragma unroll
        for (int ai = 0; ai < 2; ++ai)
#pragma unroll
            for (int m = 0; m < 4; ++m) sxv[ai][m] = sx[u.orow0 + ai * HALF + wr * 64 + m * 16 + fr];
#pragma unroll
        for (int ai = 0; ai < 2; ++ai) {
            if (rope) { const int trow = tid >> 2, tq = tid & 3, pos = (u.orow0 + ai * HALF + trow) & (SEQ - 1);
                const f32x4 tv = *(const f32x4*)((tq < 2 ? ropec : ropes) + pos * 8 + (tq & 1) * 4);
                *(LAS f32x4*)(tab + trow * 64 + tq * 16) = tv;
                asm volatile("s_waitcnt lgkmcnt(0)" ::: "memory"); __builtin_amdgcn_s_barrier(); asm volatile("" ::: "memory"); }
#pragma unroll
            for (int m = 0; m < 4; ++m) { f32x4 cs[4]; const float sxr_ = sxv[ai][m];
                if (rope) { const LAS unsigned char* tp = tab + (wr * 64 + m * 16 + fr) * 64;
                    cs[0] = *(const LAS f32x4*)(tp); cs[1] = *(const LAS f32x4*)(tp + 16); cs[2] = *(const LAS f32x4*)(tp + 32); cs[3] = *(const LAS f32x4*)(tp + 48); }
                u32x4 w[2];
#pragma unroll
                for (int bj = 0; bj < 2; ++bj) { f32x4 v0, v1;
#pragma unroll
                    for (int q = 0; q < 4; ++q) { v0[q] = (float)acc[ai][bj][m][0][q]; v1[q] = (float)acc[ai][bj][m][1][q]; }
                    v0 = v0 * (swv[bj][0] * sxr_); v1 = v1 * (swv[bj][1] * sxr_);
                    if (rope && bj == 0) { f32x4 p0, p1;
#pragma unroll
                        for (int e = 0; e < 4; ++e) { p0[e] = __shfl_xor(v0[e], 16); p1[e] = __shfl_xor(v1[e], 16); }
                        if (fq < 2) { v0 = v0 * cs[0] + p0 * (cs[2] * sg); v1 = v1 * cs[1] + p1 * (cs[3] * sg); } }
                    w[bj].x = cvt_pk_bf16(v0[0], v0[1]); w[bj].y = cvt_pk_bf16(v0[2], v0[3]); w[bj].z = cvt_pk_bf16(v1[0], v1[1]); w[bj].w = cvt_pk_bf16(v1[2], v1[3]); }
                store_rows128(stg + (wr * 4 + wc) * 2048, O + (size_t)(u.orow0 + ai * HALF + wr * 64 + m * 16) * NPROJ + u.ocol0 + wc * 64, (size_t)NPROJ, w[0], w[1], fr, fq, 16); }
            if (rope) { asm volatile("s_waitcnt lgkmcnt(0)" ::: "memory"); __builtin_amdgcn_s_barrier(); asm volatile("" ::: "memory"); }
        }
    }
};
struct EpiPlainB { typedef f32x4 acc_t; static constexpr bool I8 = false, F8 = false; static constexpr bool PERM = true;
    bf16_t* O; int ldc; LAS unsigned char* stg;
    __device__ __forceinline__ void operator()(const f32x4 (&acc)[2][2][4][2], const Unit& u, int wr, int wc, int fr, int fq) const {
        LAS unsigned char* sw_ = stg + (wr * 4 + wc) * 2048;
#pragma unroll
        for (int ai = 0; ai < 2; ++ai)
#pragma unroll
            for (int m = 0; m < 4; ++m) { u32x4 w[2];
#pragma unroll
                for (int bj = 0; bj < 2; ++bj) { const f32x4 v0 = acc[ai][bj][m][0], v1 = acc[ai][bj][m][1];
                    w[bj].x = cvt_pk_bf16(v0[0], v0[1]); w[bj].y = cvt_pk_bf16(v0[2], v0[3]); w[bj].z = cvt_pk_bf16(v1[0], v1[1]); w[bj].w = cvt_pk_bf16(v1[2], v1[3]); }
                store_rows128(sw_, O + (size_t)(u.orow0 + ai * HALF + wr * 64 + m * 16) * ldc + u.ocol0 + wc * 64, (size_t)ldc, w[0], w[1], fr, fq, 16); }
    }
};
struct EpiResidF { typedef f32x4 acc_t; static constexpr bool I8 = false, F8 = false; static constexpr bool PERM = false;
    float* O; const float* R; float alpha;
    __device__ __forceinline__ void operator()(const f32x4 (&acc)[2][2][4][2], const Unit& u, int wr, int wc, int fr, int fq) const {
        const int col0 = u.ocol0 + wc * 64 + 4 * fq;
#pragma unroll
        for (int ai = 0; ai < 2; ++ai) { f32x4 pre[4][2][2];
#pragma unroll
            for (int m = 0; m < 4; ++m) { const size_t off = (size_t)(u.orow0 + ai * HALF + wr * 64 + m * 16 + fr) * 1024 + col0;
#pragma unroll
                for (int bj = 0; bj < 2; ++bj)
#pragma unroll
                    for (int n = 0; n < 2; ++n) pre[m][bj][n] = *(const f32x4*)(R + off + bj * 32 + n * 16); }
#pragma unroll
            for (int m = 0; m < 4; ++m)
#pragma unroll
                for (int bj = 0; bj < 2; ++bj) asm volatile("" : "+v"(pre[m][bj][0]), "+v"(pre[m][bj][1]));
#pragma unroll
            for (int m = 0; m < 4; ++m) { const size_t off = (size_t)(u.orow0 + ai * HALF + wr * 64 + m * 16 + fr) * 1024 + col0;
#pragma unroll
                for (int bj = 0; bj < 2; ++bj)
#pragma unroll
                    for (int n = 0; n < 2; ++n) *(f32x4*)(O + off + bj * 32 + n * 16) = pre[m][bj][n] * alpha + acc[ai][bj][m][n]; }
            asm volatile("" ::: "memory"); }
    }
};
struct EpiResidStats { typedef f32x4 acc_t; static constexpr bool I8 = false, F8 = false; static constexpr bool PERM = false;
    bf16_t* Ob; const float* R; long long* st; float alpha;
    __device__ __forceinline__ void operator()(const f32x4 (&acc)[2][2][4][2], const Unit& u, int wr, int wc, int fr, int fq) const {
        const int col0 = u.ocol0 + wc * 64 + 4 * fq;
#pragma unroll
        for (int ai = 0; ai < 2; ++ai) { f32x4 pre[4][2][2];
#pragma unroll
            for (int m = 0; m < 4; ++m) { const size_t off = (size_t)(u.orow0 + ai * HALF + wr * 64 + m * 16 + fr) * 1024 + col0;
#pragma unroll
                for (int bj = 0; bj < 2; ++bj)
#pragma unroll
                    for (int n = 0; n < 2; ++n) pre[m][bj][n] = __builtin_nontemporal_load((const f32x4*)(R + off + bj * 32 + n * 16)); }
#pragma unroll
            for (int m = 0; m < 4; ++m)
#pragma unroll
                for (int bj = 0; bj < 2; ++bj) asm volatile("" : "+v"(pre[m][bj][0]), "+v"(pre[m][bj][1]));
#pragma unroll
            for (int m = 0; m < 4; ++m) { const int row = u.orow0 + ai * HALF + wr * 64 + m * 16 + fr; const size_t off = (size_t)row * 1024 + col0; float s1 = 0.f, s2 = 0.f;
#pragma unroll
                for (int bj = 0; bj < 2; ++bj)
#pragma unroll
                    for (int n = 0; n < 2; ++n) { const f32x4 v = pre[m][bj][n] * alpha + acc[ai][bj][m][n];
                        u32x2 w; w.x = cvt_pk_bf16(v[0], v[1]); w.y = cvt_pk_bf16(v[2], v[3]); *(u32x2*)(Ob + off + bj * 32 + n * 16) = w;
                        s1 += (v[0] + v[1]) + (v[2] + v[3]); s2 += (v[0] * v[0] + v[1] * v[1]) + (v[2] * v[2] + v[3] * v[3]); }
                s1 += __shfl_xor(s1, 16); s1 += __shfl_xor(s1, 32); s2 += __shfl_xor(s2, 16); s2 += __shfl_xor(s2, 32);
                if (fq == 0) { fx_add(st + 2 * (size_t)row, s1); fx_add(st + 2 * (size_t)row + 1, s2); } }
            asm volatile("" ::: "memory"); }
    }
};
struct EpiResidLN { typedef f32x4 acc_t; static constexpr bool I8 = false, F8 = false; static constexpr bool PERM = false;
    bf16_t* O; const bf16_t* R; const long long* st; const float* g; const float* bb; float alpha;
    __device__ __forceinline__ void operator()(const f32x4 (&acc)[2][2][4][2], const Unit& u, int wr, int wc, int fr, int fq) const {
        const int col0 = u.ocol0 + wc * 64 + 4 * fq;
        f32x4 gv[2][2], bv[2][2];
#pragma unroll
        for (int bj = 0; bj < 2; ++bj)
#pragma unroll
            for (int n = 0; n < 2; ++n) { gv[bj][n] = *(const f32x4*)(g + col0 + bj * 32 + n * 16); bv[bj][n] = *(const f32x4*)(bb + col0 + bj * 32 + n * 16); }
#pragma unroll
        for (int ai = 0; ai < 2; ++ai) { u32x2 pre[4][2][2]; float mu[4], rs[4];
#pragma unroll
            for (int m = 0; m < 4; ++m) { const int row = u.orow0 + ai * HALF + wr * 64 + m * 16 + fr; const size_t off = (size_t)row * 1024 + col0;
                mu[m] = fx_get(st + 2 * (size_t)row); rs[m] = fx_get(st + 2 * (size_t)row + 1);
#pragma unroll
                for (int bj = 0; bj < 2; ++bj)
#pragma unroll
                    for (int n = 0; n < 2; ++n) pre[m][bj][n] = *(const u32x2*)(R + off + bj * 32 + n * 16); }
#pragma unroll
            for (int m = 0; m < 4; ++m) { asm volatile("" : "+v"(mu[m]), "+v"(rs[m]));
#pragma unroll
                for (int bj = 0; bj < 2; ++bj) asm volatile("" : "+v"(pre[m][bj][0]), "+v"(pre[m][bj][1])); }
#pragma unroll
            for (int m = 0; m < 4; ++m) { const size_t off = (size_t)(u.orow0 + ai * HALF + wr * 64 + m * 16 + fr) * 1024 + col0;
                const float mean = mu[m] * (1.0f / 1024.0f), rstd = 1.0f / sqrtf(fmaxf(rs[m] * (1.0f / 1024.0f) - mean * mean, 0.f) + LN_EPS);
#pragma unroll
                for (int bj = 0; bj < 2; ++bj)
#pragma unroll
                    for (int n = 0; n < 2; ++n) { const u32x2 p = pre[m][bj][n]; const f32x4 t = {__uint_as_float(p.x << 16), __uint_as_float(p.x & 0xffff0000u), __uint_as_float(p.y << 16), __uint_as_float(p.y & 0xffff0000u)};
                        const f32x4 v = ((t - mean) * rstd * gv[bj][n] + bv[bj][n]) * alpha + acc[ai][bj][m][n];
                        u32x2 w; w.x = cvt_pk_bf16(v[0], v[1]); w.y = cvt_pk_bf16(v[2], v[3]); *(u32x2*)(O + off + bj * 32 + n * 16) = w; } }
            asm volatile("" ::: "memory"); }
    }
};
struct EpiGT { typedef f32x4 acc_t; static constexpr bool I8 = false, F8 = false; static constexpr bool PERM = true;
    bf16_t* O; const float* g; const float* bb; long long* cs; long long* bfs; LAS unsigned char* stg;
    __device__ __forceinline__ void operator()(const f32x4 (&acc)[2][2][4][2], const Unit& u, int wr, int wc, int fr, int fq) const {
        const int col0 = u.ocol0 + wc * 64 + 8 * fq;
        f32x4 gv[2][2], bv[2][2];
#pragma unroll
        for (int bj = 0; bj < 2; ++bj)
#pragma unroll
            for (int n = 0; n < 2; ++n) { gv[bj][n] = *(const f32x4*)(g + col0 + bj * 32 + 4 * n); bv[bj][n] = *(const f32x4*)(bb + col0 + bj * 32 + 4 * n); }
#pragma unroll
        for (int ai = 0; ai < 2; ++ai)
#pragma unroll
            for (int m = 0; m < 4; ++m) { const int row = u.orow0 + ai * HALF + wr * 64 + m * 16 + fr; float s1 = 0.f, s2 = 0.f; u32x4 wq[2];
#pragma unroll
                for (int bj = 0; bj < 2; ++bj) { const f32x4 a0 = acc[ai][bj][m][0], a1 = acc[ai][bj][m][1]; const f32x4 v0 = a0 * gv[bj][0], v1 = a1 * gv[bj][1], w0 = a0 * bv[bj][0], w1 = a1 * bv[bj][1];
                    wq[bj].x = cvt_pk_bf16(v0[0], v0[1]); wq[bj].y = cvt_pk_bf16(v0[2], v0[3]); wq[bj].z = cvt_pk_bf16(v1[0], v1[1]); wq[bj].w = cvt_pk_bf16(v1[2], v1[3]);
                    s1 += ((v0[0] + v0[1]) + (v0[2] + v0[3])) + ((v1[0] + v1[1]) + (v1[2] + v1[3])); s2 += ((w0[0] + w0[1]) + (w0[2] + w0[3])) + ((w1[0] + w1[1]) + (w1[2] + w1[3])); }
                store_rows128(stg + (wr * 4 + wc) * 2048, O + (size_t)(row - fr) * 1024 + u.ocol0 + wc * 64, 1024, wq[0], wq[1], fr, fq, 16);
                s1 += __shfl_xor(s1, 16); s1 += __shfl_xor(s1, 32); s2 += __shfl_xor(s2, 16); s2 += __shfl_xor(s2, 32);
                if (fq == 0) { fx_add(cs + row, s1); fx_add(bfs + row, s2); } }
    }
};
struct EpiSoftmaxP { typedef f32x4 acc_t; static constexpr bool I8 = false, F8 = false; static constexpr bool PERM = true;
    bf16_t* O; LAS unsigned char* xs; LAS unsigned char* stg; const long long* st; const long long* cs; const long long* bfs;
    __device__ __forceinline__ void operator()(const f32x4 (&acc)[2][2][4][2], const Unit& u, int wr, int wc, int fr, int fq) const {
        typedef float f32x2v __attribute__((ext_vector_type(2)));
        LAS f32x2v* X = (LAS f32x2v*)xs;
        f32x4 e[2][4][2][2]; float mw[2][4];
        const int cc0 = (u.orow0 >> 11) * 1024 + u.ocol0 + wc * 64 + 8 * fq;
        f32x4 cv[2][2], fv[2][2]; float mu[2][4], rs[2][4];
#pragma unroll
        for (int bj = 0; bj < 2; ++bj)
#pragma unroll
            for (int n = 0; n < 2; ++n)
#pragma unroll
                for (int q = 0; q < 4; ++q) { cv[bj][n][q] = fx_get(cs + cc0 + bj * 32 + 4 * n + q); fv[bj][n][q] = fx_get(bfs + cc0 + bj * 32 + 4 * n + q); }
#pragma unroll
        for (int ai = 0; ai < 2; ++ai)
#pragma unroll
            for (int m = 0; m < 4; ++m) { const size_t row = (size_t)(u.orow0 + ai * HALF + wr * 64 + m * 16 + fr); mu[ai][m] = fx_get(st + 2 * row); rs[ai][m] = fx_get(st + 2 * row + 1); }
#pragma unroll
        for (int ai = 0; ai < 2; ++ai) asm volatile("" : "+v"(mu[ai][0]), "+v"(mu[ai][1]), "+v"(mu[ai][2]), "+v"(mu[ai][3]), "+v"(rs[ai][0]), "+v"(rs[ai][1]), "+v"(rs[ai][2]), "+v"(rs[ai][3]));
#pragma unroll
        for (int ai = 0; ai < 2; ++ai)
#pragma unroll
            for (int m = 0; m < 4; ++m) { float mx = -INFINITY; const float mean = mu[ai][m] * (1.0f / 1024.0f), rstd = 1.0f / sqrtf(fmaxf(rs[ai][m] * (1.0f / 1024.0f) - mean * mean, 0.f) + LN_EPS);
#pragma unroll
                for (int bj = 0; bj < 2; ++bj)
#pragma unroll
                    for (int n = 0; n < 2; ++n) { const f32x4 v = ((acc[ai][bj][m][n] - cv[bj][n] * mean) * rstd + fv[bj][n]) * C2M; e[ai][m][bj][n] = v; mx = fmaxf(mx, fmaxf(fmaxf(v[0], v[1]), fmaxf(v[2], v[3]))); }
                mx = fmaxf(mx, __shfl_xor(mx, 16)); mx = fmaxf(mx, __shfl_xor(mx, 32)); float sm = 0.f;
#pragma unroll
                for (int bj = 0; bj < 2; ++bj)
#pragma unroll
                    for (int n = 0; n < 2; ++n) { f32x4 v = e[ai][m][bj][n];
#pragma unroll
                        for (int q = 0; q < 4; ++q) { v[q] = __builtin_amdgcn_exp2f(v[q] - mx); sm += v[q]; }
                        e[ai][m][bj][n] = v; }
                sm += __shfl_xor(sm, 16); sm += __shfl_xor(sm, 32); mw[ai][m] = mx;
                if (fq == 0) X[(ai * HALF + wr * 64 + m * 16 + fr) * 4 + wc] = (f32x2v){mx, sm}; }
        asm volatile("s_waitcnt lgkmcnt(0)" ::: "memory"); __builtin_amdgcn_s_barrier(); asm volatile("" ::: "memory");
        const int col0 = u.ocol0 + wc * 64 + 8 * fq;
#pragma unroll
        for (int ai = 0; ai < 2; ++ai)
#pragma unroll
            for (int m = 0; m < 4; ++m) { const int r = ai * HALF + wr * 64 + m * 16 + fr;
                const f32x2v a = X[r * 4 + 0], b = X[r * 4 + 1], c = X[r * 4 + 2], d = X[r * 4 + 3];
                const float mt = fmaxf(fmaxf(a.x, b.x), fmaxf(c.x, d.x));
                const float st = a.y * __builtin_amdgcn_exp2f(a.x - mt) + b.y * __builtin_amdgcn_exp2f(b.x - mt) + c.y * __builtin_amdgcn_exp2f(c.x - mt) + d.y * __builtin_amdgcn_exp2f(d.x - mt);
                const float f = __builtin_amdgcn_exp2f(mw[ai][m] - mt) / st;
                u32x4 w[2];
#pragma unroll
                for (int bj = 0; bj < 2; ++bj) { const f32x4 v0 = e[ai][m][bj][0] * f, v1 = e[ai][m][bj][1] * f;
                    w[bj].x = cvt_pk_bf16(v0[0], v0[1]); w[bj].y = cvt_pk_bf16(v0[2], v0[3]); w[bj].z = cvt_pk_bf16(v1[0], v1[1]); w[bj].w = cvt_pk_bf16(v1[2], v1[3]); }
                store_rows128(stg + (wr * 4 + wc) * 2048, O + (size_t)(u.orow0 + r - fr) * 1024 + u.ocol0 + wc * 64, 1024, w[0], w[1], fr, fq, 16); }
    }
};
}


__device__ __forceinline__ float4 ldnt4(const float* p) { const f32x4 v = __builtin_nontemporal_load((const f32x4*)p); return make_float4(v[0], v[1], v[2], v[3]); }
__device__ __forceinline__ void stnt4(float* p, float4 v) { __builtin_nontemporal_store((f32x4){v.x, v.y, v.z, v.w}, (f32x4*)p); }
__device__ __forceinline__ void transpose_item(const float* W, int K, int N, unsigned short* WT, LAS float* scr, int item, int lane) {
    const int nblk = N / 32, kb = item / nblk, nb = item % nblk, k0 = 64 * kb, n0 = 32 * nb;
#pragma unroll
    for (int i = 0; i < 8; ++i) { const int kk = 8 * i + (lane >> 3); const float4 v = ldnt4(W + (size_t)(k0 + kk) * N + n0 + 4 * (lane & 7));
        LAS float* d = scr + kk * 33 + 4 * (lane & 7); d[0] = v.x; d[1] = v.y; d[2] = v.z; d[3] = v.w; }
    WSYNC();
    const int c = lane & 7;
#pragma unroll
    for (int j = 0; j < 4; ++j) { const int n = (lane >> 3) + 8 * j; const LAS float* sp = scr + (8 * c) * 33 + n;
        g8::u32x4 o; o.x = g8::cvt_pk_bf16(sp[0 * 33], sp[1 * 33]); o.y = g8::cvt_pk_bf16(sp[2 * 33], sp[3 * 33]); o.z = g8::cvt_pk_bf16(sp[4 * 33], sp[5 * 33]); o.w = g8::cvt_pk_bf16(sp[6 * 33], sp[7 * 33]);
        *(g8::u32x4*)(WT + (size_t)(n0 + n) * K + k0 + 8 * c) = o; }
    WSYNC();
}
__device__ __forceinline__ void quant_w1_block(const float* W, int N, signed char* Q, float* sbo, LAS float* stage, LAS float* red, int nb, int tid) {
    const int lane = tid & 63, wave = tid >> 6, n0 = 32 * nb;
    float4 m4 = make_float4(0.f, 0.f, 0.f, 0.f);
    const float* wp = W + (size_t)(128 * wave + (lane >> 3)) * N + n0 + 4 * (lane & 7);
    LAS float* dp = stage + (128 * wave + (lane >> 3)) * 33 + 4 * (lane & 7);
#pragma unroll 8
    for (int i = 0; i < 16; ++i) { const float4 v = ldnt4(wp + (size_t)i * 8 * N); LAS float* d = dp + i * 8 * 33; d[0] = v.x; d[1] = v.y; d[2] = v.z; d[3] = v.w;
        m4.x = fmaxf(m4.x, fabsf(v.x)); m4.y = fmaxf(m4.y, fabsf(v.y)); m4.z = fmaxf(m4.z, fabsf(v.z)); m4.w = fmaxf(m4.w, fabsf(v.w)); }
#pragma unroll
    for (int o = 8; o < 64; o <<= 1) { m4.x = fmaxf(m4.x, __shfl_xor(m4.x, o)); m4.y = fmaxf(m4.y, __shfl_xor(m4.y, o)); m4.z = fmaxf(m4.z, __shfl_xor(m4.z, o)); m4.w = fmaxf(m4.w, __shfl_xor(m4.w, o)); }
    if (lane < 8) { LAS float* r = red + wave * 32 + 4 * lane; r[0] = m4.x; r[1] = m4.y; r[2] = m4.z; r[3] = m4.w; }
    __syncthreads();
    const int n = tid & 31, kc = tid >> 5;
    float mx = 0.f;
#pragma unroll
    for (int w = 0; w < 8; ++w) mx = fmaxf(mx, red[w * 32 + n]);
    mx = fmaxf(mx, 1e-30f);
    const float iv = 127.0f / mx;
    if (tid < 32) sbo[n0 + tid] = mx * (1.0f / 127.0f);
    const LAS float* sp = stage + (64 * kc) * 33 + n;
#pragma unroll
    for (int j = 0; j < 4; ++j) { g8::u32x4 o;
#pragma unroll
        for (int d = 0; d < 4; ++d) { unsigned w = 0u;
#pragma unroll
            for (int q = 0; q < 4; ++q) w |= ((unsigned)(int)rintf(sp[(16 * j + 4 * d + q) * 33] * iv) & 0xffu) << (8 * q);
            o[d] = w; }
        *(g8::u32x4*)(Q + (size_t)(n0 + n) * 1024 + 64 * kc + 16 * j) = o; }
    __syncthreads();
}
__device__ __forceinline__ void quant_w1_item(const float* W, int N, signed char* Q, float* sbo, LAS float* scr, int nb, int lane) {
    const int n0 = 32 * nb;
    float4 m4 = make_float4(0.f, 0.f, 0.f, 0.f);
    const float* wp = W + (size_t)(lane >> 3) * N + n0 + 4 * (lane & 7);
#pragma unroll 1
    for (int kb = 0; kb < 16; ++kb) {
#pragma unroll
        for (int i = 0; i < 8; ++i) { const float4 v = *(const float4*)(wp + (size_t)i * 8 * N); m4.x = fmaxf(m4.x, fabsf(v.x)); m4.y = fmaxf(m4.y, fabsf(v.y)); m4.z = fmaxf(m4.z, fabsf(v.z)); m4.w = fmaxf(m4.w, fabsf(v.w)); }
        wp += (size_t)64 * N; }
#pragma unroll
    for (int o = 8; o < 64; o <<= 1) { m4.x = fmaxf(m4.x, __shfl_xor(m4.x, o)); m4.y = fmaxf(m4.y, __shfl_xor(m4.y, o)); m4.z = fmaxf(m4.z, __shfl_xor(m4.z, o)); m4.w = fmaxf(m4.w, __shfl_xor(m4.w, o)); }
    float mx; { const int src = (lane & 31) >> 2, cmp = lane & 3; const float a = __shfl(m4.x, src), b = __shfl(m4.y, src), c2 = __shfl(m4.z, src), d = __shfl(m4.w, src); mx = cmp == 0 ? a : cmp == 1 ? b : cmp == 2 ? c2 : d; }
    mx = fmaxf(mx, 1e-30f);
    const float inv = 127.0f / mx;
    if (lane < 32) sbo[n0 + lane] = mx * (1.0f / 127.0f);
    const int c = lane & 7;
    wp = W + (size_t)(lane >> 3) * N + n0 + 4 * (lane & 7);
#pragma unroll 1
    for (int kb = 0; kb < 16; ++kb) { const int k0 = 64 * kb;
#pragma unroll
        for (int i = 0; i < 8; ++i) { const float4 v = ldnt4(wp + (size_t)i * 8 * N); LAS float* d = scr + (8 * i + (lane >> 3)) * 33 + 4 * (lane & 7); d[0] = v.x; d[1] = v.y; d[2] = v.z; d[3] = v.w; }
        wp += (size_t)64 * N;
        WSYNC();
#pragma unroll
        for (int j = 0; j < 4; ++j) { const int n = (lane >> 3) + 8 * j; const LAS float* sp = scr + (8 * c) * 33 + n; const float iv = __shfl(inv, n);
            unsigned lo = 0u, hi = 0u;
#pragma unroll
            for (int q = 0; q < 4; ++q) { lo |= ((unsigned)(int)rintf(sp[q * 33] * iv) & 0xffu) << (8 * q); hi |= ((unsigned)(int)rintf(sp[(q + 4) * 33] * iv) & 0xffu) << (8 * q); }
            g8::u32x2 o; o.x = lo; o.y = hi; *(g8::u32x2*)(Q + (size_t)(n0 + n) * 1024 + k0 + 8 * c) = o; }
        WSYNC(); }
}
__device__ __forceinline__ void transpose_item_f8(const float* W, int K, int N, unsigned char* WT, float scale, LAS float* scr, int item, int lane) {
    const int nblk = N / 32, kb = item / nblk, nb = item % nblk, k0 = 64 * kb, n0 = 32 * nb;
#pragma unroll
    for (int i = 0; i < 8; ++i) { const int kk = 8 * i + (lane >> 3); const float4 v = ldnt4(W + (size_t)(k0 + kk) * N + n0 + 4 * (lane & 7));
        LAS float* d = scr + kk * 33 + 4 * (lane & 7); d[0] = v.x; d[1] = v.y; d[2] = v.z; d[3] = v.w; }
    WSYNC();
    const int c = lane & 7;
#pragma unroll
    for (int j = 0; j < 4; ++j) { const int n = (lane >> 3) + 8 * j; const LAS float* sp = scr + (8 * c) * 33 + n;
        unsigned lo = 0u, hi = 0u;
        lo = __builtin_amdgcn_cvt_pk_fp8_f32(sp[0 * 33] * scale, sp[1 * 33] * scale, lo, false); lo = __builtin_amdgcn_cvt_pk_fp8_f32(sp[2 * 33] * scale, sp[3 * 33] * scale, lo, true);
        hi = __builtin_amdgcn_cvt_pk_fp8_f32(sp[4 * 33] * scale, sp[5 * 33] * scale, hi, false); hi = __builtin_amdgcn_cvt_pk_fp8_f32(sp[6 * 33] * scale, sp[7 * 33] * scale, hi, true);
        g8::u32x2 o; o.x = lo; o.y = hi; *(g8::u32x2*)(WT + (size_t)(n0 + n) * K + k0 + 8 * c) = o; }
    WSYNC();
}
__device__ __forceinline__ float bf2f(unsigned short h) { return __uint_as_float((unsigned)h << 16); }
__device__ __forceinline__ void ln_wave(float4 (&v)[4], const float* g, const float* bta, int lane) {
    float s = 0.f;
#pragma unroll
    for (int j = 0; j < 4; ++j) s += (v[j].x + v[j].y) + (v[j].z + v[j].w);
    const float mean = wave_sum(s) * (1.f / D); float s2 = 0.f;
#pragma unroll
    for (int j = 0; j < 4; ++j) { v[j].x -= mean; v[j].y -= mean; v[j].z -= mean; v[j].w -= mean; s2 += (v[j].x * v[j].x + v[j].y * v[j].y) + (v[j].z * v[j].z + v[j].w * v[j].w); }
    const float rstd = 1.f / sqrtf(wave_sum(s2) * (1.f / D) + LN_EPS);
#pragma unroll
    for (int j = 0; j < 4; ++j) { const float4 gg = *(const float4*)(g + 4 * lane + 256 * j), bb = *(const float4*)(bta + 4 * lane + 256 * j);
        v[j].x = v[j].x * rstd * gg.x + bb.x; v[j].y = v[j].y * rstd * gg.y + bb.y; v[j].z = v[j].z * rstd * gg.z + bb.z; v[j].w = v[j].w * rstd * gg.w + bb.w; }
}


__device__ __forceinline__ float dot64_bf16(const unsigned short* kp, const LAS float* qv) {
    float s = 0.f;
#pragma unroll
    for (int c = 0; c < 8; ++c) { const g8::u32x4 kk = *(const g8::u32x4*)(kp + c * 8); const f32x4 q0 = *(const LAS f32x4*)(qv + c * 8), q1 = *(const LAS f32x4*)(qv + c * 8 + 4);
        s += __uint_as_float(kk.x << 16) * q0[0] + __uint_as_float(kk.x & 0xffff0000u) * q0[1] + __uint_as_float(kk.y << 16) * q0[2] + __uint_as_float(kk.y & 0xffff0000u) * q0[3]
           + __uint_as_float(kk.z << 16) * q1[0] + __uint_as_float(kk.z & 0xffff0000u) * q1[1] + __uint_as_float(kk.w << 16) * q1[2] + __uint_as_float(kk.w & 0xffff0000u) * q1[3]; }
    return s;
}
__device__ __forceinline__ unsigned short f2bf(float f) { return (unsigned short)(g8::cvt_pk_bf16(f, 0.f) & 0xffffu); }


namespace attn2 {
using bf16=__hip_bfloat16;
using bf16x8=__attribute__((ext_vector_type(8)))short;
using s16x4=__attribute__((ext_vector_type(4)))short;
using f32x16=__attribute__((ext_vector_type(16)))float;
using u32x4=__attribute__((ext_vector_type(4)))unsigned;
constexpr int SEQ=2048,D=64,PQ=3072,PO=1024;
constexpr int NW=8,QBLK=32,QB=QBLK*NW,KVBLK=64,NQB=SEQ/QB;
__device__ __forceinline__ int crow(int r,int hi){return (r&3)+8*(r>>2)+4*hi;}
#define SBAR() __builtin_amdgcn_sched_barrier(0)
__device__ __forceinline__ void cmask(f32x16&p0,f32x16&p1,int jb,int qrel,int hi){
  const float NEG=-INFINITY; int kb=64*jb+4*hi;
  #pragma unroll
  for(int r=0;r<16;++r){int kv=kb+(r&3)+8*(r>>2); if(kv>qrel)p0[r]=NEG; if(kv+32>qrel)p1[r]=NEG;}
}

constexpr int NSLOT=3, SLOTB=8192;
constexpr int LDS_K=0, LDS_V=NSLOT*SLOTB, LDS_WS=2*NSLOT*SLOTB, LDS_OST=LDS_WS+NW*64*4, LDS_BYTES=LDS_OST+NW*4096;
constexpr float C2=0.125f*1.4426950408889634f;
__device__ __forceinline__ void glds16(const void*gsrc,unsigned lds_dst){unsigned keep;
  asm volatile("s_mov_b32 %0, m0\n\ts_mov_b32 m0, %2\n\ts_nop 0\n\tglobal_load_lds_dwordx4 %1, off\n\ts_mov_b32 m0, %0":"=&s"(keep):"v"(gsrc),"s"(lds_dst):"memory");}
__device__ __forceinline__ float max3f(float a,float b,float c){float r;asm("v_max3_f32 %0, %1, %2, %3":"=v"(r):"v"(a),"v"(b),"v"(c));return r;}
__device__ __forceinline__ float max2f(float a,float b){float r;asm("v_max_f32_e32 %0, %1, %2":"=v"(r):"v"(a),"v"(b));return r;}
__device__ __forceinline__ float fadd_s(float a,float b){float r;asm("v_add_f32_e32 %0, %1, %2":"=v"(r):"v"(a),"v"(b));return r;}
__device__ __forceinline__ float fsub_s(float a,float b){float r;asm("v_sub_f32_e32 %0, %1, %2":"=v"(r):"v"(a),"v"(b));return r;}
typedef float f32x4_t __attribute__((ext_vector_type(4)));
__device__ __forceinline__ float bfs(short h){return __uint_as_float(((unsigned)(unsigned short)h)<<16);}
typedef float f32x2_t __attribute__((ext_vector_type(2))); typedef __bf16 bf16x2_t __attribute__((ext_vector_type(2)));
__device__ __forceinline__ unsigned cvtpk_s(float lo,float hi){f32x2_t v={lo,hi};bf16x2_t b=__builtin_convertvector(v,bf16x2_t);return __builtin_bit_cast(unsigned,b);}
#define WAIT_BAR(N) asm volatile("s_waitcnt vmcnt(" #N ") lgkmcnt(0)\n\ts_barrier":::"memory")

__device__ __forceinline__ void qkt(f32x16&p0,f32x16&p1,const char*Kslot,const bf16x8*qr,int r32,int hi){ const f32x16 negm=f32x16{};
  const char*kb=Kslot+hi*1024+r32*16;
  #pragma unroll
  for(int d0=0;d0<4;++d0){
    const bf16x8 b0=*reinterpret_cast<const bf16x8*>(kb+d0*2048);
    const bf16x8 b1=*reinterpret_cast<const bf16x8*>(kb+d0*2048+512);
    if(d0==0){p0=__builtin_amdgcn_mfma_f32_32x32x16_bf16(b0,qr[0],negm,0,0,0);p1=__builtin_amdgcn_mfma_f32_32x32x16_bf16(b1,qr[0],negm,0,0,0);}
    else{p0=__builtin_amdgcn_mfma_f32_32x32x16_bf16(b0,qr[d0],p0,0,0,0);p1=__builtin_amdgcn_mfma_f32_32x32x16_bf16(b1,qr[d0],p1,0,0,0);}}
}
typedef __attribute__((address_space(3))) const char* lds_cptr;
typedef short v4i16_t __attribute__((ext_vector_type(4)));
__device__ __forceinline__ void kload8(bf16x8*kf,lds_cptr kp){
  kf[0]=*(const __attribute__((address_space(3))) bf16x8*)(kp);      kf[1]=*(const __attribute__((address_space(3))) bf16x8*)(kp+512);
  kf[2]=*(const __attribute__((address_space(3))) bf16x8*)(kp+2048); kf[3]=*(const __attribute__((address_space(3))) bf16x8*)(kp+2560);
  kf[4]=*(const __attribute__((address_space(3))) bf16x8*)(kp+4096); kf[5]=*(const __attribute__((address_space(3))) bf16x8*)(kp+4608);
  kf[6]=*(const __attribute__((address_space(3))) bf16x8*)(kp+6144); kf[7]=*(const __attribute__((address_space(3))) bf16x8*)(kp+6656);
}
__device__ __forceinline__ void kload2(bf16x8*kf,lds_cptr kp,int j){ kf[2*j]=*(const __attribute__((address_space(3))) bf16x8*)(kp+j*2048); kf[2*j+1]=*(const __attribute__((address_space(3))) bf16x8*)(kp+j*2048+512); }
__device__ __forceinline__ s16x4 vtr(lds_cptr p){ return __builtin_bit_cast(s16x4,__builtin_amdgcn_ds_read_tr16_b64_v4i16((__attribute__((address_space(3))) v4i16_t*)p)); }
__device__ __forceinline__ float rowmax(const f32x16&p0,const f32x16&p1){
  float a=max3f(p0[0],p0[1],p1[0]),b=max3f(p0[2],p0[3],p1[1]);a=max3f(a,p1[2],p1[3]);
  #pragma unroll
  for(int r=4;r<16;r+=4){a=max3f(a,p0[r],p0[r+1]);b=max3f(b,p0[r+2],p0[r+3]);a=max3f(a,p1[r],p1[r+1]);b=max3f(b,p1[r+2],p1[r+3]);}
  const float m=max2f(a,b);
  auto rr=__builtin_amdgcn_permlane32_swap(__float_as_uint(m),__float_as_uint(m),false,false);
  return max2f(__uint_as_float(rr[0]),__uint_as_float(rr[1]));
}
__device__ __forceinline__ void pv(f32x16*o,int vb,bf16x8 pa0,bf16x8 pa1,bf16x8 pa2,bf16x8 pa3){
  #pragma unroll
  for(int d0=0;d0<2;++d0){s16x4 lo[4],hi[4];
    #pragma unroll
    for(int ks=0;ks<4;++ks){
      asm volatile("ds_read_b64_tr_b16 %0,%1 offset:%c2":"=&v"(lo[ks]):"v"(vb),"i"(d0*4096+ks*1024):"memory");
      asm volatile("ds_read_b64_tr_b16 %0,%1 offset:%c2":"=&v"(hi[ks]):"v"(vb),"i"(d0*4096+ks*1024+512):"memory");}
    asm volatile("s_waitcnt lgkmcnt(0)":::"memory");SBAR();
    #define PK(k) (bf16x8){lo[k][0],lo[k][1],lo[k][2],lo[k][3],hi[k][0],hi[k][1],hi[k][2],hi[k][3]}
    o[d0]=__builtin_amdgcn_mfma_f32_32x32x16_bf16(pa0,PK(0),o[d0],0,0,0);
    o[d0]=__builtin_amdgcn_mfma_f32_32x32x16_bf16(pa1,PK(1),o[d0],0,0,0);
    o[d0]=__builtin_amdgcn_mfma_f32_32x32x16_bf16(pa2,PK(2),o[d0],0,0,0);
    o[d0]=__builtin_amdgcn_mfma_f32_32x32x16_bf16(pa3,PK(3),o[d0],0,0,0);
    #undef PK
  }
}

#ifndef ATTN_STORE16
#define ATTN_STORE16(p,v) (*(u32x4*)(p)=(v))
#endif
template<int THRL> __device__ __forceinline__ void attn_unit(int b,int qb,const bool MOBA,const bf16*Qp,const bf16*__restrict__ Kp,const bf16*__restrict__ Vp,bf16*Op,const float*kmean_bh,char*shm){
  int tid_=threadIdx.x; asm volatile("":"+v"(tid_));
  const int tid=tid_,lane=tid&63,r32=lane&31,hi=lane>>5; const int wid=__builtin_amdgcn_readfirstlane(tid>>6);
  const long rowbase=(long)b*SEQ; const int q0=qb*QB;
  const bf16*Qw=Qp+(rowbase+q0+wid*QBLK)*PQ;
  const bf16*Kh=Kp+rowbase*PQ,*Vh=Vp+rowbase*PQ;
  const unsigned lds0=(unsigned)(uintptr_t)shm;
  float*wsf=(float*)(shm+LDS_WS)+wid*64;
  const bf16*ksrc=Kh+(long)lane*PQ+wid*8;
  const bf16*vsrc=Vh+(long)(16*(wid&3)+(lane>>2))*PQ+(wid>>2)*32+(lane&3)*8;
  const unsigned kdst=lds0+LDS_K+wid*1024, vdst=lds0+LDS_V+wid*1024;
  #define TILE(t) (((t)<4)?(NT-4+(t)):((t)-4))
  #define DMA_K(t,slot) glds16(ksrc+(long)TILE(t)*KVBLK*PQ,(unsigned)__builtin_amdgcn_readfirstlane(kdst+(slot)))
  #define DMA_V(t,slot) glds16(vsrc+(long)TILE(t)*KVBLK*PQ,(unsigned)__builtin_amdgcn_readfirstlane(vdst+(slot)))
  const int vb0=(int)(lds0+LDS_V)+((lane>>4)&1)*32+(lane&3)*8+(4*hi+((lane&15)>>2))*64;
  const char*Kbase=shm+LDS_K; bf16x8 kf[8];
  const lds_cptr shm3=(lds_cptr)shm; const lds_cptr kp0=shm3+LDS_K+hi*1024+r32*16; const lds_cptr vp0=shm3+LDS_V+((lane>>4)&1)*32+(lane&3)*8+(4*hi+((lane&15)>>2))*64;
  const int NT=(q0+QB)/KVBLK;
  DMA_K(0,0);DMA_V(0,0);DMA_K(1,SLOTB);
  bf16x8 qr[4];
  #pragma unroll
  for(int d0=0;d0<4;++d0)qr[d0]=*reinterpret_cast<const bf16x8*>(&Qw[(long)r32*PQ+d0*16+hi*8]);
  unsigned selmask=0xffu;
  if(MOBA&&qb>=4){ float g[8];
    #pragma unroll
    for(int n=0;n<8;++n){ g[n]=-INFINITY; if(n<qb){ float s=0.f; const float*km=kmean_bh+n*64+hi*8;
        #pragma unroll
        for(int d0=0;d0<4;++d0){ const f32x4_t k0=*reinterpret_cast<const f32x4_t*>(km+d0*16),k1=*reinterpret_cast<const f32x4_t*>(km+d0*16+4); const bf16x8 qq=qr[d0];
          s+=bfs(qq[0])*k0[0]+bfs(qq[1])*k0[1]+bfs(qq[2])*k0[2]+bfs(qq[3])*k0[3]+bfs(qq[4])*k1[0]+bfs(qq[5])*k1[1]+bfs(qq[6])*k1[2]+bfs(qq[7])*k1[3]; }
        auto rr=__builtin_amdgcn_permlane32_swap(__float_as_uint(s),__float_as_uint(s),false,false); g[n]=__uint_as_float(rr[0])+__uint_as_float(rr[1]); } }
    selmask=0u;
    #pragma unroll
    for(int r=0;r<3;++r){ int best=-1; float bv=0.f;
      #pragma unroll
      for(int n=0;n<8;++n) if(n<qb&&!((selmask>>n)&1u)&&(best<0||g[n]>bv)){best=n;bv=g[n];}
      selmask|=1u<<best; } }
  float mhat=0.f,l_reg=0.f;f32x16 o[2];o[0]=f32x16{};o[1]=f32x16{};
  const int qrel=wid*QBLK+r32;
  const int jw=wid>>1;
  #define CMASK_SUB(P0,P1,t,SUB) do{ SUB=mhat; if((t)<4){ if((t)==jw)cmask(P0,P1,(t),qrel,hi); else if((t)>jw)SUB=INFINITY; } \
      else if(MOBA&&qb>=4){ if(!((selmask>>(((t)-4)>>2))&1u))SUB=INFINITY; } }while(0)
  bool resc=false;
  #define START(P0,P1) do{ const float rm=rowmax(P0,P1); resc=false; \
    { const float dl=(__builtin_fabsf(rm)>(float)THRL)?rm:0.f; mhat=dl;     \
      if(__any(dl!=0.f)){ _Pragma("unroll") for(int r=0;r<16;++r){P0[r]=fsub_s(P0[r],dl);P1[r]=fsub_s(P1[r],dl);} } \
    } \
    _Pragma("unroll") for(int r=0;r<16;++r)P0[r]=__builtin_amdgcn_exp2f(P0[r]); }while(0)
  #define RESC() do{ if(resc){ asm volatile("s_waitcnt lgkmcnt(0)":::"memory"); \
      _Pragma("unroll") for(int d_=0;d_<2;++d_) _Pragma("unroll") for(int r=0;r<16;++r)o[d_][r]*=wsf[crow(r,hi)]; } }while(0)
  f32x16 pA0,pA1,pB0,pB1;
  int sl_prev=0,sl_cur=0,sl_next=SLOTB;
  #define ROT() do{sl_prev=sl_cur;sl_cur=sl_next;sl_next=(sl_next==(NSLOT-1)*SLOTB)?0:sl_next+SLOTB;}while(0)
  DMA_K(2,2*SLOTB);
  WAIT_BAR(3);
  qkt(pA0,pA1,Kbase,qr,r32,hi);asm volatile("s_nop 15\n\ts_nop 7":"+v"(pA0),"+v"(pA1));if(jw==0)cmask(pA0,pA1,0,qrel,hi);
  START(pA0,pA1);
  _Pragma("unroll") for(int r=0;r<16;++r)pA1[r]=__builtin_amdgcn_exp2f(pA1[r]);
  WAIT_BAR(0);
  DMA_K(3,0);DMA_V(1,SLOTB);
  ROT();
  kload8(kf,kp0+sl_cur);
  WAIT_BAR(2);
  s16x4 vlo[8],vhi[8]; u32x4 pw0,pw1,pw2,pw3;
  #define PKW(P,B) cvtpk_s(P[B],P[B+1])
  #define PAF(k) __builtin_bit_cast(bf16x8,pw##k)
  #define VFR(i) (bf16x8){vlo[i][0],vlo[i][1],vlo[i][2],vlo[i][3],vhi[i][0],vhi[i][1],vhi[i][2],vhi[i][3]}
  #define PIN(x) asm volatile("":"+v"(x))
  #define MX3(a,b,c) __builtin_fmaxf(__builtin_fmaxf((a),(b)),(c))
  #define GAPA(MF,A0,A1,A2,A3,W0,W1,PW) do{ MF; sacc+=A0; sacc+=A1; sacc+=A2; sacc+=A3; PIN(sacc); W0; W1; PIN(PW); SBAR(); }while(0)
  #define EX(v) __builtin_amdgcn_exp2f(v)
  #define GAPB(MF,X,B) do{ MF; X[B]=EX(X[B]); X[B+1]=EX(X[B+1]); X[B+2]=EX(X[B+2]); X[B+3]=EX(X[B+3]); PIN(X); SBAR(); }while(0)
  #define VRD(i) do{ vlo[i]=vtr(vp_+(((i)>>2)*4096+((i)&3)*1024)); vhi[i]=vtr(vp_+(((i)>>2)*4096+((i)&3)*1024+512)); }while(0)
  #define KRD(G,j) do{ if(G){ kload2(kf,kp0+sl_next,j); SBAR(); } }while(0)
  #define STEP(C0,C1,P0,P1,t,GK,GV,GL) do{ SBAR(); \
    const lds_cptr vp_=vp0+sl_prev; \
    VRD(0); SBAR(); float sacc=(P0[0]+P0[1]); \
    GAPA(C0=__builtin_amdgcn_mfma_f32_32x32x16_bf16(kf[0],qr[0],f32x16{},0,0,0), P0[2],P0[3],P0[4],P0[5],     pw0[0]=PKW(P0,0), pw0[1]=PKW(P0,2), pw0); \
    VRD(4); SBAR(); GAPA(C1=__builtin_amdgcn_mfma_f32_32x32x16_bf16(kf[1],qr[0],f32x16{},0,0,0), P0[6],P0[7],P0[8],P0[9],     pw0[2]=PKW(P0,4), pw0[3]=PKW(P0,6), pw0); \
    VRD(1); SBAR(); GAPA(C0=__builtin_amdgcn_mfma_f32_32x32x16_bf16(kf[2],qr[1],C0,0,0,0),   P0[10],P0[11],P0[12],P0[13], pw1[0]=PKW(P0,8), pw1[1]=PKW(P0,10), pw1); \
    VRD(5); SBAR(); GAPA(C1=__builtin_amdgcn_mfma_f32_32x32x16_bf16(kf[3],qr[1],C1,0,0,0),   P0[14],P0[15],P1[0],P1[1],   pw1[2]=PKW(P0,12),pw1[3]=PKW(P0,14), pw1); \
    VRD(2); SBAR(); GAPA(C0=__builtin_amdgcn_mfma_f32_32x32x16_bf16(kf[4],qr[2],C0,0,0,0),   P1[2],P1[3],P1[4],P1[5],     pw2[0]=PKW(P1,0), pw2[1]=PKW(P1,2), pw2); \
    VRD(6); SBAR(); GAPA(C1=__builtin_amdgcn_mfma_f32_32x32x16_bf16(kf[5],qr[2],C1,0,0,0),   P1[6],P1[7],P1[8],P1[9],     pw2[2]=PKW(P1,4), pw2[3]=PKW(P1,6), pw2); \
    VRD(3); SBAR(); GAPA(C0=__builtin_amdgcn_mfma_f32_32x32x16_bf16(kf[6],qr[3],C0,0,0,0),   P1[10],P1[11],P1[12],P1[13], pw3[0]=PKW(P1,8), pw3[1]=PKW(P1,10), pw3); \
    VRD(7); SBAR(); GAPA(C1=__builtin_amdgcn_mfma_f32_32x32x16_bf16(kf[7],qr[3],C1,0,0,0),   P1[14],P1[15],0.f,0.f,       pw3[2]=PKW(P1,12),pw3[3]=PKW(P1,14), pw3); \
    l_reg+=sacc; \
    if(GK){DMA_K((t)+3,sl_cur);} if(GV){DMA_V((t)+1,sl_next);} \
    { float sub_; CMASK_SUB(C0,C1,t,sub_); \
    if(__any(sub_!=0.f)){ _Pragma("unroll") for(int r=0;r<16;++r){C0[r]=fsub_s(C0[r],sub_);C1[r]=fsub_s(C1[r],sub_);} } }   \
    { float a=MX3(C0[0],C0[1],C1[0]),b=MX3(C0[2],C0[3],C1[1]); a=MX3(a,C1[2],C1[3]); \
      _Pragma("unroll") for(int r=4;r<16;r+=4){a=MX3(a,C0[r],C0[r+1]);b=MX3(b,C0[r+2],C0[r+3]);a=MX3(a,C1[r],C1[r+1]);b=MX3(b,C1[r+2],C1[r+3]);} \
      float rm=__builtin_fmaxf(a,b); { auto rr=__builtin_amdgcn_permlane32_swap(__float_as_uint(rm),__float_as_uint(rm),false,false); rm=__builtin_fmaxf(__uint_as_float(rr[0]),__uint_as_float(rr[1])); } \
      resc=false; \
      if(__builtin_expect(__any(rm>(float)THRL),0)){ const float dl=__builtin_fmaxf(rm,0.f); mhat+=dl; \
        _Pragma("unroll") for(int r=0;r<16;++r){C0[r]-=dl;C1[r]-=dl;} \
        const float f=__builtin_amdgcn_exp2f(-dl); l_reg*=f; if(hi==0)wsf[r32]=f; resc=true; } } \
    SBAR(); \
    GAPB(o[0]=__builtin_amdgcn_mfma_f32_32x32x16_bf16(PAF(0),VFR(0),o[0],0,0,0), C0,0); \
    GAPB(o[1]=__builtin_amdgcn_mfma_f32_32x32x16_bf16(PAF(0),VFR(4),o[1],0,0,0), C0,4); \
    KRD(GL,0); GAPB(o[0]=__builtin_amdgcn_mfma_f32_32x32x16_bf16(PAF(1),VFR(1),o[0],0,0,0), C0,8); \
    KRD(GL,1); GAPB(o[1]=__builtin_amdgcn_mfma_f32_32x32x16_bf16(PAF(1),VFR(5),o[1],0,0,0), C0,12); \
    KRD(GL,2); GAPB(o[0]=__builtin_amdgcn_mfma_f32_32x32x16_bf16(PAF(2),VFR(2),o[0],0,0,0), C1,0); \
    KRD(GL,3); GAPB(o[1]=__builtin_amdgcn_mfma_f32_32x32x16_bf16(PAF(2),VFR(6),o[1],0,0,0), C1,4); \
    GAPB(o[0]=__builtin_amdgcn_mfma_f32_32x32x16_bf16(PAF(3),VFR(3),o[0],0,0,0), C1,8); \
    GAPB(o[1]=__builtin_amdgcn_mfma_f32_32x32x16_bf16(PAF(3),VFR(7),o[1],0,0,0), C1,12); \
    }while(0)
  int t=1;
  for(;t+5<NT;t+=2){
    STEP(pB0,pB1,pA0,pA1,t,true,true,true);     WAIT_BAR(2); RESC(); ROT();
    STEP(pA0,pA1,pB0,pB1,t+1,true,true,true);   WAIT_BAR(2); RESC(); ROT();
  }
  #define ENDW(tt) do{ if((tt)+3<NT){WAIT_BAR(2);} else if((tt)+2<NT){WAIT_BAR(1);} else {WAIT_BAR(0);} }while(0)
  for(;t+1<NT;t+=2){
    STEP(pB0,pB1,pA0,pA1,t,(t+3<NT),(t+1<NT),(t+1<NT));       ENDW(t);   RESC(); ROT();
    STEP(pA0,pA1,pB0,pB1,t+1,(t+4<NT),(t+2<NT),(t+2<NT));     ENDW(t+1); RESC(); ROT();
  }
  STEP(pB0,pB1,pA0,pA1,NT-1,false,false,false); RESC();
  { float sacc=pB0[0]+pB0[1]; _Pragma("unroll") for(int r=2;r<16;++r)sacc+=pB0[r]; _Pragma("unroll") for(int r=0;r<16;++r)sacc+=pB1[r]; l_reg+=sacc;
    pw0=(u32x4){PKW(pB0,0),PKW(pB0,2),PKW(pB0,4),PKW(pB0,6)};pw1=(u32x4){PKW(pB0,8),PKW(pB0,10),PKW(pB0,12),PKW(pB0,14)};pw2=(u32x4){PKW(pB1,0),PKW(pB1,2),PKW(pB1,4),PKW(pB1,6)};pw3=(u32x4){PKW(pB1,8),PKW(pB1,10),PKW(pB1,12),PKW(pB1,14)};
    SBAR(); pv(o,vb0+sl_cur,PAF(0),PAF(1),PAF(2),PAF(3)); }
  #undef PKW
  #undef PAF
  #undef VFR
  #undef PIN
  #undef MX3
  #undef GAPA
  #undef GAPB
  #undef EX
  #undef VRD
  #undef KRD
  #undef STEP
  #undef ENDW
  {auto rr=__builtin_amdgcn_permlane32_swap(__float_as_uint(l_reg),__float_as_uint(l_reg),false,false);l_reg=__uint_as_float(rr[0])+__uint_as_float(rr[1]);}
  if(hi==0)wsf[32+r32]=l_reg;asm volatile("s_waitcnt lgkmcnt(0)":::"memory");
  float rli[16];
  #pragma unroll
  for(int r=0;r<16;++r)rli[r]=__builtin_amdgcn_rcpf(wsf[32+crow(r,hi)]);
  bf16*Ow=Op+(rowbase+q0+wid*QBLK)*PO;
  { bf16*stg=(bf16*)(shm+LDS_OST)+wid*2048;
    #pragma unroll
    for(int r=0;r<16;++r){const int orow=crow(r,hi);
      #pragma unroll
      for(int d0=0;d0<2;++d0)stg[orow*64+d0*32+r32]=__float2bfloat16(o[d0][r]*rli[r]);}
    asm volatile("s_waitcnt lgkmcnt(0)":::"memory");
    #pragma unroll
    for(int i=0;i<4;++i){const int row=i*8+(lane>>3),ch=lane&7; const u32x4 v=*(const u32x4*)(stg+row*64+ch*8); ATTN_STORE16(Ow+(long)row*PO+ch*8,v);} }
  asm volatile("s_waitcnt lgkmcnt(0)\n\ts_barrier":::"memory");
  #undef DMA_K
  #undef TILE
  #undef DMA_V
  #undef CMASK_SUB
  #undef START
  #undef RESC
  #undef ROT
}
constexpr int ATTN_LDS_BYTES=LDS_BYTES;
#undef SBAR
#undef WAIT_BAR
}
__device__ __forceinline__ void attn_phase(char* lds, const unsigned short* projb_, unsigned short* tmpb_, unsigned short* mixb_, const float* kmean, int G, int blk,
                                           const float* lq1, const float* lk1, const float* lq2, const float* lk2, const float* subln_g) {
    using attn2::bf16;
    const bf16* projb = (const bf16*)projb_; bf16* tmpb = (bf16*)tmpb_; bf16* mixb = (bf16*)mixb_;
    const int vcu = (G % 8 == 0) ? (blk % 8) * (G / 8) + blk / 8 : blk;
    for (int it = vcu; it < 1536; it += G) {
        const bool moba = it >= 512; const int q = moba ? it - 512 : it;
        const int s = q & 3, h = moba ? (q >> 2) & 7 : (q >> 2) & 3, b = moba ? q >> 5 : q >> 4, nun = moba ? 2 : 8;
        const float* km = kmean + (size_t)((b * 8 + (moba ? h : 0)) * 8) * 64;
        for (int k = 0; k < nun; ++k) {
            const int u = moba ? k : k >> 2, cv = k & 3, c = cv >> 1, vh = cv & 1, qb = u ? s : 7 - s;
            const int qcol = moba ? 1536 + h * 64 : h * 128 + c * 64, kcol = moba ? 2048 + h * 64 : 512 + h * 128 + c * 64, vcol = moba ? 2560 + h * 64 : 1024 + h * 128 + vh * 64;
            bf16* op = moba ? mixb + 512 + h * 64 : tmpb + (h * 2 + c) * 128 + vh * 64;
            attn2::attn_unit<8>(b, qb, moba, projb + qcol, projb + kcol, projb + vcol, op, km, lds);
            if (!moba && cv == 3) {
                asm volatile("s_waitcnt vmcnt(0)" ::: "memory"); __syncthreads();
                const int lane = threadIdx.x & 63, wave = threadIdx.x >> 6, tk = lane >> 4, sg = lane & 15;
                float lam; { const float a = wave_sum(lq1[lane] * lk1[lane]), b2 = wave_sum(lq2[lane] * lk2[lane]); lam = expf(a) - expf(b2) + 0.2f; }
                float gg[8];
#pragma unroll
                for (int i = 0; i < 8; ++i) gg[i] = subln_g[sg * 8 + i] * 0.8f;
                const unsigned short* tb = tmpb_; unsigned short* mb = mixb_;
#pragma unroll 2
                for (int r0 = wave * 4; r0 < 256; r0 += 32) { const size_t r = (size_t)b * SEQ + qb * 256 + r0 + tk;
                    const unsigned* p1 = (const unsigned*)(tb + r * D + (h * 2) * 128 + sg * 8); const unsigned* p2 = (const unsigned*)(tb + r * D + (h * 2 + 1) * 128 + sg * 8);
                    unsigned u1[4], u2[4];
#pragma unroll
                    for (int i = 0; i < 4; ++i) { u1[i] = __hip_atomic_load(p1 + i, __ATOMIC_RELAXED, __HIP_MEMORY_SCOPE_AGENT); u2[i] = __hip_atomic_load(p2 + i, __ATOMIC_RELAXED, __HIP_MEMORY_SCOPE_AGENT); }
                    float a[8];
#pragma unroll
                    for (int i = 0; i < 4; ++i) { a[2 * i] = __uint_as_float(u1[i] << 16) - lam * __uint_as_float(u2[i] << 16); a[2 * i + 1] = __uint_as_float(u1[i] & 0xffff0000u) - lam * __uint_as_float(u2[i] & 0xffff0000u); }
                    float ss = 0.f;
#pragma unroll
                    for (int i = 0; i < 8; ++i) ss += a[i] * a[i];
                    ss += __shfl_xor(ss, 1); ss += __shfl_xor(ss, 2); ss += __shfl_xor(ss, 4); ss += __shfl_xor(ss, 8);
                    const float rr = 1.0f / sqrtf(ss * (1.0f / 128.0f) + 1e-5f);
                    g8::u32x4 o;
#pragma unroll
                    for (int i = 0; i < 4; ++i) o[i] = g8::cvt_pk_bf16(a[2 * i] * rr * gg[2 * i], a[2 * i + 1] * rr * gg[2 * i + 1]);
                    *(g8::u32x4*)(mb + r * D + h * 128 + sg * 8) = o; }
            }
        }
    }
}

struct Args { const float* in[26]; float* out; unsigned char* ws; int ph_lo, ph_hi; };
constexpr int LDS_BYTES = 163840, MISC_OFF = 144 * 1024 - 256, XS_OFF = 131072, GOFF_OFF = 140 * 1024, STG_OFF = 147456;
constexpr int NPH = 14;

__global__ void __launch_bounds__(NTHR, 2) fwd(Args args) {
    extern __shared__ __attribute__((aligned(16))) unsigned char lds_arr[];
    LAS unsigned char* lds = (LAS unsigned char*)lds_arr;
    volatile LAS unsigned* MISC = (volatile LAS unsigned*)(lds + MISC_OFF);
#define PH_VARS const int tid = threadIdx.x, lane = tid & 63, wave = __builtin_amdgcn_readfirstlane(tid >> 6); \
    const int gw = blockIdx.x * NWAVES + wave, NGW = gridDim.x * NWAVES; const int gt = blockIdx.x * NTHR + tid, NGT = gridDim.x * NTHR; (void)lane; (void)gw; (void)NGW; (void)gt; (void)NGT;
#define PTRS \
    unsigned char* ws = (unsigned char*)KA->ws; \
    unsigned* ctl = (unsigned*)(ws + WS_CTL); \
    const float* x = (const float*)KA->in[0]; const float* mem = (const float*)KA->in[1]; const float* w_in = (const float*)KA->in[2]; \
    const float* lq1 = (const float*)KA->in[3]; const float* lk1 = (const float*)KA->in[4]; const float* lq2 = (const float*)KA->in[5]; const float* lk2 = (const float*)KA->in[6]; \
    const float* subln_g = (const float*)KA->in[7]; const float* w_out = (const float*)KA->in[8]; const float* ln1_g = (const float*)KA->in[9]; const float* ln1_b = (const float*)KA->in[10]; \
    const float* mem_g = (const float*)KA->in[11]; const float* mem_b = (const float*)KA->in[12]; const float* w_q = (const float*)KA->in[13]; const float* w_kv = (const float*)KA->in[14]; \
    const float* w_o = (const float*)KA->in[15]; const float* ln2_g = (const float*)KA->in[16]; const float* ln2_b = (const float*)KA->in[17]; const float* w_router = (const float*)KA->in[18]; \
    const float* b_router = (const float*)KA->in[19]; const float* w_mlp1 = (const float*)KA->in[20]; const float* b_mlp1 = (const float*)KA->in[21]; const float* w_mlp2 = (const float*)KA->in[22]; \
    const float* b_mlp2 = (const float*)KA->in[23]; const float* ln3_g = (const float*)KA->in[24]; const float* ln3_b = (const float*)KA->in[25]; \
    float* out = (float*)KA->out; \
    float* ropec = (float*)(ws + WS_ROPE); float* ropes = ropec + SEQ * 8; \
    float* kmean = (float*)(ws + WS_KMEAN); \
    int* topi = (int*)(ws + WS_TOPI); float* topw = (float*)(ws + WS_TOPW); int* list = (int*)(ws + WS_LIST); float* wpos = (float*)(ws + WS_WPOS); int* posof = (int*)(ws + WS_POSOF); \
    bf* wint = (bf*)(ws + WS_WINT); bf* woutt = (bf*)(ws + WS_WOUTT); bf* wqb = (bf*)(ws + WS_WQB); bf* wkvt = (bf*)(ws + WS_WKVT); bf* wot = (bf*)(ws + WS_WOT); bf* w1t = (bf*)(ws + WS_W1T); bf* w2t = (bf*)(ws + WS_W2T); \
    bf* xb = (bf*)(ws + WS_XB); bf* projb = (bf*)(ws + WS_PROJ); bf* memn = (bf*)(ws + WS_MEMN); bf* kvmb = (bf*)(ws + WS_KVM); bf* gtb = (bf*)(ws + WS_GT); bf* vwtb = (bf*)(ws + WS_VWT); \
    bf* h1b = (bf*)(ws + WS_H1B); bf* t2b = (bf*)(ws + WS_OUT2); bf* pb = (bf*)(ws + WS_P); bf* h2b = (bf*)(ws + WS_H2B); \
    bf* mixb = (bf*)out + (size_t)T * D; \
    float* t2 = out; long long* lnst = (long long*)(ws + WS_LNZ); long long* gcs = (long long*)(ws + WS_LNZ + 1024 * 1024); long long* gbf = (long long*)(ws + WS_LNZ + 1280 * 1024); bf* hidb = (bf*)out; signed char* w1q = (signed char*)(ws + WS_W1T); unsigned char* w2q = (unsigned char*)(ws + WS_W2T); unsigned char* hid8 = (unsigned char*)out; signed char* h2q = (signed char*)(ws + WS_H2Q); float* sa = (float*)(ws + WS_SA); float* sbw = (float*)(ws + WS_SB); float* sapos = (float*)(ws + WS_SAPOS); float* sxr = (float*)(ws + WS_SX); float* swin = (float*)(ws + WS_SWIN); signed char* xq = (signed char*)(ws + WS_XB); \
    unsigned* cnt = ctl + CW_CNT; unsigned* fill = ctl + CW_FILL; \
    const int G = (int)gridDim.x, cB = (int)blockIdx.x; (void)ctl; (void)cnt; (void)fill; (void)G; (void)cB;
    typedef unsigned short bf;
    const volatile __attribute__((address_space(4))) Args* const KA = (const volatile __attribute__((address_space(4))) Args*)__builtin_amdgcn_kernarg_segment_ptr();
    unsigned* const ctl0 = (unsigned*)((unsigned char*)KA->ws + WS_CTL);
    if (threadIdx.x < 64) MISC[threadIdx.x] = 0u;
    __syncthreads();
    const int lo = KA->ph_lo, hi = KA->ph_hi;
    XcdBarrier bar; bar.bar = ctl0 + CW_BAR; bar.x = 0; bar.st = MISC + 8;
    if (hi - lo > 1) bar = xcd_barrier_post(ctl0 + CW_BAR, MISC + 8);
#define OPQ(x) ({ int _v = (x); asm volatile("" : "+s"(_v)); _v; })
#define IN(k) (OPQ(lo) <= (k) && (k) < OPQ(hi))
#define SEAM(k) do { if (IN(k) && IN((k) + 1)) xcd_barrier(bar); } while (0)

    if (IN(0)) {
        PH_VARS
        PTRS
        for (int i = gt; i < SEQ * 8; i += NGT) { double s, c; sincos_d((double)(i >> 3) * INV_FREQ[i & 7], s, c); ropec[i] = (float)c; ropes[i] = (float)s; }
        for (int r = gw; r < TM; r += NGW) { float4 v[4];
#pragma unroll
            for (int j = 0; j < 4; ++j) v[j] = *(const float4*)(mem + (size_t)r * D + 4 * lane + 256 * j);
            ln_wave(v, mem_g, mem_b, lane);
#pragma unroll
            for (int j = 0; j < 4; ++j) { g8::u32x2 w; w.x = g8::cvt_pk_bf16(v[j].x, v[j].y); w.y = g8::cvt_pk_bf16(v[j].z, v[j].w); *(g8::u32x2*)(memn + (size_t)r * D + 4 * lane + 256 * j) = w; } }
        for (int r = gw; r < T; r += NGW) { float4 v[4];
#pragma unroll
            for (int j = 0; j < 4; ++j) v[j] = ldnt4(x + (size_t)r * D + 4 * lane + 256 * j);
            float am = 0.f;
#pragma unroll
            for (int j = 0; j < 4; ++j) am = fmaxf(am, fmaxf(fmaxf(fabsf(v[j].x), fabsf(v[j].y)), fmaxf(fabsf(v[j].z), fabsf(v[j].w))));
            am = fmaxf(wave_max(am), 1e-30f); const float iv = 127.0f / am; if (lane == 0) sxr[r] = am * (1.0f / 127.0f);
#pragma unroll
            for (int j = 0; j < 4; ++j) { const unsigned q = ((unsigned)(int)rintf(v[j].x * iv) & 0xffu) | (((unsigned)(int)rintf(v[j].y * iv) & 0xffu) << 8) | (((unsigned)(int)rintf(v[j].z * iv) & 0xffu) << 16) | (((unsigned)(int)rintf(v[j].w * iv) & 0xffu) << 24);
                *(unsigned*)(xq + (size_t)r * D + 4 * lane + 256 * j) = q; } }
        for (size_t i = (size_t)gt; i < (size_t)D * D / 8; i += (size_t)NGT) { const float* src = w_q + i * 8; bf* dst = wqb + i * 8;
            const float4 a = *(const float4*)src, b = *(const float4*)(src + 4);
            g8::u32x4 w; w.x = g8::cvt_pk_bf16(a.x, a.y); w.y = g8::cvt_pk_bf16(a.z, a.w); w.z = g8::cvt_pk_bf16(b.x, b.y); w.w = g8::cvt_pk_bf16(b.z, b.w); *(g8::u32x4*)dst = w; }
        LAS float* scr = (LAS float*)lds + wave * (64 * 33);
        constexpr int I_IN = NPROJ / 32  , I_SQ = (D / 64) * (D / 32), I_KV = (D / 64) * (2 * D / 32), I2 = (DFF / 64) * (D / 32);
        constexpr int I1Q = 2 * DFF / 32;
        constexpr int NIT = I_SQ + I_KV + I_SQ + NEXP * I2;
        for (int it = gw; it < NIT; it += NGW) { int r = it;
            const float* W; unsigned short* WT; int K_, N_, q; bool quant = false, f8 = false, quant_in = false; int qe = 0;
            if (r < I_SQ) { W = w_out; WT = woutt; K_ = D; N_ = D; q = r; }
            else if ((r -= I_SQ) < I_KV) { W = w_kv; WT = wkvt; K_ = D; N_ = 2 * D; q = r; }
            else if ((r -= I_KV) < I_SQ) { W = w_o; WT = wot; K_ = D; N_ = D; q = r; }
            else { r -= I_SQ; qe = r / I2; q = r - qe * I2; W = w_mlp2 + (size_t)qe * DFF * D; WT = nullptr; K_ = DFF; N_ = D; f8 = true; }
            (void)quant; (void)quant_in;
            if (f8) transpose_item_f8(W, K_, N_, w2q + (size_t)qe * D * DFF, g8::W2_SCALE, scr, q, lane);
            else transpose_item(W, K_, N_, WT, scr, q, lane); }
        __syncthreads();
        { lfloat* stage = (lfloat*)lds; lfloat* red = stage + 1024 * 33;
          for (int it = blockIdx.x; it < I_IN + NEXP * I1Q; it += gridDim.x) {
              if (it < I_IN) quant_w1_block(w_in, NPROJ, (signed char*)wint, swin, stage, red, it, tid);
              else { const int r = it - I_IN, qe = r / I1Q, q = r - qe * I1Q; quant_w1_block(w_mlp1 + (size_t)qe * D * 2 * DFF, 2 * DFF, w1q + (size_t)qe * 2 * DFF * D, sbw + (size_t)qe * 2 * DFF, stage, red, q, tid); } } }
    }
    SEAM(0);
    if (IN(1)) {
        PTRS
        { g8::DenseOrder S; S.init(T, NPROJ, D / 2, G, cB); g8::EpiProj E{projb, ropec, ropes, lds + STG_OFF, sxr, swin, lds + XS_OFF}; int kq = D / 2; asm volatile("" : "+s"(kq)); g8::gemm_phase<g8::EpiProj, g8::DenseOrder, false>(lds, (const bf*)xq, D / 2, (const bf*)wint, D / 2, kq, nullptr, S, E); }
        { g8::DenseOrder S; S.init(TM, 2 * D, D, G, cB); g8::EpiPlainB E{kvmb, 2 * D, lds + STG_OFF}; g8::gemm_phase<g8::EpiPlainB, g8::DenseOrder, false>(lds, memn, D, wkvt, D, D, nullptr, S, E); }
    }
    SEAM(1);
    if (IN(2)) {
        PH_VARS
        PTRS
        int k256 = 256; asm volatile("" : "+s"(k256));
        { g8::GtOrder S{G, cB}; g8::EpiGT E{gtb, ln1_g, ln1_b, gcs, gbf, lds + STG_OFF}; g8::gemm_phase<g8::EpiGT, g8::GtOrder, false>(lds, kvmb, 2 * D, wqb, D, k256, nullptr, S, E); }
        { g8::VwtOrder S{G, cB}; g8::EpiPlainB E{vwtb, D, lds + STG_OFF}; g8::gemm_phase<g8::EpiPlainB, g8::VwtOrder, false>(lds, wot, D, kvmb, 2 * D, k256, nullptr, S, E); }
        for (int it = gw; it < BATCH * 8 * 8; it += NGW) { const int n = it & 7, h = (it >> 3) & 7, b = it >> 6;
            const bf* kp = projb + ((size_t)b * SEQ + n * 256) * NPROJ + 2048 + h * 64 + lane; float s = 0.f;
            for (int j = 0; j < 256; ++j) s += bf2f(kp[(size_t)j * NPROJ]);
            kmean[((b * 8 + h) * 8 + n) * 64 + lane] = s * (1.0f / 256.0f); }
    }
    SEAM(2);
    if (IN(3)) { PTRS attn_phase((char*)lds_arr, projb, (bf*)out, mixb, kmean, G, cB, lq1, lk1, lq2, lk2, subln_g); }
    if (IN(3) && IN(5)) xcd_barrier(bar);
    if (IN(5)) { PTRS g8::DenseOrder S; S.init(T, D, D, G, cB); g8::EpiResidStats E{h1b, x, lnst, ALPHA}; g8::gemm_phase<g8::EpiResidStats, g8::DenseOrder, false>(lds, mixb, D, woutt, D, D, nullptr, S, E); }
    if (IN(5) && IN(7)) xcd_barrier(bar);
    if (IN(7)) { PTRS g8::BatchOrder S; S.init(T, D, D, G, cB); S.bbatch_rows = D; g8::EpiSoftmaxP E{pb, lds + XS_OFF, lds + STG_OFF, lnst, gcs, gbf}; g8::gemm_phase<g8::EpiSoftmaxP, g8::BatchOrder, false>(lds, h1b, D, gtb, D, D, nullptr, S, E); }
    SEAM(7);
    if (IN(8)) { PTRS g8::BatchOrder S; S.init(T, D, D, G, cB); S.bbatch_rows = D; g8::EpiPlainB E{t2b, D, lds + STG_OFF}; g8::gemm_phase<g8::EpiPlainB, g8::BatchOrder, false>(lds, pb, D, vwtb, D, D, nullptr, S, E); }
    SEAM(8);
    if (IN(9)) {
        PH_VARS
        PTRS
        lfloat* xs = (lfloat*)lds; lfloat* red = (lfloat*)(lds + 32 * 1028 * 4); LAS int* chist = (LAS int*)(lds + 32 * 1028 * 4 + 2 * 32 * 33 * 4);
        if (tid < NEXP) chist[tid] = 0;
        __syncthreads();
        const int rh = wave & 1, eh = (wave >> 1) & 1, kh = wave >> 2, li = lane & 15, hq = lane >> 4;
        float Bw[128];
        { const float* wp = w_router + (size_t)(512 * kh + 128 * hq) * NEXP + 16 * eh + li;
#pragma unroll
          for (int s2 = 0; s2 < 128; ++s2) Bw[s2] = wp[(size_t)s2 * NEXP]; }
        for (int rb = blockIdx.x; rb < T / 32; rb += gridDim.x) {
#pragma unroll 1
            for (int rp = 0; rp < 4; rp += 2) {
            g8::u32x2 pin[2][4], pc[2][4]; float s1[2], s2[2];
#pragma unroll
            for (int rr = 0; rr < 2; ++rr) { const size_t r = (size_t)rb * 32 + 4 * wave + rp + rr;
                const long long* sp = lnst + 2 * r; asm volatile("" : "+v"(sp));
                s1[rr] = fx_get(sp); s2[rr] = fx_get(sp + 1);
#pragma unroll
                for (int j = 0; j < 4; ++j) { pin[rr][j] = *(const g8::u32x2*)(h1b + r * D + 4 * lane + 256 * j); pc[rr][j] = *(const g8::u32x2*)(t2b + r * D + 4 * lane + 256 * j); } }
#pragma unroll
            for (int rr = 0; rr < 2; ++rr) asm volatile("" : "+v"(pin[rr][0]), "+v"(pin[rr][1]), "+v"(pin[rr][2]), "+v"(pin[rr][3]), "+v"(pc[rr][0]), "+v"(pc[rr][1]), "+v"(pc[rr][2]), "+v"(pc[rr][3]), "+v"(s1[rr]), "+v"(s2[rr]));
#pragma unroll
            for (int rr = 0; rr < 2; ++rr) { const int row = 4 * wave + rp + rr; const size_t r = (size_t)rb * 32 + row; float4 v[4];
                const float mean1 = s1[rr] * (1.0f / 1024.0f), rstd1 = 1.0f / sqrtf(fmaxf(s2[rr] * (1.0f / 1024.0f) - mean1 * mean1, 0.f) + LN_EPS);
#pragma unroll
                for (int j = 0; j < 4; ++j) { const g8::u32x2 p = pin[rr][j], c = pc[rr][j]; const float4 gg = *(const float4*)(ln1_g + 4 * lane + 256 * j), bb = *(const float4*)(ln1_b + 4 * lane + 256 * j);
                    v[j].x = ((__uint_as_float(p.x << 16) - mean1) * rstd1 * gg.x + bb.x) * ALPHA + __uint_as_float(c.x << 16);
                    v[j].y = ((__uint_as_float(p.x & 0xffff0000u) - mean1) * rstd1 * gg.y + bb.y) * ALPHA + __uint_as_float(c.x & 0xffff0000u);
                    v[j].z = ((__uint_as_float(p.y << 16) - mean1) * rstd1 * gg.z + bb.z) * ALPHA + __uint_as_float(c.y << 16);
                    v[j].w = ((__uint_as_float(p.y & 0xffff0000u) - mean1) * rstd1 * gg.w + bb.w) * ALPHA + __uint_as_float(c.y & 0xffff0000u); }
                ln_wave(v, ln2_g, ln2_b, lane);
#pragma unroll
                for (int j = 0; j < 4; ++j) { g8::u32x2 w; w.x = g8::cvt_pk_bf16(v[j].x, v[j].y); w.y = g8::cvt_pk_bf16(v[j].z, v[j].w); *(g8::u32x2*)(h2b + r * D + 4 * lane + 256 * j) = w;
                    *(LAS f32x4*)&xs[row * 1028 + 4 * lane + 256 * j] = (f32x4){v[j].x, v[j].y, v[j].z, v[j].w}; }
                { float am = 0.f;
#pragma unroll
                  for (int j = 0; j < 4; ++j) am = fmaxf(am, fmaxf(fmaxf(fabsf(v[j].x), fabsf(v[j].y)), fmaxf(fabsf(v[j].z), fabsf(v[j].w))));
                  am = fmaxf(wave_max(am), 1e-30f); const float iv = 127.0f / am; if (lane == 0) sa[r] = am * (1.0f / 127.0f);
#pragma unroll
                  for (int j = 0; j < 4; ++j) { const unsigned q = ((unsigned)(int)rintf(v[j].x * iv) & 0xffu) | (((unsigned)(int)rintf(v[j].y * iv) & 0xffu) << 8) | (((unsigned)(int)rintf(v[j].z * iv) & 0xffu) << 16) | (((unsigned)(int)rintf(v[j].w * iv) & 0xffu) << 24);
                      *(unsigned*)(h2q + r * D + 4 * lane + 256 * j) = q; } } }
            }
            __syncthreads();
            f32x4 acc = {0.f, 0.f, 0.f, 0.f};
            { const lfloat* xp = xs + (16 * rh + li) * 1028 + 512 * kh + 128 * hq;
#pragma unroll
              for (int s4 = 0; s4 < 32; ++s4) { const f32x4 a4 = *(const LAS f32x4*)(xp + 4 * s4);
#pragma unroll
                  for (int u = 0; u < 4; ++u) acc = __builtin_amdgcn_mfma_f32_16x16x4f32(a4[u], Bw[4 * s4 + u], acc, 0, 0, 0); } }
#pragma unroll
            for (int q = 0; q < 4; ++q) red[(kh * 32 + 16 * rh + 4 * hq + q) * 33 + 16 * eh + li] = acc[q];
            __syncthreads();
            if (wave == 0 && lane < 32) { const size_t r = (size_t)rb * 32 + lane; float l32[NEXP];
#pragma unroll
                for (int e = 0; e < NEXP; ++e) l32[e] = red[lane * 33 + e] + red[(32 + lane) * 33 + e] + b_router[e];
                int bi[4]; float bv[4]; unsigned used = 0u;
#pragma unroll
                for (int k = 0; k < 4; ++k) { int best = -1; float bval = 0.f;
#pragma unroll
                    for (int e = 0; e < NEXP; ++e) if (!((used >> e) & 1u) && (best < 0 || l32[e] > bval)) { best = e; bval = l32[e]; }
                    used |= 1u << best; bi[k] = best; bv[k] = bval; }
                const float e0 = 1.0f, e1 = expf(bv[1] - bv[0]), e2 = expf(bv[2] - bv[0]), e3 = expf(bv[3] - bv[0]), inv = 1.0f / (e0 + e1 + e2 + e3);
                *(int4*)(topi + r * 4) = make_int4(bi[0], bi[1], bi[2], bi[3]); *(float4*)(topw + r * 4) = make_float4(e0 * inv, e1 * inv, e2 * inv, e3 * inv);
                __hip_atomic_fetch_add(&chist[bi[0]], 1, __ATOMIC_RELAXED, __HIP_MEMORY_SCOPE_WORKGROUP); __hip_atomic_fetch_add(&chist[bi[1]], 1, __ATOMIC_RELAXED, __HIP_MEMORY_SCOPE_WORKGROUP);
                __hip_atomic_fetch_add(&chist[bi[2]], 1, __ATOMIC_RELAXED, __HIP_MEMORY_SCOPE_WORKGROUP); __hip_atomic_fetch_add(&chist[bi[3]], 1, __ATOMIC_RELAXED, __HIP_MEMORY_SCOPE_WORKGROUP); }
            __syncthreads();
        }
        if (tid < NEXP) { const int n = chist[tid]; if (n) atomicAdd(&cnt[tid], (unsigned)n); }
    }
    SEAM(9);
    LAS int* goff = (LAS int*)(lds + GOFF_OFF);
    if (hi > 10) { const int tid = threadIdx.x; unsigned* cnt = ctl0 + CW_CNT; __syncthreads(); if (tid < 1) { int a = 0; for (int e = 0; e < NEXP; ++e) { goff[tid * 33 + e] = a; a += (int)__hip_atomic_load(&cnt[tid * NEXP + e], __ATOMIC_RELAXED, __HIP_MEMORY_SCOPE_AGENT); } goff[tid * 33 + 32] = a; } __syncthreads(); }
    if (IN(10)) {
        PH_VARS
        PTRS
        LAS int* hist = (LAS int*)lds; LAS int* base = hist + 32;
        for (int ch = blockIdx.x; ch < T / 256; ch += gridDim.x) {
            if (tid < 32) hist[tid] = 0;
            __syncthreads();
            const int t = ch * 256 + tid; int ee[4] = {0, 0, 0, 0}, loc[4] = {0, 0, 0, 0}; float ww[4] = {0.f, 0.f, 0.f, 0.f};
            if (tid < 256) { const int4 e4 = *(const int4*)(topi + (size_t)t * 4); const float4 w4 = *(const float4*)(topw + (size_t)t * 4);
                ee[0] = e4.x; ee[1] = e4.y; ee[2] = e4.z; ee[3] = e4.w; ww[0] = w4.x; ww[1] = w4.y; ww[2] = w4.z; ww[3] = w4.w;
#pragma unroll
                for (int k = 0; k < 4; ++k) loc[k] = __hip_atomic_fetch_add(&hist[ee[k]], 1, __ATOMIC_RELAXED, __HIP_MEMORY_SCOPE_WORKGROUP); }
            __syncthreads();
            if (tid < 32) { const int n = hist[tid]; base[tid] = goff[tid] + (n ? (int)atomicAdd(&fill[tid], (unsigned)n) : 0); }
            __syncthreads();
            if (tid < 256) { int pp[4]; const float sat = sa[t];
#pragma unroll
                for (int k = 0; k < 4; ++k) { const int pos = base[ee[k]] + loc[k]; list[pos] = t; wpos[pos] = ww[k]; sapos[pos] = sat; pp[k] = pos; }
                *(int4*)(posof + (size_t)t * 4) = make_int4(pp[0], pp[1], pp[2], pp[3]); }
            __syncthreads();
        }
    }
    SEAM(10);
    {
        PTRS
        bf* out2_p = (bf*)(ws + WS_OUT2);
        if (IN(11)) { g8::MoeOrder S{goff, 8, G, cB, D / 2, 0, 0, -1, 0}; g8::EpiSwigluI8 E{hid8, b_mlp1, sapos, sbw};
            g8::gemm_phase<g8::EpiSwigluI8, g8::MoeOrder, true>(lds, (const bf*)h2q, D / 2, (const bf*)w1q, D / 2, D / 2, list, S, E); }
        SEAM(11);
        if (IN(12)) { g8::MoeOrder S{goff, 4, G, cB, DFF / 2, 0, 0, -1, 0}; g8::EpiMoe2F8 E{out2_p, b_mlp2, wpos, lds + STG_OFF};
            int kq = DFF / 2; asm volatile("" : "+s"(kq));
            g8::gemm_phase<g8::EpiMoe2F8, g8::MoeOrder, false>(lds, (const bf*)hid8, DFF / 2, (const bf*)w2q, DFF / 2, kq, nullptr, S, E); }
        SEAM(12);
    }
    if (IN(13)) {
        PH_VARS
        PTRS
        const bf* o0 = (const bf*)(ws + WS_OUT2); const bf* o1 = o0; const bf* o2 = o0; const bf* o3 = o0;
        for (int r = gw; r < T; r += NGW) { float4 v[4]; const int4 ps = *(const int4*)(posof + (size_t)r * 4);
#pragma unroll
            for (int j = 0; j < 4; ++j) { const int c = 4 * lane + 256 * j;
                const g8::u32x2 hh = __builtin_nontemporal_load((const g8::u32x2*)(h2b + (size_t)r * D + c)), a0 = __builtin_nontemporal_load((const g8::u32x2*)(o0 + (size_t)ps.x * D + c)), a1 = __builtin_nontemporal_load((const g8::u32x2*)(o1 + (size_t)ps.y * D + c)),
                                a2 = __builtin_nontemporal_load((const g8::u32x2*)(o2 + (size_t)ps.z * D + c)), a3 = __builtin_nontemporal_load((const g8::u32x2*)(o3 + (size_t)ps.w * D + c));
#define LO(u) __uint_as_float((u) << 16)
#define HI(u) __uint_as_float((u) & 0xffff0000u)
                v[j].x = ALPHA * LO(hh.x) + ((LO(a0.x) + LO(a1.x)) + (LO(a2.x) + LO(a3.x)));
                v[j].y = ALPHA * HI(hh.x) + ((HI(a0.x) + HI(a1.x)) + (HI(a2.x) + HI(a3.x)));
                v[j].z = ALPHA * LO(hh.y) + ((LO(a0.y) + LO(a1.y)) + (LO(a2.y) + LO(a3.y)));
                v[j].w = ALPHA * HI(hh.y) + ((HI(a0.y) + HI(a1.y)) + (HI(a2.y) + HI(a3.y)));
#undef LO
#undef HI
            }
            ln_wave(v, ln3_g, ln3_b, lane);
#pragma unroll
            for (int j = 0; j < 4; ++j) stnt4(out + (size_t)r * D + 4 * lane + 256 * j, v[j]); }
    }
#undef IN
#undef SEAM
}

extern "C" void kernel_launch(void* const* d_in, const int* in_sizes, int n_in, void* d_out, int out_size, void* d_ws, size_t ws_size, hipStream_t stream) {
    static int grid = 0;
    if (grid == 0) {
        if (n_in != 26 || out_size != T * D || ws_size < WS_END) { fprintf(stderr, "kernel_launch: unexpected shapes (n_in %d out %d ws %zu)\n", n_in, out_size, ws_size); grid = -1; return; }
        int dev = 0, cus = 0, per_cu = 0;
        if (hipGetDevice(&dev) != hipSuccess || hipDeviceGetAttribute(&cus, hipDeviceAttributeMultiprocessorCount, dev) != hipSuccess) { grid = -1; return; }
        if (hipFuncSetAttribute((const void*)fwd, hipFuncAttributeMaxDynamicSharedMemorySize, LDS_BYTES) != hipSuccess) { fprintf(stderr, "kernel_launch: hipFuncSetAttribute failed\n"); grid = -1; return; }
        if (hipOccupancyMaxActiveBlocksPerMultiprocessor(&per_cu, (const void*)fwd, NTHR, LDS_BYTES) != hipSuccess || per_cu < 1) fprintf(stderr, "kernel_launch: occupancy query reports %d\n", per_cu);
        (void)hipGetLastError();
        grid = cus;
    }
    if (grid < 0) return;
    (void)hipMemsetAsync((char*)d_ws + WS_CTL, 0, CTL_ZERO_BYTES, stream);
    (void)hipMemsetAsync((char*)d_ws + WS_LNZ, 0, LNZ_BYTES, stream);
    Args a{};
    for (int i = 0; i < 26; ++i) a.in[i] = (const float*)d_in[i];
    a.out = (float*)d_out; a.ws = (unsigned char*)d_ws;
#if ONE_LAUNCH
#ifdef EXP_PREFIX
    a.ph_lo = 0; a.ph_hi = EXP_PREFIX + 1; hipLaunchKernelGGL(fwd, dim3(grid), dim3(NTHR), LDS_BYTES, stream, a);
    (void)hipMemsetAsync((char*)d_ws + WS_CTL, 0, CTL_ZERO_BYTES, stream); (void)hipMemsetAsync((char*)d_ws + WS_LNZ, 0, LNZ_BYTES, stream);
#endif
#ifndef EXP_LIST
    a.ph_lo = 0; a.ph_hi = NPH;
    hipLaunchKernelGGL(fwd, dim3(grid), dim3(NTHR), LDS_BYTES, stream, a);
#else
    { const int reps[] = {EXP_LIST}; int lo = 0;
      for (unsigned i = 0; i <= sizeof(reps) / sizeof(int); ++i) { const int hi = (i < sizeof(reps) / sizeof(int)) ? reps[i] + 1 : NPH;
          if (i) (void)hipMemsetAsync((char*)d_ws + WS_CTL + CW_BAR * 4, 0, (CW_CNT - CW_BAR) * 4, stream);
          a.ph_lo = lo; a.ph_hi = hi; hipLaunchKernelGGL(fwd, dim3(grid), dim3(NTHR), LDS_BYTES, stream, a); lo = hi - 1; } }
#endif
#else
    for (int p = 0; p < NPH; ++p) { a.ph_lo = p; a.ph_hi = p + 1; hipLaunchKernelGGL(fwd, dim3(grid), dim3(NTHR), LDS_BYTES, stream, a); }
#endif
}
```

```cpp
#include <hip/hip_runtime.h>
#include <hip/hip_bf16.h>
#include <cmath>
#include <cstdio>
#include <cstdint>

#ifndef ONE_LAUNCH
#define ONE_LAUNCH 1
#endif

constexpr int BATCH = 32, SEQ = 2048, D = 1024, T = BATCH * SEQ;
constexpr int MEML = 256, TM = BATCH * MEML;
constexpr int NPROJ = 3072;
constexpr int NEXP = 32, TOPK = 4, DFF = 1024;
constexpr float ALPHA = 1.189207115002721f;
constexpr float LN_EPS = 1e-5f;
constexpr int NTHR = 512, NWAVES = 8;

#define GAS __attribute__((address_space(1)))
#define LAS __attribute__((address_space(3)))
typedef LAS float lfloat;
typedef float f32x4 __attribute__((ext_vector_type(4)));
#define WSYNC() asm volatile("s_waitcnt lgkmcnt(0)" ::: "memory")

constexpr size_t MiB = 1u << 20;
constexpr size_t WS_CTL = 0, CTL_ZERO_BYTES = 1 * MiB;
constexpr size_t WS_ROPE = 1 * MiB;
constexpr size_t WS_KMEAN = 2 * MiB;
constexpr size_t WS_LNZ = 10 * MiB, LNZ_BYTES = 2 * MiB;
constexpr float FXS = 16777216.0f, FXI = 1.0f / 16777216.0f;
__device__ __forceinline__ void fx_add(long long* p, float v) { atomicAdd((unsigned long long*)p, (unsigned long long)(long long)rintf(v * FXS)); }
__device__ __forceinline__ float fx_get(const long long* p) { return (float)(*p) * FXI; }
constexpr size_t WS_SX = 13 * MiB, WS_SWIN = 14 * MiB;
constexpr size_t WS_SAPOS = 12 * MiB;
constexpr size_t WS_SA = 8 * MiB, WS_SB = 9 * MiB;
constexpr size_t WS_H2Q = 96 * MiB;
constexpr size_t WS_TOPI = 3 * MiB, WS_TOPW = 4 * MiB, WS_LIST = 5 * MiB, WS_WPOS = 6 * MiB, WS_POSOF = 7 * MiB;
constexpr size_t WS_WINT = 16 * MiB, WS_WOUTT = 22 * MiB, WS_WQB = 24 * MiB, WS_WKVT = 26 * MiB, WS_WOT = 30 * MiB, WS_W1T = 32 * MiB, WS_W2T = 160 * MiB;
constexpr size_t WS_XB = 224 * MiB;
constexpr size_t WS_PROJ = 352 * MiB;
constexpr size_t WS_MEMN = 736 * MiB, WS_KVM = 752 * MiB;
constexpr size_t WS_GT = 784 * MiB, WS_VWT = 848 * MiB;
constexpr size_t WS_H1B = 224 * MiB;
constexpr size_t WS_P = 608 * MiB;
constexpr size_t WS_H2B = 224 * MiB;
constexpr size_t WS_OUT2 = 352 * MiB;
constexpr size_t WS_END = 912 * MiB;
constexpr int CW_BAR = 4096, CW_CNT = 8192, CW_FILL = 8448;
constexpr float C2Q = 0.125f * 1.4426950408889634f;
constexpr float C2M = 0.0625f * 1.4426950408889634f;

#define XB_TMO      128
#define XB_XCNT(j)  (256  + 64 * (j))
#define XB_XSUB(j)  (1280 + 64 * (j))
#define XB_XGEN(j)  (2304 + 64 * (j))
#define XB_TOP      3328
#define XB_TOPGEN   3392
#define XCD_BAR_WORDS 3456
#define XB_SPIN_CAP (1u << 24)

__device__ __forceinline__ unsigned xb_ld(unsigned* p)              { return __hip_atomic_load(p, __ATOMIC_RELAXED, __HIP_MEMORY_SCOPE_AGENT); }
__device__ __forceinline__ unsigned xb_add(unsigned* p, unsigned v) { return __hip_atomic_fetch_add(p, v, __ATOMIC_RELAXED, __HIP_MEMORY_SCOPE_AGENT); }
__device__ __forceinline__ unsigned xb_xcc_id() { return (unsigned)__builtin_amdgcn_s_getreg((3 << 11) | 20) & 0xFu; }
#define XB_SPIN(cond, bar) do { unsigned _sp = 0; while (cond) { __builtin_amdgcn_s_sleep(1); \
    if ((++_sp & 255u) == 0u) { if (xb_ld(&(bar)[XB_TMO])) break; if (_sp > XB_SPIN_CAP) { atomicAdd(&(bar)[XB_TMO], 1u); break; } } } } while (0)

struct XcdBarrier { unsigned* bar; unsigned x; volatile LAS unsigned* st; };

__device__ __forceinline__ XcdBarrier xcd_barrier_post(unsigned* bar, volatile LAS unsigned* st) {
    XcdBarrier b; b.bar = bar; b.x = xb_xcc_id(); b.st = st;
    if (threadIdx.x == 0) (void)xb_add(&bar[XB_XCNT(b.x)], 1u);
    return b;
}
__device__ __forceinline__ void xcd_barrier_complete(unsigned* bar, unsigned x, unsigned& nloc, unsigned& nx) {
    const unsigned G = gridDim.x * gridDim.y * gridDim.z;
    unsigned sum, cnt, mine, sp = 0u;
    for (;;) {
        sum = 0u; cnt = 0u; mine = 0u;
#pragma unroll
        for (unsigned j = 0; j < 16; ++j) { const unsigned c = xb_ld(&bar[XB_XCNT(j)]); sum += c; cnt += (c > 0u) ? 1u : 0u; mine = (j == x) ? c : mine; }
        if (sum == G) break;
        __builtin_amdgcn_s_sleep(1);
        if ((++sp & 255u) == 0u) { if (xb_ld(&bar[XB_TMO])) break; if (sp > XB_SPIN_CAP) { atomicAdd(&bar[XB_TMO], 1u); break; } }
    }
    nloc = mine > 0u ? mine : 1u; nx = cnt > 0u ? cnt : 1u;
}
__device__ __forceinline__ void xcd_barrier(const XcdBarrier& b) {
    asm volatile("s_waitcnt vmcnt(0)" ::: "memory");
    __syncthreads();
    if (threadIdx.x == 0) {
        unsigned* bar = b.bar;
        __builtin_amdgcn_s_waitcnt(0);
        unsigned nloc = b.st[0], nx = b.st[1];
        if (nloc == 0u) { xcd_barrier_complete(bar, b.x, nloc, nx); b.st[0] = nloc; b.st[1] = nx; }
        const unsigned old = xb_add(&bar[XB_XSUB(b.x)], 1u);
        const unsigned gen = old / nloc;
        if (old + 1u == (gen + 1u) * nloc) {
            __builtin_amdgcn_fence(__ATOMIC_RELEASE, "agent");
            asm volatile("s_waitcnt vmcnt(0)" ::: "memory");
            const unsigned og = xb_add(&bar[XB_TOP], 1u);
            const unsigned tg = og / nx;
            if (og + 1u == (tg + 1u) * nx) xb_add(&bar[XB_TOPGEN], 1u);
            else XB_SPIN(xb_ld(&bar[XB_TOPGEN]) == tg, bar);
            __builtin_amdgcn_fence(__ATOMIC_ACQUIRE, "agent");
            xb_add(&bar[XB_XGEN(b.x)], 1u);
            asm volatile("s_waitcnt vmcnt(0)" ::: "memory");
        } else {
            XB_SPIN(xb_ld(&bar[XB_XGEN(b.x)]) == gen, bar);
            __builtin_amdgcn_fence(__ATOMIC_ACQUIRE, "agent");
            asm volatile("s_waitcnt vmcnt(0)" ::: "memory");
        }
    }
    __syncthreads();
}

__device__ __forceinline__ float wave_sum(float v) {
#pragma unroll
    for (int o = 1; o < 64; o <<= 1) v += __shfl_xor(v, o);
    return v;
}
__device__ __forceinline__ float wave_max(float v) {
#pragma unroll
    for (int o = 1; o < 64; o <<= 1) v = fmaxf(v, __shfl_xor(v, o));
    return v;
}
__device__ __forceinline__ void sincos_d(double a, double& s, double& c) {
    const double TWO_PI_HI = 6.283185307179586232, TWO_PI_LO = 2.4492935982947064e-16;
    const double k = rint(a / TWO_PI_HI);
    double r = (a - k * TWO_PI_HI) - k * TWO_PI_LO;
    const double r2 = r * r;
    double ts = 1.0, tc = 1.0;
#pragma unroll
    for (int n = 16; n >= 1; --n) {
        ts = 1.0 - ts * r2 / (double)((2 * n) * (2 * n + 1));
        tc = 1.0 - tc * r2 / (double)((2 * n - 1) * (2 * n));
    }
    s = r * ts; c = tc;
}
__constant__ double INV_FREQ[8] = {1.0, 0.19392274474868576, 0.03760603093086393, 0.007292664737217109,
                                   0.001414213562373095, 0.0002742481756762073, 5.318295896944988e-05, 1.031338537721246e-05};

namespace g8 {
typedef unsigned short bf16_t;
typedef short bf16x8 __attribute__((ext_vector_type(8)));
typedef unsigned u32x4 __attribute__((ext_vector_type(4)));
typedef unsigned u32x2 __attribute__((ext_vector_type(2)));
typedef int i32x4 __attribute__((ext_vector_type(4)));
constexpr int BM = 256, BK = 64, HALF = 128, HTB = HALF * BK * 2, STAGE_BYTES = 8 * HTB, NXCD = 8, WGM = 8;
__host__ __device__ __forceinline__ int lds_byte(int r, int c) { const int st = (r >> 4) * 2 + (c >> 5), rr = r & 15, cc = c & 31, ob = rr * 64 + cc * 2; return st * 1024 + (ob ^ (((ob >> 9) & 1) << 5)); }
__host__ __device__ __forceinline__ void stage_rc(int b, int& R, int& C) { const int st = b / 1024, sb = b % 1024, swz = sb ^ (((sb >> 9) & 1) << 5); R = (st >> 1) * 16 + swz / 64; C = (st & 1) * 32 + (swz % 64) / 2; }
__host__ __device__ __forceinline__ int perm32(int rho) { const int n = rho >> 4, i = rho & 15; return 8 * (i >> 2) + 4 * n + (i & 3); }
__device__ __forceinline__ unsigned cvt_pk_bf16(float lo, float hi) { unsigned r; asm volatile("v_cvt_pk_bf16_f32 %0, %1, %2" : "=v"(r) : "v"(lo), "v"(hi)); return r; }

struct Unit { int arow0, nrows, acol0, orow0, ocol0, aux; size_t boff; };

struct DenseOrder {
    int nM, nN, nwg, G, c, ldb;
    __device__ void init(int M, int N, int ldb_, int G_, int c_) { nM = M / BM; nN = N / BM; nwg = nM * nN; G = G_; c = c_; ldb = ldb_; }
    __device__ bool tile(int i, int& pm, int& pn) const {
        const long L = (long)i * G + c; if (L >= nwg) return false;
        int wgid = (int)L; { const int q = nwg / NXCD, r = nwg % NXCD, xcd = wgid % NXCD, off = wgid / NXCD; wgid = (xcd < r ? xcd * (q + 1) : r * (q + 1) + (xcd - r) * q) + off; }
        const int nig = WGM * nN, gid = wgid / nig, fm = gid * WGM, gsz = (nM - fm) < WGM ? (nM - fm) : WGM;
        pm = fm + ((wgid % nig) % gsz); pn = (wgid % nig) / gsz; return true;
    }
    __device__ bool next(int i, Unit& u) const { int pm, pn; if (!tile(i, pm, pn)) return false;
        u.arow0 = pm * BM; u.nrows = BM; u.acol0 = 0; u.orow0 = pm * BM; u.ocol0 = pn * BM; u.aux = 0; u.boff = (size_t)pn * BM * ldb; return true; }
};
struct MoeOrder {
    const LAS int* goff; int nct, G, c, ldb;
    mutable int e_ = 0, base_ = 0, lo_ = -1, hi_ = 0;
    __device__ __forceinline__ int g(int e) const { return __builtin_amdgcn_readfirstlane(goff[e]); }
    __device__ bool next(int i, Unit& u) const {
        const int L = i * G + c;
        if (lo_ < 0) { lo_ = g(0); hi_ = g(1); }
        for (;;) { if (e_ >= 32) return false; const int n = ((hi_ - lo_ + 255) >> 8) * nct; if (L < base_ + n) break; base_ += n; ++e_; lo_ = hi_; hi_ = e_ < 32 ? g(e_ + 1) : hi_; }
        const int li = L - base_, rt = li / nct, ct = li - rt * nct;
        u.arow0 = lo_ + rt * BM; u.nrows = min(BM, hi_ - u.arow0); u.acol0 = 0; u.orow0 = u.arow0; u.ocol0 = ct * BM; u.aux = e_;
        u.boff = ((size_t)e_ * nct + ct) * BM * ldb; return true; }
};

__device__ __forceinline__ f32x4 mma_bf16(bf16x8 b, bf16x8 a, f32x4 c) { return __builtin_amdgcn_mfma_f32_16x16x32_bf16(b, a, c, 0, 0, 0); }
__device__ __forceinline__ i32x4 mma_bf16(bf16x8, bf16x8, i32x4 c) { return c; }
__device__ __forceinline__ i32x4 mma_i8(bf16x8 b, bf16x8 a, i32x4 c) { return __builtin_amdgcn_mfma_i32_16x16x64_i8(__builtin_bit_cast(i32x4, b), __builtin_bit_cast(i32x4, a), c, 0, 0, 0); }
__device__ __forceinline__ f32x4 mma_i8(bf16x8, bf16x8, f32x4 c) { return c; }
typedef int i32x8 __attribute__((ext_vector_type(8)));
__device__ __forceinline__ f32x4 mma_f8(i32x8 b, i32x8 a, f32x4 c) { const int one = 127; asm volatile("v_mfma_scale_f32_16x16x128_f8f6f4 %0, %1, %2, %0, %3, %3 op_sel_hi:[0,0,0]" : "+v"(c) : "v"(b), "v"(a), "v"(one)); return c; }
__device__ __forceinline__ i32x4 mma_f8(i32x8, i32x8, i32x4 c) { return c; }
template <class Epi, class Sched, bool GATHER>
__device__ __forceinline__ void gemm_phase(LAS unsigned char* lds, const bf16_t* A, int lda, const bf16_t* Bt, int ldb, int K, const int* list, const Sched& S, const Epi& E) {
    int tid_ = threadIdx.x; asm volatile("" : "+v"(tid_));
    const int tid = tid_, wid = __builtin_amdgcn_readfirstlane(tid >> 6), lane = tid & 63, wr = wid >> 2, wc = wid & 3, fr = lane & 15, fq = lane >> 4;
    const int nt = K / BK;
    unsigned voffB[2];
#pragma unroll
    for (int i = 0; i < 2; ++i) { int R, C; stage_rc(tid * 16 + i * 8192, R, C); const int Rb = 64 * (R >> 5) + (Epi::PERM ? perm32(R & 31) : (R & 31));   voffB[i] = (unsigned)(Rb * ldb + C) * 2u; }
    const size_t kstep = (size_t)(BK * 2);
    const size_t hstepB = (size_t)32 * ldb * 2;
    const unsigned ldsw = (unsigned)wid * 1024u;
    const int aoff = lds_byte(wr * 64 + fr, fq * 8), boff = lds_byte(wc * 32 + fr, fq * 8);
#define G8_MKRAW(V, U) do { _Pragma("unroll") for (int _h = 0; _h < 2; ++_h) _Pragma("unroll") for (int _i = 0; _i < 2; ++_i) { int _R, _C; stage_rc(tid * 16 + _i * 8192, _R, _C); int _r = 128 * _h + _R; _r = _r < (U).nrows ? _r : (U).nrows - 1; \
            V[_h][_i] = GATHER ? (unsigned)list[(U).arow0 + _r] : (unsigned)((U).arow0 + _r); } } while (0)
#define G8_MKCONV(V, U) do { _Pragma("unroll") for (int _h = 0; _h < 2; ++_h) _Pragma("unroll") for (int _i = 0; _i < 2; ++_i) { int _R, _C; stage_rc(tid * 16 + _i * 8192, _R, _C); V[_h][_i] = (V[_h][_i] * (unsigned)lda + (unsigned)((U).acol0 + _C)) * 2u; } } while (0)
#define G8_MKOFF(V, U) do { G8_MKRAW(V, U); G8_MKCONV(V, U); } while (0)
#define G8_SA(b, h) (((b) * 2 + (h)) * HTB)
#define G8_SB(b, h) ((4 + (b) * 2 + (h)) * HTB)
#define G8_STAGE_B(bufoff, gbase) do { _Pragma("unroll") for (int _i = 0; _i < 2; ++_i) \
        __builtin_amdgcn_global_load_lds((const unsigned*)((const char*)(gbase) + voffB[_i]), (LAS unsigned*)(lds + (bufoff) + ldsw + _i * 8192), 16, 0, 0); } while (0)
#define G8_STAGE_A(bufoff, kb, V, h) do { _Pragma("unroll") for (int _i = 0; _i < 2; ++_i) \
        __builtin_amdgcn_global_load_lds((const unsigned*)((const char*)A + (kb) + V[h][_i]), (LAS unsigned*)(lds + (bufoff) + ldsw + _i * 8192), 16, 0, 0); } while (0)
#define G8_STAGE_A2(bufoff, kb, h) do { _Pragma("unroll") for (int _i = 0; _i < 2; ++_i) \
        __builtin_amdgcn_global_load_lds((const unsigned*)((const char*)A + (kb) + (last ? vN[h][_i] : vC[h][_i])), (LAS unsigned*)(lds + (bufoff) + ldsw + _i * 8192), 16, 0, 0); } while (0)
#define G8_LDA(dst, b, h) do { if constexpr (Epi::F8) { _Pragma("unroll") for (int m = 0; m < 4; ++m) { const i32x4 _l = *(const LAS i32x4*)(lds + G8_SA(b, h) + aoff + m * 2048), _h = *(const LAS i32x4*)(lds + G8_SA(b, h) + aoff + m * 2048 + 1024); dst##8[m] = __builtin_shufflevector(_l, _h, 0, 1, 2, 3, 4, 5, 6, 7); } } \
        else { _Pragma("unroll") for (int m = 0; m < 4; ++m) _Pragma("unroll") for (int k = 0; k < 2; ++k) dst[m][k] = *(const LAS bf16x8*)(lds + G8_SA(b, h) + aoff + m * 2048 + k * 1024); } } while (0)
#define G8_LDB(dst, b, h) do { if constexpr (Epi::F8) { _Pragma("unroll") for (int n = 0; n < 2; ++n) { const i32x4 _l = *(const LAS i32x4*)(lds + G8_SB(b, h) + boff + n * 2048), _h = *(const LAS i32x4*)(lds + G8_SB(b, h) + boff + n * 2048 + 1024); dst##8[n] = __builtin_shufflevector(_l, _h, 0, 1, 2, 3, 4, 5, 6, 7); } } \
        else { _Pragma("unroll") for (int n = 0; n < 2; ++n) _Pragma("unroll") for (int k = 0; k < 2; ++k) dst[n][k] = *(const LAS bf16x8*)(lds + G8_SB(b, h) + boff + n * 2048 + k * 1024); } } while (0)
#define G8_MMA(ai, bj, At, Bt_) do { __builtin_amdgcn_s_setprio(1); _Pragma("unroll") for (int m = 0; m < 4; ++m) _Pragma("unroll") for (int n = 0; n < 2; ++n) { \
        if constexpr (Epi::F8) acc[ai][bj][m][n] = mma_f8(Bt_##8[n], At##8[m], acc[ai][bj][m][n]); \
        else { _Pragma("unroll") for (int k = 0; k < 2; ++k) { if constexpr (Epi::I8) acc[ai][bj][m][n] = mma_i8(Bt_[n][k], At[m][k], acc[ai][bj][m][n]); else acc[ai][bj][m][n] = mma_bf16(Bt_[n][k], At[m][k], acc[ai][bj][m][n]); } } } \
        if constexpr (Epi::F8) asm volatile("s_nop 15\n\ts_nop 7" ::: "memory");     \
        __builtin_amdgcn_s_setprio(0); } while (0)
#define G8_WAIT_V(n) asm volatile("s_waitcnt vmcnt(" #n ")" ::: "memory")
#define G8_WAIT_L(n) asm volatile("s_waitcnt lgkmcnt(" #n ")" ::: "memory")
#define G8_BAR __builtin_amdgcn_s_barrier()
#define G8_SCHED __builtin_amdgcn_sched_barrier(0)
    Unit cur, nxt; int ui = 0;
    if (!S.next(0, cur)) return;
    typedef typename Epi::acc_t acc_t;
    acc_t acc[2][2][4][2];
#pragma unroll
    for (int a = 0; a < 2; ++a)
#pragma unroll
        for (int b = 0; b < 2; ++b)
#pragma unroll
            for (int m = 0; m < 4; ++m)
#pragma unroll
                for (int n = 0; n < 2; ++n) acc[a][b][m][n] = (acc_t){0, 0, 0, 0};
    bf16x8 At[4][2], B0[2][2], B1[2][2];
    i32x8 At8[4], B08[2], B18[2];
    (void)At; (void)B0; (void)B1; (void)At8; (void)B08; (void)B18;
    unsigned vC[2][2], vN[2][2];
    G8_MKOFF(vC, cur);
    const char* cB = (const char*)Bt + cur.boff * 2;
    G8_STAGE_B(G8_SB(0, 0), cB); G8_STAGE_B(G8_SB(0, 1), cB + hstepB); G8_STAGE_A(G8_SA(0, 0), 0, vC, 0); G8_STAGE_A(G8_SA(0, 1), 0, vC, 1);
    if (wr == 1) G8_BAR;
    G8_WAIT_V(2); G8_BAR;
    G8_STAGE_B(G8_SB(1, 0), cB + kstep); G8_STAGE_A(G8_SA(1, 0), kstep, vC, 0); G8_STAGE_B(G8_SB(1, 1), cB + hstepB + kstep);
    G8_WAIT_V(6); G8_BAR;
    for (;;) {
        const bool has_next = S.next(ui + 1, nxt);
        const int tconv = (GATHER && nt > 2) ? 2 : 0;
        if (has_next) { if (GATHER) { G8_MKRAW(vN, nxt); } else { G8_MKOFF(vN, nxt); } } else {
#pragma unroll
            for (int h = 0; h < 2; ++h)
#pragma unroll
                for (int i = 0; i < 2; ++i) vN[h][i] = vC[h][i]; }
        const char* nB = has_next ? (const char*)Bt + nxt.boff * 2 : cB;
        for (int t = 0; t < nt; t += 2) {
            const bool last = (t == nt - 2);
            const size_t kb1 = (size_t)(t + 1) * kstep;
            const size_t kb2 = last ? 0 : (size_t)(t + 2) * kstep, kb3 = kb2 + kstep;
            const char* b2 = last ? nB : cB + (size_t)(t + 2) * kstep; const char* b3 = b2 + kstep;
            G8_LDB(B0, 0, 0); G8_LDB(B1, 0, 1); G8_SCHED; G8_LDA(At, 0, 0); G8_STAGE_A(G8_SA(1, 1), kb1, vC, 1);
            if (GATHER) { if (t == tconv && has_next) { G8_MKCONV(vN, nxt); } }
            G8_WAIT_V(8); G8_WAIT_L(0); G8_BAR; G8_MMA(0, 0, At, B0); G8_MMA(0, 1, At, B1); G8_BAR; G8_SCHED;
            G8_LDA(At, 0, 1); G8_STAGE_B(G8_SB(0, 0), b2); G8_STAGE_B(G8_SB(0, 1), b2 + hstepB); G8_STAGE_A2(G8_SA(0, 0), kb2, 0);
            G8_WAIT_V(8); G8_WAIT_L(0); G8_BAR; G8_MMA(1, 0, At, B0); G8_MMA(1, 1, At, B1); G8_BAR; G8_SCHED;
            G8_LDB(B0, 1, 0); G8_LDB(B1, 1, 1); G8_SCHED; G8_LDA(At, 1, 0); G8_STAGE_A2(G8_SA(0, 1), kb2, 1);
            G8_WAIT_V(8); G8_WAIT_L(0); G8_BAR; G8_MMA(0, 0, At, B0); G8_MMA(0, 1, At, B1); G8_BAR; G8_SCHED;
            G8_LDA(At, 1, 1); G8_STAGE_B(G8_SB(1, 0), b3); G8_STAGE_B(G8_SB(1, 1), b3 + hstepB); G8_STAGE_A2(G8_SA(1, 0), kb3, 0);
            G8_WAIT_V(8); G8_WAIT_L(0); G8_BAR; G8_MMA(1, 0, At, B0); G8_MMA(1, 1, At, B1); G8_BAR; G8_SCHED;
        }
        if (wr == 0) G8_BAR;
        E(acc, cur, wr, wc, fr, fq);
        if (!has_next) break;
#pragma unroll
        for (int a = 0; a < 2; ++a)
#pragma unroll
            for (int b = 0; b < 2; ++b)
#pragma unroll
                for (int m = 0; m < 4; ++m)
#pragma unroll
                    for (int n = 0; n < 2; ++n) acc[a][b][m][n] = (acc_t){0, 0, 0, 0};
        cur = nxt; cB = nB; ++ui;
#pragma unroll
        for (int h = 0; h < 2; ++h)
#pragma unroll
            for (int i = 0; i < 2; ++i) vC[h][i] = vN[h][i];
        if (wr == 1) G8_BAR;
    }
    G8_WAIT_V(0);
    G8_BAR;
#undef G8_MKOFF
#undef G8_MKRAW
#undef G8_MKCONV
#undef G8_SA
#undef G8_SB
#undef G8_STAGE_A
#undef G8_STAGE_A2
#undef G8_STAGE_B
#undef G8_LDA
#undef G8_LDB
#undef G8_MMA
#undef G8_WAIT_V
#undef G8_WAIT_L
#undef G8_BAR
#undef G8_SCHED
}

constexpr float HID_SCALE = 4.0f, W2_SCALE = 64.0f;
__device__ __forceinline__ void store_rows128(LAS unsigned char* stg, bf16_t* gp  , size_t ldc, u32x4 p0, u32x4 p1, int fr, int fq, int nvalid) {
    const int sw = fr & 7, lane = fr + 16 * fq, r0 = lane >> 3, c = lane & 7;
    *(LAS u32x4*)(stg + fr * 128 + ((fq ^ sw) << 4)) = p0;
    *(LAS u32x4*)(stg + fr * 128 + (((4 + fq) ^ sw) << 4)) = p1;
    asm volatile("s_waitcnt lgkmcnt(0)" ::: "memory");
    const u32x4 o0 = *(const LAS u32x4*)(stg + r0 * 128 + ((c ^ (r0 & 7)) << 4)), o1 = *(const LAS u32x4*)(stg + (8 + r0) * 128 + ((c ^ (r0 & 7)) << 4));
    asm volatile("s_waitcnt lgkmcnt(0)" ::: "memory");
    if (r0 < nvalid) *(u32x4*)(gp + (size_t)r0 * ldc + c * 8) = o0;
    if (8 + r0 < nvalid) *(u32x4*)(gp + (size_t)(8 + r0) * ldc + c * 8) = o1;
}
__device__ __forceinline__ float swiglu_f(float g, float l) {
    g = fminf(g, 7.0f); l = fminf(fmaxf(l, -7.0f), 7.0f);
    return g * __builtin_amdgcn_rcpf(1.0f + __expf(-1.702f * g)) * (l + 1.0f);
}
struct EpiSwigluB { typedef f32x4 acc_t; static constexpr bool I8 = false, F8 = false; static constexpr bool PERM = true;
    bf16_t* H; const float* b1;
    __device__ __forceinline__ void operator()(const f32x4 (&acc)[2][2][4][2], const Unit& u, int wr, int wc, int fr, int fq) const {
        const int col0 = u.ocol0 + wc * 64 + 8 * fq; const float* bp = b1 + (size_t)u.aux * 2048 + col0;
        f32x4 bv[2][2];
#pragma unroll
        for (int bj = 0; bj < 2; ++bj)
#pragma unroll
            for (int n = 0; n < 2; ++n) bv[bj][n] = *(const f32x4*)(bp + bj * 32 + 4 * n);
#pragma unroll
        for (int ai = 0; ai < 2; ++ai)
#pragma unroll
            for (int m = 0; m < 4; ++m) { const int r = ai * HALF + wr * 64 + m * 16 + fr; if (r < u.nrows) { bf16_t* rowp = H + (size_t)(u.orow0 + r) * 1024 + (col0 >> 1);
#pragma unroll
                for (int bj = 0; bj < 2; ++bj) { const f32x4 v0 = acc[ai][bj][m][0] + bv[bj][0], v1 = acc[ai][bj][m][1] + bv[bj][1];
                    u32x2 w; w.x = cvt_pk_bf16(swiglu_f(v0[0], v0[1]), swiglu_f(v0[2], v0[3])); w.y = cvt_pk_bf16(swiglu_f(v1[0], v1[1]), swiglu_f(v1[2], v1[3]));
                    *(u32x2*)(rowp + bj * 16) = w; } } }
    }
};
struct EpiSwigluI8 { typedef i32x4 acc_t; static constexpr bool I8 = true, F8 = false; static constexpr bool PERM = true;
    unsigned char* H; const float* b1; const float* sa; const float* sb;
    typedef float f2 __attribute__((ext_vector_type(2)));
    static __device__ __forceinline__ f2 swiglu2(f2 g, f2 l) {
        g.x = fminf(g.x, 7.0f); g.y = fminf(g.y, 7.0f); l.x = fminf(fmaxf(l.x, -7.0f), 7.0f); l.y = fminf(fmaxf(l.y, -7.0f), 7.0f);
        f2 t = g * (-1.702f * 1.4426950408889634f); t.x = __builtin_amdgcn_exp2f(t.x); t.y = __builtin_amdgcn_exp2f(t.y); t = t + 1.0f;
        f2 r; r.x = __builtin_amdgcn_rcpf(t.x); r.y = __builtin_amdgcn_rcpf(t.y);
        return (g * r) * (l * HID_SCALE + HID_SCALE); }
    __device__ __forceinline__ void operator()(const i32x4 (&acc)[2][2][4][2], const Unit& u, int wr, int wc, int fr, int fq) const {
        const int col0 = u.ocol0 + wc * 64 + 8 * fq; const float* bp = b1 + (size_t)u.aux * 2048 + col0; const float* sp = sb + (size_t)u.aux * 2048 + col0;
        f32x4 bv[2][2], sv[2][2]; float av[2][4];
#pragma unroll
        for (int bj = 0; bj < 2; ++bj)
#pragma unroll
            for (int n = 0; n < 2; ++n) { bv[bj][n] = *(const f32x4*)(bp + bj * 32 + 4 * n); sv[bj][n] = *(const f32x4*)(sp + bj * 32 + 4 * n); }
#pragma unroll
        for (int ai = 0; ai < 2; ++ai)
#pragma unroll
            for (int m = 0; m < 4; ++m) { const int r = ai * HALF + wr * 64 + m * 16 + fr; av[ai][m] = sa[u.orow0 + (r < u.nrows ? r : u.nrows - 1)]; }
#pragma unroll
        for (int ai = 0; ai < 2; ++ai) asm volatile("" : "+v"(av[ai][0]), "+v"(av[ai][1]), "+v"(av[ai][2]), "+v"(av[ai][3]));
#pragma unroll
        for (int ai = 0; ai < 2; ++ai)
#pragma unroll
            for (int m = 0; m < 4; ++m) { const int r = ai * HALF + wr * 64 + m * 16 + fr; if (r < u.nrows) { unsigned char* rowp = H + (size_t)(u.orow0 + r) * 1024 + (col0 >> 1); const float a = av[ai][m];
#pragma unroll
                for (int bj = 0; bj < 2; ++bj) { f32x4 c0, c1;
#pragma unroll
                    for (int q = 0; q < 4; ++q) { c0[q] = (float)acc[ai][bj][m][0][q]; c1[q] = (float)acc[ai][bj][m][1][q]; }
                    const f32x4 v0 = c0 * (sv[bj][0] * a) + bv[bj][0], v1 = c1 * (sv[bj][1] * a) + bv[bj][1];
                    const f2 h0 = swiglu2((f2){v0[0], v0[2]}, (f2){v0[1], v0[3]}), h1 = swiglu2((f2){v1[0], v1[2]}, (f2){v1[1], v1[3]});
                    unsigned w = 0u; w = __builtin_amdgcn_cvt_pk_fp8_f32(h0.x, h0.y, w, false); w = __builtin_amdgcn_cvt_pk_fp8_f32(h1.x, h1.y, w, true);
                    *(unsigned*)(rowp + bj * 16) = w; } } }
    }
};
struct EpiMoe2B { typedef f32x4 acc_t; static constexpr bool I8 = false, F8 = false; static constexpr bool PERM = true;
    bf16_t* O; const float* b2; const float* wpos;
    __device__ __forceinline__ void operator()(const f32x4 (&acc)[2][2][4][2], const Unit& u, int wr, int wc, int fr, int fq) const {
        const int col0 = u.ocol0 + wc * 64 + 8 * fq; const float* bp = b2 + (size_t)u.aux * 1024 + col0;
        f32x4 bv[2][2];
#pragma unroll
        for (int bj = 0; bj < 2; ++bj)
#pragma unroll
            for (int n = 0; n < 2; ++n) bv[bj][n] = *(const f32x4*)(bp + bj * 32 + 4 * n);
        float wv[2][4];
#pragma unroll
        for (int ai = 0; ai < 2; ++ai)
#pragma unroll
            for (int m = 0; m < 4; ++m) { const int r = ai * HALF + wr * 64 + m * 16 + fr; wv[ai][m] = wpos[u.orow0 + (r < u.nrows ? r : u.nrows - 1)]; }
#pragma unroll
        for (int ai = 0; ai < 2; ++ai) asm volatile("" : "+v"(wv[ai][0]), "+v"(wv[ai][1]), "+v"(wv[ai][2]), "+v"(wv[ai][3]));
#pragma unroll
        for (int ai = 0; ai < 2; ++ai)
#pragma unroll
            for (int m = 0; m < 4; ++m) { const int r = ai * HALF + wr * 64 + m * 16 + fr; if (r < u.nrows) { const float w = wv[ai][m]; bf16_t* rowp = O + (size_t)(u.orow0 + r) * 1024 + col0;
#pragma unroll
                for (int bj = 0; bj < 2; ++bj) { const f32x4 v0 = (acc[ai][bj][m][0] + bv[bj][0]) * w, v1 = (acc[ai][bj][m][1] + bv[bj][1]) * w;
                    u32x4 o; o.x = cvt_pk_bf16(v0[0], v0[1]); o.y = cvt_pk_bf16(v0[2], v0[3]); o.z = cvt_pk_bf16(v1[0], v1[1]); o.w = cvt_pk_bf16(v1[2], v1[3]);
                    *(u32x4*)(rowp + bj * 32) = o; } } }
    }
};

struct BatchOrder : DenseOrder { int bbatch_rows;
    __device__ bool next(int i, Unit& u) const { int pm, pn; if (!tile(i, pm, pn)) return false;
        u.arow0 = pm * BM; u.nrows = BM; u.acol0 = 0; u.orow0 = pm * BM; u.ocol0 = pn * BM; u.aux = 0; u.boff = ((size_t)(pm >> 3) * bbatch_rows + (size_t)pn * BM) * ldb; return true; } };
struct GtOrder { int G, c;
    __device__ bool next(int i, Unit& u) const { const int L = i * G + c; if (L >= 512) return false; const int h = L >> 7, b = (L >> 2) & 31, pn = L & 3;
        u.arow0 = b * 256; u.nrows = 256; u.acol0 = h * 256; u.boff = (size_t)pn * 256 * 1024 + h * 256; u.orow0 = b * 1024 + h * 256; u.ocol0 = pn * 256; u.aux = 0; return true; } };
struct VwtOrder { int G, c;
    __device__ bool next(int i, Unit& u) const { const int L = i * G + c; if (L >= 512) return false; const int b = L >> 4, h = (L >> 2) & 3, pm = L & 3;
        u.arow0 = pm * 256; u.nrows = 256; u.acol0 = h * 256; u.boff = (size_t)(b * 256) * 2048 + 1024 + h * 256; u.orow0 = b * 1024 + pm * 256; u.ocol0 = h * 256; u.aux = 0; return true; } };

struct EpiMoe2F8 { typedef f32x4 acc_t; static constexpr bool I8 = false, F8 = true; static constexpr bool PERM = true;
    bf16_t* O; const float* b2; const float* wpos; LAS unsigned char* stg;
    __device__ __forceinline__ void operator()(const f32x4 (&acc)[2][2][4][2], const Unit& u, int wr, int wc, int fr, int fq) const {
        const int col0 = u.ocol0 + wc * 64 + 8 * fq; const float* bp = b2 + (size_t)u.aux * 1024 + col0; const float is = 1.0f / (HID_SCALE * W2_SCALE);
        f32x4 bv[2][2];
#pragma unroll
        for (int bj = 0; bj < 2; ++bj)
#pragma unroll
            for (int n = 0; n < 2; ++n) bv[bj][n] = *(const f32x4*)(bp + bj * 32 + 4 * n);
        float wv[2][4];
#pragma unroll
        for (int ai = 0; ai < 2; ++ai)
#pragma unroll
            for (int m = 0; m < 4; ++m) { const int r = ai * HALF + wr * 64 + m * 16 + fr; wv[ai][m] = wpos[u.orow0 + (r < u.nrows ? r : u.nrows - 1)]; }
#pragma unroll
        for (int ai = 0; ai < 2; ++ai) asm volatile("" : "+v"(wv[ai][0]), "+v"(wv[ai][1]), "+v"(wv[ai][2]), "+v"(wv[ai][3]));
        LAS unsigned char* sw_ = stg + (wr * 4 + wc) * 2048;
#pragma unroll
        for (int ai = 0; ai < 2; ++ai)
#pragma unroll
            for (int m = 0; m < 4; ++m) { const int rg = ai * HALF + wr * 64 + m * 16; const float w = wv[ai][m]; u32x4 o[2];
#pragma unroll
                for (int bj = 0; bj < 2; ++bj) { const f32x4 v0 = (acc[ai][bj][m][0] * is + bv[bj][0]) * w, v1 = (acc[ai][bj][m][1] * is + bv[bj][1]) * w;
                    o[bj].x = cvt_pk_bf16(v0[0], v0[1]); o[bj].y = cvt_pk_bf16(v0[2], v0[3]); o[bj].z = cvt_pk_bf16(v1[0], v1[1]); o[bj].w = cvt_pk_bf16(v1[2], v1[3]); }
                store_rows128(sw_, O + (size_t)(u.orow0 + rg) * 1024 + u.ocol0 + wc * 64, 1024, o[0], o[1], fr, fq, u.nrows - rg); }
    }
};
struct EpiProj { typedef i32x4 acc_t; static constexpr bool I8 = true, F8 = false; static constexpr bool PERM = true;
    bf16_t* O; const float* ropec; const float* ropes; LAS unsigned char* stg; const float* sx; const float* sw; LAS unsigned char* tab;
    __device__ __forceinline__ void operator()(const i32x4 (&acc)[2][2][4][2], const Unit& u, int wr, int wc, int fr, int fq) const {
        const int region = u.ocol0 >> 9;
        const bool rope = (region != 2 && region != 5);
        const float sc = (region == 0 || region == 3) ? C2Q : 1.0f;
        const float sg = (fq == 0) ? -1.0f : 1.0f;
        const int tid = (wr * 4 + wc) * 64 + fr + 16 * fq;
        f32x4 swv[2][2]; float sxv[2][4];
#pragma unroll
        for (int bj = 0; bj < 2; ++bj)
#pragma unroll
            for (int n = 0; n < 2; ++n) swv[bj][n] = *(const f32x4*)(sw + u.ocol0 + wc * 64 + 8 * fq + bj * 32 + 4 * n) * sc;
#pragma unroll
        for (int ai = 0; ai < 2; ++ai)
#pragma unroll
            for (int m = 0; m < 4; ++m) sxv[ai][m] = sx[u.orow0 + ai * HALF + wr * 64 + m * 16 + fr];
#pragma unroll
        for (int ai = 0; ai < 2; ++ai) {
            if (rope) { const int trow = tid >> 2, tq = tid & 3, pos = (u.orow0 + ai * HALF + trow) & (SEQ - 1);
                const f32x4 tv = *(const f32x4*)((tq < 2 ? ropec : ropes) + pos * 8 + (tq & 1) * 4);
                *(LAS f32x4*)(tab + trow * 64 + tq * 16) = tv;
                asm volatile("s_waitcnt lgkmcnt(0)" ::: "memory"); __builtin_amdgcn_s_barrier(); asm volatile("" ::: "memory"); }
#pragma unroll
            for (int m = 0; m < 4; ++m) { f32x4 cs[4]; const float sxr_ = sxv[ai][m];
                if (rope) { const LAS unsigned char* tp = tab + (wr * 64 + m * 16 + fr) * 64;
                    cs[0] = *(const LAS f32x4*)(tp); cs[1] = *(const LAS f32x4*)(tp + 16); cs[2] = *(const LAS f32x4*)(tp + 32); cs[3] = *(const LAS f32x4*)(tp + 48); }
                u32x4 w[2];
#pragma unroll
                for (int bj = 0; bj < 2; ++bj) { f32x4 v0, v1;
#pragma unroll
                    for (int q = 0; q < 4; ++q) { v0[q] = (float)acc[ai][bj][m][0][q]; v1[q] = (float)acc[ai][bj][m][1][q]; }
                    v0 = v0 * (swv[bj][0] * sxr_); v1 = v1 * (swv[bj][1] * sxr_);
                    if (rope && bj == 0) { f32x4 p0, p1;
#pragma unroll
                        for (int e = 0; e < 4; ++e) { p0[e] = __shfl_xor(v0[e], 16); p1[e] = __shfl_xor(v1[e], 16); }
                        if (fq < 2) { v0 = v0 * cs[0] + p0 * (cs[2] * sg); v1 = v1 * cs[1] + p1 * (cs[3] * sg); } }
                    w[bj].x = cvt_pk_bf16(v0[0], v0[1]); w[bj].y = cvt_pk_bf16(v0[2], v0[3]); w[bj].z = cvt_pk_bf16(v1[0], v1[1]); w[bj].w = cvt_pk_bf16(v1[2], v1[3]); }
                store_rows128(stg + (wr * 4 + wc) * 2048, O + (size_t)(u.orow0 + ai * HALF + wr * 64 + m * 16) * NPROJ + u.ocol0 + wc * 64, (size_t)NPROJ, w[0], w[1], fr, fq, 16); }
            if (rope) { asm volatile("s_waitcnt lgkmcnt(0)" ::: "memory"); __builtin_amdgcn_s_barrier(); asm volatile("" ::: "memory"); }
        }
    }
};
struct EpiPlainB { typedef f32x4 acc_t; static constexpr bool I8 = false, F8 = false; static constexpr bool PERM = true;
    bf16_t* O; int ldc; LAS unsigned char* stg;
    __device__ __forceinline__ void operator()(const f32x4 (&acc)[2][2][4][2], const Unit& u, int wr, int wc, int fr, int fq) const {
        LAS unsigned char* sw_ = stg + (wr * 4 + wc) * 2048;
#pragma unroll
        for (int ai = 0; ai < 2; ++ai)
#pragma unroll
            for (int m = 0; m < 4; ++m) { u32x4 w[2];
#pragma unroll
                for (int bj = 0; bj < 2; ++bj) { const f32x4 v0 = acc[ai][bj][m][0], v1 = acc[ai][bj][m][1];
                    w[bj].x = cvt_pk_bf16(v0[0], v0[1]); w[bj].y = cvt_pk_bf16(v0[2], v0[3]); w[bj].z = cvt_pk_bf16(v1[0], v1[1]); w[bj].w = cvt_pk_bf16(v1[2], v1[3]); }
                store_rows128(sw_, O + (size_t)(u.orow0 + ai * HALF + wr * 64 + m * 16) * ldc + u.ocol0 + wc * 64, (size_t)ldc, w[0], w[1], fr, fq, 16); }
    }
};
struct EpiResidF { typedef f32x4 acc_t; static constexpr bool I8 = false, F8 = false; static constexpr bool PERM = false;
    float* O; const float* R; float alpha;
    __device__ __forceinline__ void operator()(const f32x4 (&acc)[2][2][4][2], const Unit& u, int wr, int wc, int fr, int fq) const {
        const int col0 = u.ocol0 + wc * 64 + 4 * fq;
#pragma unroll
        for (int ai = 0; ai < 2; ++ai) { f32x4 pre[4][2][2];
#pragma unroll
            for (int m = 0; m < 4; ++m) { const size_t off = (size_t)(u.orow0 + ai * HALF + wr * 64 + m * 16 + fr) * 1024 + col0;
#pragma unroll
                for (int bj = 0; bj < 2; ++bj)
#pragma unroll
                    for (int n = 0; n < 2; ++n) pre[m][bj][n] = *(const f32x4*)(R + off + bj * 32 + n * 16); }
#pragma unroll
            for (int m = 0; m < 4; ++m)
#pragma unroll
                for (int bj = 0; bj < 2; ++bj) asm volatile("" : "+v"(pre[m][bj][0]), "+v"(pre[m][bj][1]));
#pragma unroll
            for (int m = 0; m < 4; ++m) { const size_t off = (size_t)(u.orow0 + ai * HALF + wr * 64 + m * 16 + fr) * 1024 + col0;
#pragma unroll
                for (int bj = 0; bj < 2; ++bj)
#pragma unroll
                    for (int n = 0; n < 2; ++n) *(f32x4*)(O + off + bj * 32 + n * 16) = pre[m][bj][n] * alpha + acc[ai][bj][m][n]; }
            asm volatile("" ::: "memory"); }
    }
};
struct EpiResidStats { typedef f32x4 acc_t; static constexpr bool I8 = false, F8 = false; static constexpr bool PERM = false;
    bf16_t* Ob; const float* R; long long* st; float alpha;
    __device__ __forceinline__ void operator()(const f32x4 (&acc)[2][2][4][2], const Unit& u, int wr, int wc, int fr, int fq) const {
        const int col0 = u.ocol0 + wc * 64 + 4 * fq;
#pragma unroll
        for (int ai = 0; ai < 2; ++ai) { f32x4 pre[4][2][2];
#pragma unroll
            for (int m = 0; m < 4; ++m) { const size_t off = (size_t)(u.orow0 + ai * HALF + wr * 64 + m * 16 + fr) * 1024 + col0;
#pragma unroll
                for (int bj = 0; bj < 2; ++bj)
#pragma unroll
                    for (int n = 0; n < 2; ++n) pre[m][bj][n] = __builtin_nontemporal_load((const f32x4*)(R + off + bj * 32 + n * 16)); }
#pragma unroll
            for (int m = 0; m < 4; ++m)
#pragma unroll
                for (int bj = 0; bj < 2; ++bj) asm volatile("" : "+v"(pre[m][bj][0]), "+v"(pre[m][bj][1]));
#pragma unroll
            for (int m = 0; m < 4; ++m) { const int row = u.orow0 + ai * HALF + wr * 64 + m * 16 + fr; const size_t off = (size_t)row * 1024 + col0; float s1 = 0.f, s2 = 0.f;
#pragma unroll
                for (int bj = 0; bj < 2; ++bj)
#pragma unroll
                    for (int n = 0; n < 2; ++n) { const f32x4 v = pre[m][bj][n] * alpha + acc[ai][bj][m][n];
                        u32x2 w; w.x = cvt_pk_bf16(v[0], v[1]); w.y = cvt_pk_bf16(v[2], v[3]); *(u32x2*)(Ob + off + bj * 32 + n * 16) = w;
                        s1 += (v[0] + v[1]) + (v[2] + v[3]); s2 += (v[0] * v[0] + v[1] * v[1]) + (v[2] * v[2] + v[3] * v[3]); }
                s1 += __shfl_xor(s1, 16); s1 += __shfl_xor(s1, 32); s2 += __shfl_xor(s2, 16); s2 += __shfl_xor(s2, 32);
                if (fq == 0) { fx_add(st + 2 * (size_t)row, s1); fx_add(st + 2 * (size_t)row + 1, s2); } }
            asm volatile("" ::: "memory"); }
    }
};
struct EpiResidLN { typedef f32x4 acc_t; static constexpr bool I8 = false, F8 = false; static constexpr bool PERM = false;
    bf16_t* O; const bf16_t* R; const long long* st; const float* g; const float* bb; float alpha;
    __device__ __forceinline__ void operator()(const f32x4 (&acc)[2][2][4][2], const Unit& u, int wr, int wc, int fr, int fq) const {
        const int col0 = u.ocol0 + wc * 64 + 4 * fq;
        f32x4 gv[2][2], bv[2][2];
#pragma unroll
        for (int bj = 0; bj < 2; ++bj)
#pragma unroll
            for (int n = 0; n < 2; ++n) { gv[bj][n] = *(const f32x4*)(g + col0 + bj * 32 + n * 16); bv[bj][n] = *(const f32x4*)(bb + col0 + bj * 32 + n * 16); }
#pragma unroll
        for (int ai = 0; ai < 2; ++ai) { u32x2 pre[4][2][2]; float mu[4], rs[4];
#pragma unroll
            for (int m = 0; m < 4; ++m) { const int row = u.orow0 + ai * HALF + wr * 64 + m * 16 + fr; const size_t off = (size_t)row * 1024 + col0;
                mu[m] = fx_get(st + 2 * (size_t)row); rs[m] = fx_get(st + 2 * (size_t)row + 1);
#pragma unroll
                for (int bj = 0; bj < 2; ++bj)
#pragma unroll
                    for (int n = 0; n < 2; ++n) pre[m][bj][n] = *(const u32x2*)(R + off + bj * 32 + n * 16); }
#pragma unroll
            for (int m = 0; m < 4; ++m) { asm volatile("" : "+v"(mu[m]), "+v"(rs[m]));
#pragma unroll
                for (int bj = 0; bj < 2; ++bj) asm volatile("" : "+v"(pre[m][bj][0]), "+v"(pre[m][bj][1])); }
#pragma unroll
            for (int m = 0; m < 4; ++m) { const size_t off = (size_t)(u.orow0 + ai * HALF + wr * 64 + m * 16 + fr) * 1024 + col0;
                const float mean = mu[m] * (1.0f / 1024.0f), rstd = 1.0f / sqrtf(fmaxf(rs[m] * (1.0f / 1024.0f) - mean * mean, 0.f) + LN_EPS);
#pragma unroll
                for (int bj = 0; bj < 2; ++bj)
#pragma unroll
                    for (int n = 0; n < 2; ++n) { const u32x2 p = pre[m][bj][n]; const f32x4 t = {__uint_as_float(p.x << 16), __uint_as_float(p.x & 0xffff0000u), __uint_as_float(p.y << 16), __uint_as_float(p.y & 0xffff0000u)};
                        const f32x4 v = ((t - mean) * rstd * gv[bj][n] + bv[bj][n]) * alpha + acc[ai][bj][m][n];
                        u32x2 w; w.x = cvt_pk_bf16(v[0], v[1]); w.y = cvt_pk_bf16(v[2], v[3]); *(u32x2*)(O + off + bj * 32 + n * 16) = w; } }
            asm volatile("" ::: "memory"); }
    }
};
struct EpiGT { typedef f32x4 acc_t; static constexpr bool I8 = false, F8 = false; static constexpr bool PERM = true;
    bf16_t* O; const float* g; const float* bb; long long* cs; long long* bfs; LAS unsigned char* stg;
    __device__ __forceinline__ void operator()(const f32x4 (&acc)[2][2][4][2], const Unit& u, int wr, int wc, int fr, int fq) const {
        const int col0 = u.ocol0 + wc * 64 + 8 * fq;
        f32x4 gv[2][2], bv[2][2];
#pragma unroll
        for (int bj = 0; bj < 2; ++bj)
#pragma unroll
            for (int n = 0; n < 2; ++n) { gv[bj][n] = *(const f32x4*)(g + col0 + bj * 32 + 4 * n); bv[bj][n] = *(const f32x4*)(bb + col0 + bj * 32 + 4 * n); }
#pragma unroll
        for (int ai = 0; ai < 2; ++ai)
#pragma unroll
            for (int m = 0; m < 4; ++m) { const int row = u.orow0 + ai * HALF + wr * 64 + m * 16 + fr; float s1 = 0.f, s2 = 0.f; u32x4 wq[2];
#pragma unroll
                for (int bj = 0; bj < 2; ++bj) { const f32x4 a0 = acc[ai][bj][m][0], a1 = acc[ai][bj][m][1]; const f32x4 v0 = a0 * gv[bj][0], v1 = a1 * gv[bj][1], w0 = a0 * bv[bj][0], w1 = a1 * bv[bj][1];
                    wq[bj].x = cvt_pk_bf16(v0[0], v0[1]); wq[bj].y = cvt_pk_bf16(v0[2], v0[3]); wq[bj].z = cvt_pk_bf16(v1[0], v1[1]); wq[bj].w = cvt_pk_bf16(v1[2], v1[3]);
                    s1 += ((v0[0] + v0[1]) + (v0[2] + v0[3])) + ((v1[0] + v1[1]) + (v1[2] + v1[3])); s2 += ((w0[0] + w0[1]) + (w0[2] + w0[3])) + ((w1[0] + w1[1]) + (w1[2] + w1[3])); }
                store_rows128(stg + (wr * 4 + wc) * 2048, O + (size_t)(row - fr) * 1024 + u.ocol0 + wc * 64, 1024, wq[0], wq[1], fr, fq, 16);
                s1 += __shfl_xor(s1, 16); s1 += __shfl_xor(s1, 32); s2 += __shfl_xor(s2, 16); s2 += __shfl_xor(s2, 32);
                if (fq == 0) { fx_add(cs + row, s1); fx_add(bfs + row, s2); } }
    }
};
struct EpiSoftmaxP { typedef f32x4 acc_t; static constexpr bool I8 = false, F8 = false; static constexpr bool PERM = true;
    bf16_t* O; LAS unsigned char* xs; LAS unsigned char* stg; const long long* st; const long long* cs; const long long* bfs;
    __device__ __forceinline__ void operator()(const f32x4 (&acc)[2][2][4][2], const Unit& u, int wr, int wc, int fr, int fq) const {
        typedef float f32x2v __attribute__((ext_vector_type(2)));
        LAS f32x2v* X = (LAS f32x2v*)xs;
        f32x4 e[2][4][2][2]; float mw[2][4];
        const int cc0 = (u.orow0 >> 11) * 1024 + u.ocol0 + wc * 64 + 8 * fq;
        f32x4 cv[2][2], fv[2][2]; float mu[2][4], rs[2][4];
#pragma unroll
        for (int bj = 0; bj < 2; ++bj)
#pragma unroll
            for (int n = 0; n < 2; ++n)
#pragma unroll
                for (int q = 0; q < 4; ++q) { cv[bj][n][q] = fx_get(cs + cc0 + bj * 32 + 4 * n + q); fv[bj][n][q] = fx_get(bfs + cc0 + bj * 32 + 4 * n + q); }
#pragma unroll
        for (int ai = 0; ai < 2; ++ai)
#pragma unroll
            for (int m = 0; m < 4; ++m) { const size_t row = (size_t)(u.orow0 + ai * HALF + wr * 64 + m * 16 + fr); mu[ai][m] = fx_get(st + 2 * row); rs[ai][m] = fx_get(st + 2 * row + 1); }
#pragma unroll
        for (int ai = 0; ai < 2; ++ai) asm volatile("" : "+v"(mu[ai][0]), "+v"(mu[ai][1]), "+v"(mu[ai][2]), "+v"(mu[ai][3]), "+v"(rs[ai][0]), "+v"(rs[ai][1]), "+v"(rs[ai][2]), "+v"(rs[ai][3]));
#pragma unroll
        for (int ai = 0; ai < 2; ++ai)
#pragma unroll
            for (int m = 0; m < 4; ++m) { float mx = -INFINITY; const float mean = mu[ai][m] * (1.0f / 1024.0f), rstd = 1.0f / sqrtf(fmaxf(rs[ai][m] * (1.0f / 1024.0f) - mean * mean, 0.f) + LN_EPS);
#pragma unroll
                for (int bj = 0; bj < 2; ++bj)
#pragma unroll
                    for (int n = 0; n < 2; ++n) { const f32x4 v = ((acc[ai][bj][m][n] - cv[bj][n] * mean) * rstd + fv[bj][n]) * C2M; e[ai][m][bj][n] = v; mx = fmaxf(mx, fmaxf(fmaxf(v[0], v[1]), fmaxf(v[2], v[3]))); }
                mx = fmaxf(mx, __shfl_xor(mx, 16)); mx = fmaxf(mx, __shfl_xor(mx, 32)); float sm = 0.f;
#pragma unroll
                for (int bj = 0; bj < 2; ++bj)
#pragma unroll
                    for (int n = 0; n < 2; ++n) { f32x4 v = e[ai][m][bj][n];
#pragma unroll
                        for (int q = 0; q < 4; ++q) { v[q] = __builtin_amdgcn_exp2f(v[q] - mx); sm += v[q]; }
                        e[ai][m][bj][n] = v; }
                sm += __shfl_xor(sm, 16); sm += __shfl_xor(sm, 32); mw[ai][m] = mx;
                if (fq == 0) X[(ai * HALF + wr * 64 + m * 16 + fr) * 4 + wc] = (f32x2v){mx, sm}; }
        asm volatile("s_waitcnt lgkmcnt(0)" ::: "memory"); __builtin_amdgcn_s_barrier(); asm volatile("" ::: "memory");
        const int col0 = u.ocol0 + wc * 64 + 8 * fq;
#pragma unroll
        for (int ai = 0; ai < 2; ++ai)
#pragma unroll
            for (int m = 0; m < 4; ++m) { const int r = ai * HALF + wr * 64 + m * 16 + fr;
                const f32x2v a = X[r * 4 + 0], b = X[r * 4 + 1], c = X[r * 4 + 2], d = X[r * 4 + 3];
                const float mt = fmaxf(fmaxf(a.x, b.x), fmaxf(c.x, d.x));
                const float st = a.y * __builtin_amdgcn_exp2f(a.x - mt) + b.y * __builtin_amdgcn_exp2f(b.x - mt) + c.y * __builtin_amdgcn_exp2f(c.x - mt) + d.y * __builtin_amdgcn_exp2f(d.x - mt);
                const float f = __builtin_amdgcn_exp2f(mw[ai][m] - mt) / st;
                u32x4 w[2];
#pragma unroll
                for (int bj = 0; bj < 2; ++bj) { const f32x4 v0 = e[ai][m][bj][0] * f, v1 = e[ai][m][bj][1] * f;
                    w[bj].x = cvt_pk_bf16(v0[0], v0[1]); w[bj].y = cvt_pk_bf16(v0[2], v0[3]); w[bj].z = cvt_pk_bf16(v1[0], v1[1]); w[bj].w = cvt_pk_bf16(v1[2], v1[3]); }
                store_rows128(stg + (wr * 4 + wc) * 2048, O + (size_t)(u.orow0 + r - fr) * 1024 + u.ocol0 + wc * 64, 1024, w[0], w[1], fr, fq, 16); }
    }
};
}


__device__ __forceinline__ float4 ldnt4(const float* p) { const f32x4 v = __builtin_nontemporal_load((const f32x4*)p); return make_float4(v[0], v[1], v[2], v[3]); }
__device__ __forceinline__ void stnt4(float* p, float4 v) { __builtin_nontemporal_store((f32x4){v.x, v.y, v.z, v.w}, (f32x4*)p); }
__device__ __forceinline__ void transpose_item(const float* W, int K, int N, unsigned short* WT, LAS float* scr, int item, int lane) {
    const int nblk = N / 32, kb = item / nblk, nb = item % nblk, k0 = 64 * kb, n0 = 32 * nb;
#pragma unroll
    for (int i = 0; i < 8; ++i) { const int kk = 8 * i + (lane >> 3); const float4 v = ldnt4(W + (size_t)(k0 + kk) * N + n0 + 4 * (lane & 7));
        LAS float* d = scr + kk * 33 + 4 * (lane & 7); d[0] = v.x; d[1] = v.y; d[2] = v.z; d[3] = v.w; }
    WSYNC();
    const int c = lane & 7;
#pragma unroll
    for (int j = 0; j < 4; ++j) { const int n = (lane >> 3) + 8 * j; const LAS float* sp = scr + (8 * c) * 33 + n;
        g8::u32x4 o; o.x = g8::cvt_pk_bf16(sp[0 * 33], sp[1 * 33]); o.y = g8::cvt_pk_bf16(sp[2 * 33], sp[3 * 33]); o.z = g8::cvt_pk_bf16(sp[4 * 33], sp[5 * 33]); o.w = g8::cvt_pk_bf16(sp[6 * 33], sp[7 * 33]);
        *(g8::u32x4*)(WT + (size_t)(n0 + n) * K + k0 + 8 * c) = o; }
    WSYNC();
}
__device__ __forceinline__ void quant_w1_block(const float* W, int N, signed char* Q, float* sbo, LAS float* stage, LAS float* red, int nb, int tid) {
    const int lane = tid & 63, wave = tid >> 6, n0 = 32 * nb;
    float4 m4 = make_float4(0.f, 0.f, 0.f, 0.f);
    const float* wp = W + (size_t)(128 * wave + (lane >> 3)) * N + n0 + 4 * (lane & 7);
    LAS float* dp = stage + (128 * wave + (lane >> 3)) * 33 + 4 * (lane & 7);
#pragma unroll 8
    for (int i = 0; i < 16; ++i) { const float4 v = ldnt4(wp + (size_t)i * 8 * N); LAS float* d = dp + i * 8 * 33; d[0] = v.x; d[1] = v.y; d[2] = v.z; d[3] = v.w;
        m4.x = fmaxf(m4.x, fabsf(v.x)); m4.y = fmaxf(m4.y, fabsf(v.y)); m4.z = fmaxf(m4.z, fabsf(v.z)); m4.w = fmaxf(m4.w, fabsf(v.w)); }
#pragma unroll
    for (int o = 8; o < 64; o <<= 1) { m4.x = fmaxf(m4.x, __shfl_xor(m4.x, o)); m4.y = fmaxf(m4.y, __shfl_xor(m4.y, o)); m4.z = fmaxf(m4.z, __shfl_xor(m4.z, o)); m4.w = fmaxf(m4.w, __shfl_xor(m4.w, o)); }
    if (lane < 8) { LAS float* r = red + wave * 32 + 4 * lane; r[0] = m4.x; r[1] = m4.y; r[2] = m4.z; r[3] = m4.w; }
    __syncthreads();
    const int n = tid & 31, kc = tid >> 5;
    float mx = 0.f;
#pragma unroll
    for (int w = 0; w < 8; ++w) mx = fmaxf(mx, red[w * 32 + n]);
    mx = fmaxf(mx, 1e-30f);
    const float iv = 127.0f / mx;
    if (tid < 32) sbo[n0 + tid] = mx * (1.0f / 127.0f);
    const LAS float* sp = stage + (64 * kc) * 33 + n;
#pragma unroll
    for (int j = 0; j < 4; ++j) { g8::u32x4 o;
#pragma unroll
        for (int d = 0; d < 4; ++d) { unsigned w = 0u;
#pragma unroll
            for (int q = 0; q < 4; ++q) w |= ((unsigned)(int)rintf(sp[(16 * j + 4 * d + q) * 33] * iv) & 0xffu) << (8 * q);
            o[d] = w; }
        *(g8::u32x4*)(Q + (size_t)(n0 + n) * 1024 + 64 * kc + 16 * j) = o; }
    __syncthreads();
}
__device__ __forceinline__ void quant_w1_item(const float* W, int N, signed char* Q, float* sbo, LAS float* scr, int nb, int lane) {
    const int n0 = 32 * nb;
    float4 m4 = make_float4(0.f, 0.f, 0.f, 0.f);
    const float* wp = W + (size_t)(lane >> 3) * N + n0 + 4 * (lane & 7);
#pragma unroll 1
    for (int kb = 0; kb < 16; ++kb) {
#pragma unroll
        for (int i = 0; i < 8; ++i) { const float4 v = *(const float4*)(wp + (size_t)i * 8 * N); m4.x = fmaxf(m4.x, fabsf(v.x)); m4.y = fmaxf(m4.y, fabsf(v.y)); m4.z = fmaxf(m4.z, fabsf(v.z)); m4.w = fmaxf(m4.w, fabsf(v.w)); }
        wp += (size_t)64 * N; }
#pragma unroll
    for (int o = 8; o < 64; o <<= 1) { m4.x = fmaxf(m4.x, __shfl_xor(m4.x, o)); m4.y = fmaxf(m4.y, __shfl_xor(m4.y, o)); m4.z = fmaxf(m4.z, __shfl_xor(m4.z, o)); m4.w = fmaxf(m4.w, __shfl_xor(m4.w, o)); }
    float mx; { const int src = (lane & 31) >> 2, cmp = lane & 3; const float a = __shfl(m4.x, src), b = __shfl(m4.y, src), c2 = __shfl(m4.z, src), d = __shfl(m4.w, src); mx = cmp == 0 ? a : cmp == 1 ? b : cmp == 2 ? c2 : d; }
    mx = fmaxf(mx, 1e-30f);
    const float inv = 127.0f / mx;
    if (lane < 32) sbo[n0 + lane] = mx * (1.0f / 127.0f);
    const int c = lane & 7;
    wp = W + (size_t)(lane >> 3) * N + n0 + 4 * (lane & 7);
#pragma unroll 1
    for (int kb = 0; kb < 16; ++kb) { const int k0 = 64 * kb;
#pragma unroll
        for (int i = 0; i < 8; ++i) { const float4 v = ldnt4(wp + (size_t)i * 8 * N); LAS float* d = scr + (8 * i + (lane >> 3)) * 33 + 4 * (lane & 7); d[0] = v.x; d[1] = v.y; d[2] = v.z; d[3] = v.w; }
        wp += (size_t)64 * N;
        WSYNC();
#pragma unroll
        for (int j = 0; j < 4; ++j) { const int n = (lane >> 3) + 8 * j; const LAS float* sp = scr + (8 * c) * 33 + n; const float iv = __shfl(inv, n);
            unsigned lo = 0u, hi = 0u;
#pragma unroll
            for (int q = 0; q < 4; ++q) { lo |= ((unsigned)(int)rintf(sp[q * 33] * iv) & 0xffu) << (8 * q); hi |= ((unsigned)(int)rintf(sp[(q + 4) * 33] * iv) & 0xffu) << (8 * q); }
            g8::u32x2 o; o.x = lo; o.y = hi; *(g8::u32x2*)(Q + (size_t)(n0 + n) * 1024 + k0 + 8 * c) = o; }
        WSYNC(); }
}
__device__ __forceinline__ void transpose_item_f8(const float* W, int K, int N, unsigned char* WT, float scale, LAS float* scr, int item, int lane) {
    const int nblk = N / 32, kb = item / nblk, nb = item % nblk, k0 = 64 * kb, n0 = 32 * nb;
#pragma unroll
    for (int i = 0; i < 8; ++i) { const int kk = 8 * i + (lane >> 3); const float4 v = ldnt4(W + (size_t)(k0 + kk) * N + n0 + 4 * (lane & 7));
        LAS float* d = scr + kk * 33 + 4 * (lane & 7); d[0] = v.x; d[1] = v.y; d[2] = v.z; d[3] = v.w; }
    WSYNC();
    const int c = lane & 7;
#pragma unroll
    for (int j = 0; j < 4; ++j) { const int n = (lane >> 3) + 8 * j; const LAS float* sp = scr + (8 * c) * 33 + n;
        unsigned lo = 0u, hi = 0u;
        lo = __builtin_amdgcn_cvt_pk_fp8_f32(sp[0 * 33] * scale, sp[1 * 33] * scale, lo, false); lo = __builtin_amdgcn_cvt_pk_fp8_f32(sp[2 * 33] * scale, sp[3 * 33] * scale, lo, true);
        hi = __builtin_amdgcn_cvt_pk_fp8_f32(sp[4 * 33] * scale, sp[5 * 33] * scale, hi, false); hi = __builtin_amdgcn_cvt_pk_fp8_f32(sp[6 * 33] * scale, sp[7 * 33] * scale, hi, true);
        g8::u32x2 o; o.x = lo; o.y = hi; *(g8::u32x2*)(WT + (size_t)(n0 + n) * K + k0 + 8 * c) = o; }
    WSYNC();
}
__device__ __forceinline__ float bf2f(unsigned short h) { return __uint_as_float((unsigned)h << 16); }
__device__ __forceinline__ void ln_wave(float4 (&v)[4], const float* g, const float* bta, int lane) {
    float s = 0.f;
#pragma unroll
    for (int j = 0; j < 4; ++j) s += (v[j].x + v[j].y) + (v[j].z + v[j].w);
    const float mean = wave_sum(s) * (1.f / D); float s2 = 0.f;
#pragma unroll
    for (int j = 0; j < 4; ++j) { v[j].x -= mean; v[j].y -= mean; v[j].z -= mean; v[j].w -= mean; s2 += (v[j].x * v[j].x + v[j].y * v[j].y) + (v[j].z * v[j].z + v[j].w * v[j].w); }
    const float rstd = 1.f / sqrtf(wave_sum(s2) * (1.f / D) + LN_EPS);
#pragma unroll
    for (int j = 0; j < 4; ++j) { const float4 gg = *(const float4*)(g + 4 * lane + 256 * j), bb = *(const float4*)(bta + 4 * lane + 256 * j);
        v[j].x = v[j].x * rstd * gg.x + bb.x; v[j].y = v[j].y * rstd * gg.y + bb.y; v[j].z = v[j].z * rstd * gg.z + bb.z; v[j].w = v[j].w * rstd * gg.w + bb.w; }
}


__device__ __forceinline__ float dot64_bf16(const unsigned short* kp, const LAS float* qv) {
    float s = 0.f;
#pragma unroll
    for (int c = 0; c < 8; ++c) { const g8::u32x4 kk = *(const g8::u32x4*)(kp + c * 8); const f32x4 q0 = *(const LAS f32x4*)(qv + c * 8), q1 = *(const LAS f32x4*)(qv + c * 8 + 4);
        s += __uint_as_float(kk.x << 16) * q0[0] + __uint_as_float(kk.x & 0xffff0000u) * q0[1] + __uint_as_float(kk.y << 16) * q0[2] + __uint_as_float(kk.y & 0xffff0000u) * q0[3]
           + __uint_as_float(kk.z << 16) * q1[0] + __uint_as_float(kk.z & 0xffff0000u) * q1[1] + __uint_as_float(kk.w << 16) * q1[2] + __uint_as_float(kk.w & 0xffff0000u) * q1[3]; }
    return s;
}
__device__ __forceinline__ unsigned short f2bf(float f) { return (unsigned short)(g8::cvt_pk_bf16(f, 0.f) & 0xffffu); }


namespace attn2 {
using bf16=__hip_bfloat16;
using bf16x8=__attribute__((ext_vector_type(8)))short;
using s16x4=__attribute__((ext_vector_type(4)))short;
using f32x16=__attribute__((ext_vector_type(16)))float;
using u32x4=__attribute__((ext_vector_type(4)))unsigned;
constexpr int SEQ=2048,D=64,PQ=3072,PO=1024;
constexpr int NW=8,QBLK=32,QB=QBLK*NW,KVBLK=64,NQB=SEQ/QB;
__device__ __forceinline__ int crow(int r,int hi){return (r&3)+8*(r>>2)+4*hi;}
#define SBAR() __builtin_amdgcn_sched_barrier(0)
__device__ __forceinline__ void cmask(f32x16&p0,f32x16&p1,int jb,int qrel,int hi){
  const float NEG=-INFINITY; int kb=64*jb+4*hi;
  #pragma unroll
  for(int r=0;r<16;++r){int kv=kb+(r&3)+8*(r>>2); if(kv>qrel)p0[r]=NEG; if(kv+32>qrel)p1[r]=NEG;}
}

constexpr int NSLOT=3, SLOTB=8192;
constexpr int LDS_K=0, LDS_V=NSLOT*SLOTB, LDS_WS=2*NSLOT*SLOTB, LDS_OST=LDS_WS+NW*64*4, LDS_BYTES=LDS_OST+NW*4096;
constexpr float C2=0.125f*1.4426950408889634f;
__device__ __forceinline__ void glds16(const void*gsrc,unsigned lds_dst){unsigned keep;
  asm volatile("s_mov_b32 %0, m0\n\ts_mov_b32 m0, %2\n\ts_nop 0\n\tglobal_load_lds_dwordx4 %1, off\n\ts_mov_b32 m0, %0":"=&s"(keep):"v"(gsrc),"s"(lds_dst):"memory");}
__device__ __forceinline__ float max3f(float a,float b,float c){float r;asm("v_max3_f32 %0, %1, %2, %3":"=v"(r):"v"(a),"v"(b),"v"(c));return r;}
__device__ __forceinline__ float max2f(float a,float b){float r;asm("v_max_f32_e32 %0, %1, %2":"=v"(r):"v"(a),"v"(b));return r;}
__device__ __forceinline__ float fadd_s(float a,float b){float r;asm("v_add_f32_e32 %0, %1, %2":"=v"(r):"v"(a),"v"(b));return r;}
__device__ __forceinline__ float fsub_s(float a,float b){float r;asm("v_sub_f32_e32 %0, %1, %2":"=v"(r):"v"(a),"v"(b));return r;}
typedef float f32x4_t __attribute__((ext_vector_type(4)));
__device__ __forceinline__ float bfs(short h){return __uint_as_float(((unsigned)(unsigned short)h)<<16);}
typedef float f32x2_t __attribute__((ext_vector_type(2))); typedef __bf16 bf16x2_t __attribute__((ext_vector_type(2)));
__device__ __forceinline__ unsigned cvtpk_s(float lo,float hi){f32x2_t v={lo,hi};bf16x2_t b=__builtin_convertvector(v,bf16x2_t);return __builtin_bit_cast(unsigned,b);}
#define WAIT_BAR(N) asm volatile("s_waitcnt vmcnt(" #N ") lgkmcnt(0)\n\ts_barrier":::"memory")

__device__ __forceinline__ void qkt(f32x16&p0,f32x16&p1,const char*Kslot,const bf16x8*qr,int r32,int hi){ const f32x16 negm=f32x16{};
  const char*kb=Kslot+hi*1024+r32*16;
  #pragma unroll
  for(int d0=0;d0<4;++d0){
    const bf16x8 b0=*reinterpret_cast<const bf16x8*>(kb+d0*2048);
    const bf16x8 b1=*reinterpret_cast<const bf16x8*>(kb+d0*2048+512);
    if(d0==0){p0=__builtin_amdgcn_mfma_f32_32x32x16_bf16(b0,qr[0],negm,0,0,0);p1=__builtin_amdgcn_mfma_f32_32x32x16_bf16(b1,qr[0],negm,0,0,0);}
    else{p0=__builtin_amdgcn_mfma_f32_32x32x16_bf16(b0,qr[d0],p0,0,0,0);p1=__builtin_amdgcn_mfma_f32_32x32x16_bf16(b1,qr[d0],p1,0,0,0);}}
}
typedef __attribute__((address_space(3))) const char* lds_cptr;
typedef short v4i16_t __attribute__((ext_vector_type(4)));
__device__ __forceinline__ void kload8(bf16x8*kf,lds_cptr kp){
  kf[0]=*(const __attribute__((address_space(3))) bf16x8*)(kp);      kf[1]=*(const __attribute__((address_space(3))) bf16x8*)(kp+512);
  kf[2]=*(const __attribute__((address_space(3))) bf16x8*)(kp+2048); kf[3]=*(const __attribute__((address_space(3))) bf16x8*)(kp+2560);
  kf[4]=*(const __attribute__((address_space(3))) bf16x8*)(kp+4096); kf[5]=*(const __attribute__((address_space(3))) bf16x8*)(kp+4608);
  kf[6]=*(const __attribute__((address_space(3))) bf16x8*)(kp+6144); kf[7]=*(const __attribute__((address_space(3))) bf16x8*)(kp+6656);
}
__device__ __forceinline__ void kload2(bf16x8*kf,lds_cptr kp,int j){ kf[2*j]=*(const __attribute__((address_space(3))) bf16x8*)(kp+j*2048); kf[2*j+1]=*(const __attribute__((address_space(3))) bf16x8*)(kp+j*2048+512); }
__device__ __forceinline__ s16x4 vtr(lds_cptr p){ return __builtin_bit_cast(s16x4,__builtin_amdgcn_ds_read_tr16_b64_v4i16((__attribute__((address_space(3))) v4i16_t*)p)); }
__device__ __forceinline__ float rowmax(const f32x16&p0,const f32x16&p1){
  float a=max3f(p0[0],p0[1],p1[0]),b=max3f(p0[2],p0[3],p1[1]);a=max3f(a,p1[2],p1[3]);
  #pragma unroll
  for(int r=4;r<16;r+=4){a=max3f(a,p0[r],p0[r+1]);b=max3f(b,p0[r+2],p0[r+3]);a=max3f(a,p1[r],p1[r+1]);b=max3f(b,p1[r+2],p1[r+3]);}
  const float m=max2f(a,b);
  auto rr=__builtin_amdgcn_permlane32_swap(__float_as_uint(m),__float_as_uint(m),false,false);
  return max2f(__uint_as_float(rr[0]),__uint_as_float(rr[1]));
}
__device__ __forceinline__ void pv(f32x16*o,int vb,bf16x8 pa0,bf16x8 pa1,bf16x8 pa2,bf16x8 pa3){
  #pragma unroll
  for(int d0=0;d0<2;++d0){s16x4 lo[4],hi[4];
    #pragma unroll
    for(int ks=0;ks<4;++ks){
      asm volatile("ds_read_b64_tr_b16 %0,%1 offset:%c2":"=&v"(lo[ks]):"v"(vb),"i"(d0*4096+ks*1024):"memory");
      asm volatile("ds_read_b64_tr_b16 %0,%1 offset:%c2":"=&v"(hi[ks]):"v"(vb),"i"(d0*4096+ks*1024+512):"memory");}
    asm volatile("s_waitcnt lgkmcnt(0)":::"memory");SBAR();
    #define PK(k) (bf16x8){lo[k][0],lo[k][1],lo[k][2],lo[k][3],hi[k][0],hi[k][1],hi[k][2],hi[k][3]}
    o[d0]=__builtin_amdgcn_mfma_f32_32x32x16_bf16(pa0,PK(0),o[d0],0,0,0);
    o[d0]=__builtin_amdgcn_mfma_f32_32x32x16_bf16(pa1,PK(1),o[d0],0,0,0);
    o[d0]=__builtin_amdgcn_mfma_f32_32x32x16_bf16(pa2,PK(2),o[d0],0,0,0);
    o[d0]=__builtin_amdgcn_mfma_f32_32x32x16_bf16(pa3,PK(3),o[d0],0,0,0);
    #undef PK
  }
}

#ifndef ATTN_STORE16
#define ATTN_STORE16(p,v) (*(u32x4*)(p)=(v))
#endif
template<int THRL> __device__ __forceinline__ void attn_unit(int b,int qb,const bool MOBA,const bf16*Qp,const bf16*__restrict__ Kp,const bf16*__restrict__ Vp,bf16*Op,const float*kmean_bh,char*shm){
  int tid_=threadIdx.x; asm volatile("":"+v"(tid_));
  const int tid=tid_,lane=tid&63,r32=lane&31,hi=lane>>5; const int wid=__builtin_amdgcn_readfirstlane(tid>>6);
  const long rowbase=(long)b*SEQ; const int q0=qb*QB;
  const bf16*Qw=Qp+(rowbase+q0+wid*QBLK)*PQ;
  const bf16*Kh=Kp+rowbase*PQ,*Vh=Vp+rowbase*PQ;
  const unsigned lds0=(unsigned)(uintptr_t)shm;
  float*wsf=(float*)(shm+LDS_WS)+wid*64;
  const bf16*ksrc=Kh+(long)lane*PQ+wid*8;
  const bf16*vsrc=Vh+(long)(16*(wid&3)+(lane>>2))*PQ+(wid>>2)*32+(lane&3)*8;
  const unsigned kdst=lds0+LDS_K+wid*1024, vdst=lds0+LDS_V+wid*1024;
  #define TILE(t) (((t)<4)?(NT-4+(t)):((t)-4))
  #define DMA_K(t,slot) glds16(ksrc+(long)TILE(t)*KVBLK*PQ,(unsigned)__builtin_amdgcn_readfirstlane(kdst+(slot)))
  #define DMA_V(t,slot) glds16(vsrc+(long)TILE(t)*KVBLK*PQ,(unsigned)__builtin_amdgcn_readfirstlane(vdst+(slot)))
  const int vb0=(int)(lds0+LDS_V)+((lane>>4)&1)*32+(lane&3)*8+(4*hi+((lane&15)>>2))*64;
  const char*Kbase=shm+LDS_K; bf16x8 kf[8];
  const lds_cptr shm3=(lds_cptr)shm; const lds_cptr kp0=shm3+LDS_K+hi*1024+r32*16; const lds_cptr vp0=shm3+LDS_V+((lane>>4)&1)*32+(lane&3)*8+(4*hi+((lane&15)>>2))*64;
  const int NT=(q0+QB)/KVBLK;
  DMA_K(0,0);DMA_V(0,0);DMA_K(1,SLOTB);
  bf16x8 qr[4];
  #pragma unroll
  for(int d0=0;d0<4;++d0)qr[d0]=*reinterpret_cast<const bf16x8*>(&Qw[(long)r32*PQ+d0*16+hi*8]);
  unsigned selmask=0xffu;
  if(MOBA&&qb>=4){ float g[8];
    #pragma unroll
    for(int n=0;n<8;++n){ g[n]=-INFINITY; if(n<qb){ float s=0.f; const float*km=kmean_bh+n*64+hi*8;
        #pragma unroll
        for(int d0=0;d0<4;++d0){ const f32x4_t k0=*reinterpret_cast<const f32x4_t*>(km+d0*16),k1=*reinterpret_cast<const f32x4_t*>(km+d0*16+4); const bf16x8 qq=qr[d0];
          s+=bfs(qq[0])*k0[0]+bfs(qq[1])*k0[1]+bfs(qq[2])*k0[2]+bfs(qq[3])*k0[3]+bfs(qq[4])*k1[0]+bfs(qq[5])*k1[1]+bfs(qq[6])*k1[2]+bfs(qq[7])*k1[3]; }
        auto rr=__builtin_amdgcn_permlane32_swap(__float_as_uint(s),__float_as_uint(s),false,false); g[n]=__uint_as_float(rr[0])+__uint_as_float(rr[1]); } }
    selmask=0u;
    #pragma unroll
    for(int r=0;r<3;++r){ int best=-1; float bv=0.f;
      #pragma unroll
      for(int n=0;n<8;++n) if(n<qb&&!((selmask>>n)&1u)&&(best<0||g[n]>bv)){best=n;bv=g[n];}
      selmask|=1u<<best; } }
  float mhat=0.f,l_reg=0.f;f32x16 o[2];o[0]=f32x16{};o[1]=f32x16{};
  const int qrel=wid*QBLK+r32;
  const int jw=wid>>1;
  #define CMASK_SUB(P0,P1,t,SUB) do{ SUB=mhat; if((t)<4){ if((t)==jw)cmask(P0,P1,(t),qrel,hi); else if((t)>jw)SUB=INFINITY; } \
      else if(MOBA&&qb>=4){ if(!((selmask>>(((t)-4)>>2))&1u))SUB=INFINITY; } }while(0)
  bool resc=false;
  #define START(P0,P1) do{ const float rm=rowmax(P0,P1); resc=false; \
    { const float dl=(__builtin_fabsf(rm)>(float)THRL)?rm:0.f; mhat=dl;     \
      if(__any(dl!=0.f)){ _Pragma("unroll") for(int r=0;r<16;++r){P0[r]=fsub_s(P0[r],dl);P1[r]=fsub_s(P1[r],dl);} } \
    } \
    _Pragma("unroll") for(int r=0;r<16;++r)P0[r]=__builtin_amdgcn_exp2f(P0[r]); }while(0)
  #define RESC() do{ if(resc){ asm volatile("s_waitcnt lgkmcnt(0)":::"memory"); \
      _Pragma("unroll") for(int d_=0;d_<2;++d_) _Pragma("unroll") for(int r=0;r<16;++r)o[d_][r]*=wsf[crow(r,hi)]; } }while(0)
  f32x16 pA0,pA1,pB0,pB1;
  int sl_prev=0,sl_cur=0,sl_next=SLOTB;
  #define ROT() do{sl_prev=sl_cur;sl_cur=sl_next;sl_next=(sl_next==(NSLOT-1)*SLOTB)?0:sl_next+SLOTB;}while(0)
  DMA_K(2,2*SLOTB);
  WAIT_BAR(3);
  qkt(pA0,pA1,Kbase,qr,r32,hi);asm volatile("s_nop 15\n\ts_nop 7":"+v"(pA0),"+v"(pA1));if(jw==0)cmask(pA0,pA1,0,qrel,hi);
  START(pA0,pA1);
  _Pragma("unroll") for(int r=0;r<16;++r)pA1[r]=__builtin_amdgcn_exp2f(pA1[r]);
  WAIT_BAR(0);
  DMA_K(3,0);DMA_V(1,SLOTB);
  ROT();
  kload8(kf,kp0+sl_cur);
  WAIT_BAR(2);
  s16x4 vlo[8],vhi[8]; u32x4 pw0,pw1,pw2,pw3;
  #define PKW(P,B) cvtpk_s(P[B],P[B+1])
  #define PAF(k) __builtin_bit_cast(bf16x8,pw##k)
  #define VFR(i) (bf16x8){vlo[i][0],vlo[i][1],vlo[i][2],vlo[i][3],vhi[i][0],vhi[i][1],vhi[i][2],vhi[i][3]}
  #define PIN(x) asm volatile("":"+v"(x))
  #define MX3(a,b,c) __builtin_fmaxf(__builtin_fmaxf((a),(b)),(c))
  #define GAPA(MF,A0,A1,A2,A3,W0,W1,PW) do{ MF; sacc+=A0; sacc+=A1; sacc+=A2; sacc+=A3; PIN(sacc); W0; W1; PIN(PW); SBAR(); }while(0)
  #define EX(v) __builtin_amdgcn_exp2f(v)
  #define GAPB(MF,X,B) do{ MF; X[B]=EX(X[B]); X[B+1]=EX(X[B+1]); X[B+2]=EX(X[B+2]); X[B+3]=EX(X[B+3]); PIN(X); SBAR(); }while(0)
  #define VRD(i) do{ vlo[i]=vtr(vp_+(((i)>>2)*4096+((i)&3)*1024)); vhi[i]=vtr(vp_+(((i)>>2)*4096+((i)&3)*1024+512)); }while(0)
  #define KRD(G,j) do{ if(G){ kload2(kf,kp0+sl_next,j); SBAR(); } }while(0)
  #define STEP(C0,C1,P0,P1,t,GK,GV,GL) do{ SBAR(); \
    const lds_cptr vp_=vp0+sl_prev; \
    VRD(0); SBAR(); float sacc=(P0[0]+P0[1]); \
    GAPA(C0=__builtin_amdgcn_mfma_f32_32x32x16_bf16(kf[0],qr[0],f32x16{},0,0,0), P0[2],P0[3],P0[4],P0[5],     pw0[0]=PKW(P0,0), pw0[1]=PKW(P0,2), pw0); \
    VRD(4); SBAR(); GAPA(C1=__builtin_amdgcn_mfma_f32_32x32x16_bf16(kf[1],qr[0],f32x16{},0,0,0), P0[6],P0[7],P0[8],P0[9],     pw0[2]=PKW(P0,4), pw0[3]=PKW(P0,6), pw0); \
    VRD(1); SBAR(); GAPA(C0=__builtin_amdgcn_mfma_f32_32x32x16_bf16(kf[2],qr[1],C0,0,0,0),   P0[10],P0[11],P0[12],P0[13], pw1[0]=PKW(P0,8), pw1[1]=PKW(P0,10), pw1); \
    VRD(5); SBAR(); GAPA(C1=__builtin_amdgcn_mfma_f32_32x32x16_bf16(kf[3],qr[1],C1,0,0,0),   P0[14],P0[15],P1[0],P1[1],   pw1[2]=PKW(P0,12),pw1[3]=PKW(P0,14), pw1); \
    VRD(2); SBAR(); GAPA(C0=__builtin_amdgcn_mfma_f32_32x32x16_bf16(kf[4],qr[2],C0,0,0,0),   P1[2],P1[3],P1[4],P1[5],     pw2[0]=PKW(P1,0), pw2[1]=PKW(P1,2), pw2); \
    VRD(6); SBAR(); GAPA(C1=__builtin_amdgcn_mfma_f32_32x32x16_bf16(kf[5],qr[2],C1,0,0,0),   P1[6],P1[7],P1[8],P1[9],     pw2[2]=PKW(P1,4), pw2[3]=PKW(P1,6), pw2); \
    VRD(3); SBAR(); GAPA(C0=__builtin_amdgcn_mfma_f32_32x32x16_bf16(kf[6],qr[3],C0,0,0,0),   P1[10],P1[11],P1[12],P1[13], pw3[0]=PKW(P1,8), pw3[1]=PKW(P1,10), pw3); \
    VRD(7); SBAR(); GAPA(C1=__builtin_amdgcn_mfma_f32_32x32x16_bf16(kf[7],qr[3],C1,0,0,0),   P1[14],P1[15],0.f,0.f,       pw3[2]=PKW(P1,12),pw3[3]=PKW(P1,14), pw3); \
    l_reg+=sacc; \
    if(GK){DMA_K((t)+3,sl_cur);} if(GV){DMA_V((t)+1,sl_next);} \
    { float sub_; CMASK_SUB(C0,C1,t,sub_); \
    if(__any(sub_!=0.f)){ _Pragma("unroll") for(int r=0;r<16;++r){C0[r]=fsub_s(C0[r],sub_);C1[r]=fsub_s(C1[r],sub_);} } }   \
    { float a=MX3(C0[0],C0[1],C1[0]),b=MX3(C0[2],C0[3],C1[1]); a=MX3(a,C1[2],C1[3]); \
      _Pragma("unroll") for(int r=4;r<16;r+=4){a=MX3(a,C0[r],C0[r+1]);b=MX3(b,C0[r+2],C0[r+3]);a=MX3(a,C1[r],C1[r+1]);b=MX3(b,C1[r+2],C1[r+3]);} \
      float rm=__builtin_fmaxf(a,b); { auto rr=__builtin_amdgcn_permlane32_swap(__float_as_uint(rm),__float_as_uint(rm),false,false); rm=__builtin_fmaxf(__uint_as_float(rr[0]),__uint_as_float(rr[1])); } \
      resc=false; \
      if(__builtin_expect(__any(rm>(float)THRL),0)){ const float dl=__builtin_fmaxf(rm,0.f); mhat+=dl; \
        _Pragma("unroll") for(int r=0;r<16;++r){C0[r]-=dl;C1[r]-=dl;} \
        const float f=__builtin_amdgcn_exp2f(-dl); l_reg*=f; if(hi==0)wsf[r32]=f; resc=true; } } \
    SBAR(); \
    GAPB(o[0]=__builtin_amdgcn_mfma_f32_32x32x16_bf16(PAF(0),VFR(0),o[0],0,0,0), C0,0); \
    GAPB(o[1]=__builtin_amdgcn_mfma_f32_32x32x16_bf16(PAF(0),VFR(4),o[1],0,0,0), C0,4); \
    KRD(GL,0); GAPB(o[0]=__builtin_amdgcn_mfma_f32_32x32x16_bf16(PAF(1),VFR(1),o[0],0,0,0), C0,8); \
    KRD(GL,1); GAPB(o[1]=__builtin_amdgcn_mfma_f32_32x32x16_bf16(PAF(1),VFR(5),o[1],0,0,0), C0,12); \
    KRD(GL,2); GAPB(o[0]=__builtin_amdgcn_mfma_f32_32x32x16_bf16(PAF(2),VFR(2),o[0],0,0,0), C1,0); \
    KRD(GL,3); GAPB(o[1]=__builtin_amdgcn_mfma_f32_32x32x16_bf16(PAF(2),VFR(6),o[1],0,0,0), C1,4); \
    GAPB(o[0]=__builtin_amdgcn_mfma_f32_32x32x16_bf16(PAF(3),VFR(3),o[0],0,0,0), C1,8); \
    GAPB(o[1]=__builtin_amdgcn_mfma_f32_32x32x16_bf16(PAF(3),VFR(7),o[1],0,0,0), C1,12); \
    }while(0)
  int t=1;
  for(;t+5<NT;t+=2){
    STEP(pB0,pB1,pA0,pA1,t,true,true,true);     WAIT_BAR(2); RESC(); ROT();
    STEP(pA0,pA1,pB0,pB1,t+1,true,true,true);   WAIT_BAR(2); RESC(); ROT();
  }
  #define ENDW(tt) do{ if((tt)+3<NT){WAIT_BAR(2);} else if((tt)+2<NT){WAIT_BAR(1);} else {WAIT_BAR(0);} }while(0)
  for(;t+1<NT;t+=2){
    STEP(pB0,pB1,pA0,pA1,t,(t+3<NT),(t+1<NT),(t+1<NT));       ENDW(t);   RESC(); ROT();
    STEP(pA0,pA1,pB0,pB1,t+1,(t+4<NT),(t+2<NT),(t+2<NT));     ENDW(t+1); RESC(); ROT();
  }
  STEP(pB0,pB1,pA0,pA1,NT-1,false,false,false); RESC();
  { float sacc=pB0[0]+pB0[1]; _Pragma("unroll") for(int r=2;r<16;++r)sacc+=pB0[r]; _Pragma("unroll") for(int r=0;r<16;++r)sacc+=pB1[r]; l_reg+=sacc;
    pw0=(u32x4){PKW(pB0,0),PKW(pB0,2),PKW(pB0,4),PKW(pB0,6)};pw1=(u32x4){PKW(pB0,8),PKW(pB0,10),PKW(pB0,12),PKW(pB0,14)};pw2=(u32x4){PKW(pB1,0),PKW(pB1,2),PKW(pB1,4),PKW(pB1,6)};pw3=(u32x4){PKW(pB1,8),PKW(pB1,10),PKW(pB1,12),PKW(pB1,14)};
    SBAR(); pv(o,vb0+sl_cur,PAF(0),PAF(1),PAF(2),PAF(3)); }
  #undef PKW
  #undef PAF
  #undef VFR
  #undef PIN
  #undef MX3
  #undef GAPA
  #undef GAPB
  #undef EX
  #undef VRD
  #undef KRD
  #undef STEP
  #undef ENDW
  {auto rr=__builtin_amdgcn_permlane32_swap(__float_as_uint(l_reg),__float_as_uint(l_reg),false,false);l_reg=__uint_as_float(rr[0])+__uint_as_float(rr[1]);}
  if(hi==0)wsf[32+r32]=l_reg;asm volatile("s_waitcnt lgkmcnt(0)":::"memory");
  float rli[16];
  #pragma unroll
  for(int r=0;r<16;++r)rli[r]=__builtin_amdgcn_rcpf(wsf[32+crow(r,hi)]);
  bf16*Ow=Op+(rowbase+q0+wid*QBLK)*PO;
  { bf16*stg=(bf16*)(shm+LDS_OST)+wid*2048;
    #pragma unroll
    for(int r=0;r<16;++r){const int orow=crow(r,hi);
      #pragma unroll
      for(int d0=0;d0<2;++d0)stg[orow*64+d0*32+r32]=__float2bfloat16(o[d0][r]*rli[r]);}
    asm volatile("s_waitcnt lgkmcnt(0)":::"memory");
    #pragma unroll
    for(int i=0;i<4;++i){const int row=i*8+(lane>>3),ch=lane&7; const u32x4 v=*(const u32x4*)(stg+row*64+ch*8); ATTN_STORE16(Ow+(long)row*PO+ch*8,v);} }
  asm volatile("s_waitcnt lgkmcnt(0)\n\ts_barrier":::"memory");
  #undef DMA_K
  #undef TILE
  #undef DMA_V
  #undef CMASK_SUB
  #undef START
  #undef RESC
  #undef ROT
}
constexpr int ATTN_LDS_BYTES=LDS_BYTES;
#undef SBAR
#undef WAIT_BAR
}
__device__ __forceinline__ void attn_phase(char* lds, const unsigned short* projb_, unsigned short* tmpb_, unsigned short* mixb_, const float* kmean, int G, int blk,
                                           const float* lq1, const float* lk1, const float* lq2, const float* lk2, const float* subln_g) {
    using attn2::bf16;
    const bf16* projb = (const bf16*)projb_; bf16* tmpb = (bf16*)tmpb_; bf16* mixb = (bf16*)mixb_;
    const int vcu = (G % 8 == 0) ? (blk % 8) * (G / 8) + blk / 8 : blk;
    for (int it = vcu; it < 1536; it += G) {
        const bool moba = it >= 512; const int q = moba ? it - 512 : it;
        const int s = q & 3, h = moba ? (q >> 2) & 7 : (q >> 2) & 3, b = moba ? q >> 5 : q >> 4, nun = moba ? 2 : 8;
        const float* km = kmean + (size_t)((b * 8 + (moba ? h : 0)) * 8) * 64;
        for (int k = 0; k < nun; ++k) {
            const int u = moba ? k : k >> 2, cv = k & 3, c = cv >> 1, vh = cv & 1, qb = u ? s : 7 - s;
            const int qcol = moba ? 1536 + h * 64 : h * 128 + c * 64, kcol = moba ? 2048 + h * 64 : 512 + h * 128 + c * 64, vcol = moba ? 2560 + h * 64 : 1024 + h * 128 + vh * 64;
            bf16* op = moba ? mixb + 512 + h * 64 : tmpb + (h * 2 + c) * 128 + vh * 64;
            attn2::attn_unit<8>(b, qb, moba, projb + qcol, projb + kcol, projb + vcol, op, km, lds);
            if (!moba && cv == 3) {
                asm volatile("s_waitcnt vmcnt(0)" ::: "memory"); __syncthreads();
                const int lane = threadIdx.x & 63, wave = threadIdx.x >> 6, tk = lane >> 4, sg = lane & 15;
                float lam; { const float a = wave_sum(lq1[lane] * lk1[lane]), b2 = wave_sum(lq2[lane] * lk2[lane]); lam = expf(a) - expf(b2) + 0.2f; }
                float gg[8];
#pragma unroll
                for (int i = 0; i < 8; ++i) gg[i] = subln_g[sg * 8 + i] * 0.8f;
                const unsigned short* tb = tmpb_; unsigned short* mb = mixb_;
                unsigned ua[8][4], ub[8][4];
#pragma unroll
                for (int g = 0; g < 8; ++g) { const size_t r = (size_t)b * SEQ + qb * 256 + wave * 4 + 32 * g + tk;
                    const unsigned* p1 = (const unsigned*)(tb + r * D + (h * 2) * 128 + sg * 8); const unsigned* p2 = (const unsigned*)(tb + r * D + (h * 2 + 1) * 128 + sg * 8);
#pragma unroll
                    for (int i = 0; i < 4; ++i) { ua[g][i] = __hip_atomic_load(p1 + i, __ATOMIC_RELAXED, __HIP_MEMORY_SCOPE_AGENT); ub[g][i] = __hip_atomic_load(p2 + i, __ATOMIC_RELAXED, __HIP_MEMORY_SCOPE_AGENT); } }
#pragma unroll
                for (int g = 0; g < 8; ++g) { const size_t r = (size_t)b * SEQ + qb * 256 + wave * 4 + 32 * g + tk;
                    unsigned u1[4], u2[4];
#pragma unroll
                    for (int i = 0; i < 4; ++i) { u1[i] = ua[g][i]; u2[i] = ub[g][i]; }
                    float a[8];
#pragma unroll
                    for (int i = 0; i < 4; ++i) { a[2 * i] = __uint_as_float(u1[i] << 16) - lam * __uint_as_float(u2[i] << 16); a[2 * i + 1] = __uint_as_float(u1[i] & 0xffff0000u) - lam * __uint_as_float(u2[i] & 0xffff0000u); }
                    float ss = 0.f;
#pragma unroll
                    for (int i = 0; i < 8; ++i) ss += a[i] * a[i];
                    ss += __shfl_xor(ss, 1); ss += __shfl_xor(ss, 2); ss += __shfl_xor(ss, 4); ss += __shfl_xor(ss, 8);
                    const float rr = 1.0f / sqrtf(ss * (1.0f / 128.0f) + 1e-5f);
                    g8::u32x4 o;
#pragma unroll
                    for (int i = 0; i < 4; ++i) o[i] = g8::cvt_pk_bf16(a[2 * i] * rr * gg[2 * i], a[2 * i + 1] * rr * gg[2 * i + 1]);
                    *(g8::u32x4*)(mb + r * D + h * 128 + sg * 8) = o; }
            }
        }
    }
}

struct Args { const float* in[26]; float* out; unsigned char* ws; int ph_lo, ph_hi; };
constexpr int LDS_BYTES = 163840, MISC_OFF = 144 * 1024 - 256, XS_OFF = 131072, GOFF_OFF = 140 * 1024, STG_OFF = 147456;
constexpr int NPH = 14;

__global__ void __launch_bounds__(NTHR, 2) fwd(Args args) {
    extern __shared__ __attribute__((aligned(16))) unsigned char lds_arr[];
    LAS unsigned char* lds = (LAS unsigned char*)lds_arr;
    volatile LAS unsigned* MISC = (volatile LAS unsigned*)(lds + MISC_OFF);
#define PH_VARS const int tid = threadIdx.x, lane = tid & 63, wave = __builtin_amdgcn_readfirstlane(tid >> 6); \
    const int gw = blockIdx.x * NWAVES + wave, NGW = gridDim.x * NWAVES; const int gt = blockIdx.x * NTHR + tid, NGT = gridDim.x * NTHR; (void)lane; (void)gw; (void)NGW; (void)gt; (void)NGT;
#define PTRS \
    unsigned char* ws = (unsigned char*)KA->ws; \
    unsigned* ctl = (unsigned*)(ws + WS_CTL); \
    const float* x = (const float*)KA->in[0]; const float* mem = (const float*)KA->in[1]; const float* w_in = (const float*)KA->in[2]; \
    const float* lq1 = (const float*)KA->in[3]; const float* lk1 = (const float*)KA->in[4]; const float* lq2 = (const float*)KA->in[5]; const float* lk2 = (const float*)KA->in[6]; \
    const float* subln_g = (const float*)KA->in[7]; const float* w_out = (const float*)KA->in[8]; const float* ln1_g = (const float*)KA->in[9]; const float* ln1_b = (const float*)KA->in[10]; \
    const float* mem_g = (const float*)KA->in[11]; const float* mem_b = (const float*)KA->in[12]; const float* w_q = (const float*)KA->in[13]; const float* w_kv = (const float*)KA->in[14]; \
    const float* w_o = (const float*)KA->in[15]; const float* ln2_g = (const float*)KA->in[16]; const float* ln2_b = (const float*)KA->in[17]; const float* w_router = (const float*)KA->in[18]; \
    const float* b_router = (const float*)KA->in[19]; const float* w_mlp1 = (const float*)KA->in[20]; const float* b_mlp1 = (const float*)KA->in[21]; const float* w_mlp2 = (const float*)KA->in[22]; \
    const float* b_mlp2 = (const float*)KA->in[23]; const float* ln3_g = (const float*)KA->in[24]; const float* ln3_b = (const float*)KA->in[25]; \
    float* out = (float*)KA->out; \
    float* ropec = (float*)(ws + WS_ROPE); float* ropes = ropec + SEQ * 8; \
    float* kmean = (float*)(ws + WS_KMEAN); \
    int* topi = (int*)(ws + WS_TOPI); float* topw = (float*)(ws + WS_TOPW); int* list = (int*)(ws + WS_LIST); float* wpos = (float*)(ws + WS_WPOS); int* posof = (int*)(ws + WS_POSOF); \
    bf* wint = (bf*)(ws + WS_WINT); bf* woutt = (bf*)(ws + WS_WOUTT); bf* wqb = (bf*)(ws + WS_WQB); bf* wkvt = (bf*)(ws + WS_WKVT); bf* wot = (bf*)(ws + WS_WOT); bf* w1t = (bf*)(ws + WS_W1T); bf* w2t = (bf*)(ws + WS_W2T); \
    bf* xb = (bf*)(ws + WS_XB); bf* projb = (bf*)(ws + WS_PROJ); bf* memn = (bf*)(ws + WS_MEMN); bf* kvmb = (bf*)(ws + WS_KVM); bf* gtb = (bf*)(ws + WS_GT); bf* vwtb = (bf*)(ws + WS_VWT); \
    bf* h1b = (bf*)(ws + WS_H1B); bf* t2b = (bf*)(ws + WS_OUT2); bf* pb = (bf*)(ws + WS_P); bf* h2b = (bf*)(ws + WS_H2B); \
    bf* mixb = (bf*)out + (size_t)T * D; \
    float* t2 = out; long long* lnst = (long long*)(ws + WS_LNZ); long long* gcs = (long long*)(ws + WS_LNZ + 1024 * 1024); long long* gbf = (long long*)(ws + WS_LNZ + 1280 * 1024); bf* hidb = (bf*)out; signed char* w1q = (signed char*)(ws + WS_W1T); unsigned char* w2q = (unsigned char*)(ws + WS_W2T); unsigned char* hid8 = (unsigned char*)out; signed char* h2q = (signed char*)(ws + WS_H2Q); float* sa = (float*)(ws + WS_SA); float* sbw = (float*)(ws + WS_SB); float* sapos = (float*)(ws + WS_SAPOS); float* sxr = (float*)(ws + WS_SX); float* swin = (float*)(ws + WS_SWIN); signed char* xq = (signed char*)(ws + WS_XB); \
    unsigned* cnt = ctl + CW_CNT; unsigned* fill = ctl + CW_FILL; \
    const int G = (int)gridDim.x, cB = (int)blockIdx.x; (void)ctl; (void)cnt; (void)fill; (void)G; (void)cB;
    typedef unsigned short bf;
    const volatile __attribute__((address_space(4))) Args* const KA = (const volatile __attribute__((address_space(4))) Args*)__builtin_amdgcn_kernarg_segment_ptr();
    unsigned* const ctl0 = (unsigned*)((unsigned char*)KA->ws + WS_CTL);
    if (threadIdx.x < 64) MISC[threadIdx.x] = 0u;
    __syncthreads();
    const int lo = KA->ph_lo, hi = KA->ph_hi;
    XcdBarrier bar; bar.bar = ctl0 + CW_BAR; bar.x = 0; bar.st = MISC + 8;
    if (hi - lo > 1) bar = xcd_barrier_post(ctl0 + CW_BAR, MISC + 8);
#define OPQ(x) ({ int _v = (x); asm volatile("" : "+s"(_v)); _v; })
#define IN(k) (OPQ(lo) <= (k) && (k) < OPQ(hi))
#define SEAM(k) do { if (IN(k) && IN((k) + 1)) xcd_barrier(bar); } while (0)

    if (IN(0)) {
        PH_VARS
        PTRS
        for (int i = gt; i < SEQ * 8; i += NGT) { double s, c; sincos_d((double)(i >> 3) * INV_FREQ[i & 7], s, c); ropec[i] = (float)c; ropes[i] = (float)s; }
        for (int r = gw; r < TM; r += NGW) { float4 v[4];
#pragma unroll
            for (int j = 0; j < 4; ++j) v[j] = *(const float4*)(mem + (size_t)r * D + 4 * lane + 256 * j);
            ln_wave(v, mem_g, mem_b, lane);
#pragma unroll
            for (int j = 0; j < 4; ++j) { g8::u32x2 w; w.x = g8::cvt_pk_bf16(v[j].x, v[j].y); w.y = g8::cvt_pk_bf16(v[j].z, v[j].w); *(g8::u32x2*)(memn + (size_t)r * D + 4 * lane + 256 * j) = w; } }
        for (int r = gw; r < T; r += NGW) { float4 v[4];
#pragma unroll
            for (int j = 0; j < 4; ++j) v[j] = ldnt4(x + (size_t)r * D + 4 * lane + 256 * j);
            float am = 0.f;
#pragma unroll
            for (int j = 0; j < 4; ++j) am = fmaxf(am, fmaxf(fmaxf(fabsf(v[j].x), fabsf(v[j].y)), fmaxf(fabsf(v[j].z), fabsf(v[j].w))));
            am = fmaxf(wave_max(am), 1e-30f); const float iv = 127.0f / am; if (lane == 0) sxr[r] = am * (1.0f / 127.0f);
#pragma unroll
            for (int j = 0; j < 4; ++j) { const unsigned q = ((unsigned)(int)rintf(v[j].x * iv) & 0xffu) | (((unsigned)(int)rintf(v[j].y * iv) & 0xffu) << 8) | (((unsigned)(int)rintf(v[j].z * iv) & 0xffu) << 16) | (((unsigned)(int)rintf(v[j].w * iv) & 0xffu) << 24);
                *(unsigned*)(xq + (size_t)r * D + 4 * lane + 256 * j) = q; } }
        for (size_t i = (size_t)gt; i < (size_t)D * D / 8; i += (size_t)NGT) { const float* src = w_q + i * 8; bf* dst = wqb + i * 8;
            const float4 a = *(const float4*)src, b = *(const float4*)(src + 4);
            g8::u32x4 w; w.x = g8::cvt_pk_bf16(a.x, a.y); w.y = g8::cvt_pk_bf16(a.z, a.w); w.z = g8::cvt_pk_bf16(b.x, b.y); w.w = g8::cvt_pk_bf16(b.z, b.w); *(g8::u32x4*)dst = w; }
        LAS float* scr = (LAS float*)lds + wave * (64 * 33);
        constexpr int I_IN = NPROJ / 32  , I_SQ = (D / 64) * (D / 32), I_KV = (D / 64) * (2 * D / 32), I2 = (DFF / 64) * (D / 32);
        constexpr int I1Q = 2 * DFF / 32;
        constexpr int NIT = I_SQ + I_KV + I_SQ + NEXP * I2;
        for (int it = gw; it < NIT; it += NGW) { int r = it;
            const float* W; unsigned short* WT; int K_, N_, q; bool quant = false, f8 = false, quant_in = false; int qe = 0;
            if (r < I_SQ) { W = w_out; WT = woutt; K_ = D; N_ = D; q = r; }
            else if ((r -= I_SQ) < I_KV) { W = w_kv; WT = wkvt; K_ = D; N_ = 2 * D; q = r; }
            else if ((r -= I_KV) < I_SQ) { W = w_o; WT = wot; K_ = D; N_ = D; q = r; }
            else { r -= I_SQ; qe = r / I2; q = r - qe * I2; W = w_mlp2 + (size_t)qe * DFF * D; WT = nullptr; K_ = DFF; N_ = D; f8 = true; }
            (void)quant; (void)quant_in;
            if (f8) transpose_item_f8(W, K_, N_, w2q + (size_t)qe * D * DFF, g8::W2_SCALE, scr, q, lane);
            else transpose_item(W, K_, N_, WT, scr, q, lane); }
        __syncthreads();
        { lfloat* stage = (lfloat*)lds; lfloat* red = stage + 1024 * 33;
          for (int it = blockIdx.x; it < I_IN + NEXP * I1Q; it += gridDim.x) {
              if (it < I_IN) quant_w1_block(w_in, NPROJ, (signed char*)wint, swin, stage, red, it, tid);
              else { const int r = it - I_IN, qe = r / I1Q, q = r - qe * I1Q; quant_w1_block(w_mlp1 + (size_t)qe * D * 2 * DFF, 2 * DFF, w1q + (size_t)qe * 2 * DFF * D, sbw + (size_t)qe * 2 * DFF, stage, red, q, tid); } } }
    }
    SEAM(0);
    if (IN(1)) {
        PTRS
        { g8::DenseOrder S; S.init(T, NPROJ, D / 2, G, cB); g8::EpiProj E{projb, ropec, ropes, lds + STG_OFF, sxr, swin, lds + XS_OFF}; int kq = D / 2; asm volatile("" : "+s"(kq)); g8::gemm_phase<g8::EpiProj, g8::DenseOrder, false>(lds, (const bf*)xq, D / 2, (const bf*)wint, D / 2, kq, nullptr, S, E); }
        { g8::DenseOrder S; S.init(TM, 2 * D, D, G, cB); g8::EpiPlainB E{kvmb, 2 * D, lds + STG_OFF}; g8::gemm_phase<g8::EpiPlainB, g8::DenseOrder, false>(lds, memn, D, wkvt, D, D, nullptr, S, E); }
    }
    SEAM(1);
    if (IN(2)) {
        PH_VARS
        PTRS
        int k256 = 256; asm volatile("" : "+s"(k256));
        { g8::GtOrder S{G, cB}; g8::EpiGT E{gtb, ln1_g, ln1_b, gcs, gbf, lds + STG_OFF}; g8::gemm_phase<g8::EpiGT, g8::GtOrder, false>(lds, kvmb, 2 * D, wqb, D, k256, nullptr, S, E); }
        { g8::VwtOrder S{G, cB}; g8::EpiPlainB E{vwtb, D, lds + STG_OFF}; g8::gemm_phase<g8::EpiPlainB, g8::VwtOrder, false>(lds, wot, D, kvmb, 2 * D, k256, nullptr, S, E); }
        for (int it = gw; it < BATCH * 8 * 8; it += NGW) { const int n = it & 7, h = (it >> 3) & 7, b = it >> 6;
            const bf* kp = projb + ((size_t)b * SEQ + n * 256) * NPROJ + 2048 + h * 64 + lane; float s = 0.f;
            for (int j = 0; j < 256; ++j) s += bf2f(kp[(size_t)j * NPROJ]);
            kmean[((b * 8 + h) * 8 + n) * 64 + lane] = s * (1.0f / 256.0f); }
    }
    SEAM(2);
    if (IN(3)) { PTRS attn_phase((char*)lds_arr, projb, (bf*)out, mixb, kmean, G, cB, lq1, lk1, lq2, lk2, subln_g); }
    if (IN(3) && IN(5)) xcd_barrier(bar);
    if (IN(5)) { PTRS g8::DenseOrder S; S.init(T, D, D, G, cB); g8::EpiResidStats E{h1b, x, lnst, ALPHA}; g8::gemm_phase<g8::EpiResidStats, g8::DenseOrder, false>(lds, mixb, D, woutt, D, D, nullptr, S, E); }
    if (IN(5) && IN(7)) xcd_barrier(bar);
    if (IN(7)) { PTRS g8::BatchOrder S; S.init(T, D, D, G, cB); S.bbatch_rows = D; g8::EpiSoftmaxP E{pb, lds + XS_OFF, lds + STG_OFF, lnst, gcs, gbf}; g8::gemm_phase<g8::EpiSoftmaxP, g8::BatchOrder, false>(lds, h1b, D, gtb, D, D, nullptr, S, E); }
    SEAM(7);
    if (IN(8)) { PTRS g8::BatchOrder S; S.init(T, D, D, G, cB); S.bbatch_rows = D; g8::EpiPlainB E{t2b, D, lds + STG_OFF}; g8::gemm_phase<g8::EpiPlainB, g8::BatchOrder, false>(lds, pb, D, vwtb, D, D, nullptr, S, E); }
    SEAM(8);
    if (IN(9)) {
        PH_VARS
        PTRS
        lfloat* xs = (lfloat*)lds; lfloat* red = (lfloat*)(lds + 32 * 1028 * 4); LAS int* chist = (LAS int*)(lds + 32 * 1028 * 4 + 2 * 32 * 33 * 4);
        if (tid < NEXP) chist[tid] = 0;
        __syncthreads();
        const int rh = wave & 1, eh = (wave >> 1) & 1, kh = wave >> 2, li = lane & 15, hq = lane >> 4;
        float Bw[128];
        { const float* wp = w_router + (size_t)(512 * kh + 128 * hq) * NEXP + 16 * eh + li;
#pragma unroll
          for (int s2 = 0; s2 < 128; ++s2) Bw[s2] = wp[(size_t)s2 * NEXP]; }
        for (int rb = blockIdx.x; rb < T / 32; rb += gridDim.x) {
#pragma unroll 1
            for (int rp = 0; rp < 4; rp += 2) {
            g8::u32x2 pin[2][4], pc[2][4]; float s1[2], s2[2];
#pragma unroll
            for (int rr = 0; rr < 2; ++rr) { const size_t r = (size_t)rb * 32 + 4 * wave + rp + rr;
                const long long* sp = lnst + 2 * r; asm volatile("" : "+v"(sp));
                s1[rr] = fx_get(sp); s2[rr] = fx_get(sp + 1);
#pragma unroll
                for (int j = 0; j < 4; ++j) { pin[rr][j] = *(const g8::u32x2*)(h1b + r * D + 4 * lane + 256 * j); pc[rr][j] = *(const g8::u32x2*)(t2b + r * D + 4 * lane + 256 * j); } }
#pragma unroll
            for (int rr = 0; rr < 2; ++rr) asm volatile("" : "+v"(pin[rr][0]), "+v"(pin[rr][1]), "+v"(pin[rr][2]), "+v"(pin[rr][3]), "+v"(pc[rr][0]), "+v"(pc[rr][1]), "+v"(pc[rr][2]), "+v"(pc[rr][3]), "+v"(s1[rr]), "+v"(s2[rr]));
#pragma unroll
            for (int rr = 0; rr < 2; ++rr) { const int row = 4 * wave + rp + rr; const size_t r = (size_t)rb * 32 + row; float4 v[4];
                const float mean1 = s1[rr] * (1.0f / 1024.0f), rstd1 = 1.0f / sqrtf(fmaxf(s2[rr] * (1.0f / 1024.0f) - mean1 * mean1, 0.f) + LN_EPS);
#pragma unroll
                for (int j = 0; j < 4; ++j) { const g8::u32x2 p = pin[rr][j], c = pc[rr][j]; const float4 gg = *(const float4*)(ln1_g + 4 * lane + 256 * j), bb = *(const float4*)(ln1_b + 4 * lane + 256 * j);
                    v[j].x = ((__uint_as_float(p.x << 16) - mean1) * rstd1 * gg.x + bb.x) * ALPHA + __uint_as_float(c.x << 16);
                    v[j].y = ((__uint_as_float(p.x & 0xffff0000u) - mean1) * rstd1 * gg.y + bb.y) * ALPHA + __uint_as_float(c.x & 0xffff0000u);
                    v[j].z = ((__uint_as_float(p.y << 16) - mean1) * rstd1 * gg.z + bb.z) * ALPHA + __uint_as_float(c.y << 16);
                    v[j].w = ((__uint_as_float(p.y & 0xffff0000u) - mean1) * rstd1 * gg.w + bb.w) * ALPHA + __uint_as_float(c.y & 0xffff0000u); }
                ln_wave(v, ln2_g, ln2_b, lane);
#pragma unroll
                for (int j = 0; j < 4; ++j) { g8::u32x2 w; w.x = g8::cvt_pk_bf16(v[j].x, v[j].y); w.y = g8::cvt_pk_bf16(v[j].z, v[j].w); *(g8::u32x2*)(h2b + r * D + 4 * lane + 256 * j) = w;
                    *(LAS f32x4*)&xs[row * 1028 + 4 * lane + 256 * j] = (f32x4){v[j].x, v[j].y, v[j].z, v[j].w}; }
                { float am = 0.f;
#pragma unroll
                  for (int j = 0; j < 4; ++j) am = fmaxf(am, fmaxf(fmaxf(fabsf(v[j].x), fabsf(v[j].y)), fmaxf(fabsf(v[j].z), fabsf(v[j].w))));
                  am = fmaxf(wave_max(am), 1e-30f); const float iv = 127.0f / am; if (lane == 0) sa[r] = am * (1.0f / 127.0f);
#pragma unroll
                  for (int j = 0; j < 4; ++j) { const unsigned q = ((unsigned)(int)rintf(v[j].x * iv) & 0xffu) | (((unsigned)(int)rintf(v[j].y * iv) & 0xffu) << 8) | (((unsigned)(int)rintf(v[j].z * iv) & 0xffu) << 16) | (((unsigned)(int)rintf(v[j].w * iv) & 0xffu) << 24);
                      *(unsigned*)(h2q + r * D + 4 * lane + 256 * j) = q; } } }
            }
            __syncthreads();
            f32x4 acc = {0.f, 0.f, 0.f, 0.f};
            { const lfloat* xp = xs + (16 * rh + li) * 1028 + 512 * kh + 128 * hq;
#pragma unroll
              for (int s4 = 0; s4 < 32; ++s4) { const f32x4 a4 = *(const LAS f32x4*)(xp + 4 * s4);
#pragma unroll
                  for (int u = 0; u < 4; ++u) acc = __builtin_amdgcn_mfma_f32_16x16x4f32(a4[u], Bw[4 * s4 + u], acc, 0, 0, 0); } }
#pragma unroll
            for (int q = 0; q < 4; ++q) red[(kh * 32 + 16 * rh + 4 * hq + q) * 33 + 16 * eh + li] = acc[q];
            __syncthreads();
            if (wave == 0 && lane < 32) { const size_t r = (size_t)rb * 32 + lane; float l32[NEXP];
#pragma unroll
                for (int e = 0; e < NEXP; ++e) l32[e] = red[lane * 33 + e] + red[(32 + lane) * 33 + e] + b_router[e];
                int bi[4]; float bv[4]; unsigned used = 0u;
#pragma unroll
                for (int k = 0; k < 4; ++k) { int best = -1; float bval = 0.f;
#pragma unroll
                    for (int e = 0; e < NEXP; ++e) if (!((used >> e) & 1u) && (best < 0 || l32[e] > bval)) { best = e; bval = l32[e]; }
                    used |= 1u << best; bi[k] = best; bv[k] = bval; }
                const float e0 = 1.0f, e1 = expf(bv[1] - bv[0]), e2 = expf(bv[2] - bv[0]), e3 = expf(bv[3] - bv[0]), inv = 1.0f / (e0 + e1 + e2 + e3);
                *(int4*)(topi + r * 4) = make_int4(bi[0], bi[1], bi[2], bi[3]); *(float4*)(topw + r * 4) = make_float4(e0 * inv, e1 * inv, e2 * inv, e3 * inv);
                __hip_atomic_fetch_add(&chist[bi[0]], 1, __ATOMIC_RELAXED, __HIP_MEMORY_SCOPE_WORKGROUP); __hip_atomic_fetch_add(&chist[bi[1]], 1, __ATOMIC_RELAXED, __HIP_MEMORY_SCOPE_WORKGROUP);
                __hip_atomic_fetch_add(&chist[bi[2]], 1, __ATOMIC_RELAXED, __HIP_MEMORY_SCOPE_WORKGROUP); __hip_atomic_fetch_add(&chist[bi[3]], 1, __ATOMIC_RELAXED, __HIP_MEMORY_SCOPE_WORKGROUP); }
            __syncthreads();
        }
        if (tid < NEXP) { const int n = chist[tid]; if (n) atomicAdd(&cnt[tid], (unsigned)n); }
    }
    SEAM(9);
    LAS int* goff = (LAS int*)(lds + GOFF_OFF);
    if (hi > 10) { const int tid = threadIdx.x; unsigned* cnt = ctl0 + CW_CNT; __syncthreads(); if (tid < 1) { int a = 0; for (int e = 0; e < NEXP; ++e) { goff[tid * 33 + e] = a; a += (int)__hip_atomic_load(&cnt[tid * NEXP + e], __ATOMIC_RELAXED, __HIP_MEMORY_SCOPE_AGENT); } goff[tid * 33 + 32] = a; } __syncthreads(); }
    if (IN(10)) {
        PH_VARS
        PTRS
        LAS int* hist = (LAS int*)lds; LAS int* base = hist + 32;
        for (int ch = blockIdx.x; ch < T / 256; ch += gridDim.x) {
            if (tid < 32) hist[tid] = 0;
            __syncthreads();
            const int t = ch * 256 + tid; int ee[4] = {0, 0, 0, 0}, loc[4] = {0, 0, 0, 0}; float ww[4] = {0.f, 0.f, 0.f, 0.f};
            if (tid < 256) { const int4 e4 = *(const int4*)(topi + (size_t)t * 4); const float4 w4 = *(const float4*)(topw + (size_t)t * 4);
                ee[0] = e4.x; ee[1] = e4.y; ee[2] = e4.z; ee[3] = e4.w; ww[0] = w4.x; ww[1] = w4.y; ww[2] = w4.z; ww[3] = w4.w;
#pragma unroll
                for (int k = 0; k < 4; ++k) loc[k] = __hip_atomic_fetch_add(&hist[ee[k]], 1, __ATOMIC_RELAXED, __HIP_MEMORY_SCOPE_WORKGROUP); }
            __syncthreads();
            if (tid < 32) { const int n = hist[tid]; base[tid] = goff[tid] + (n ? (int)atomicAdd(&fill[tid], (unsigned)n) : 0); }
            __syncthreads();
            if (tid < 256) { int pp[4]; const float sat = sa[t];
#pragma unroll
                for (int k = 0; k < 4; ++k) { const int pos = base[ee[k]] + loc[k]; list[pos] = t; wpos[pos] = ww[k]; sapos[pos] = sat; pp[k] = pos; }
                *(int4*)(posof + (size_t)t * 4) = make_int4(pp[0], pp[1], pp[2], pp[3]); }
            __syncthreads();
        }
    }
    SEAM(10);
    {
        PTRS
        bf* out2_p = (bf*)(ws + WS_OUT2);
        if (IN(11)) { g8::MoeOrder S{goff, 8, G, cB, D / 2, 0, 0, -1, 0}; g8::EpiSwigluI8 E{hid8, b_mlp1, sapos, sbw};
            g8::gemm_phase<g8::EpiSwigluI8, g8::MoeOrder, true>(lds, (const bf*)h2q, D / 2, (const bf*)w1q, D / 2, D / 2, list, S, E); }
        SEAM(11);
        if (IN(12)) { g8::MoeOrder S{goff, 4, G, cB, DFF / 2, 0, 0, -1, 0}; g8::EpiMoe2F8 E{out2_p, b_mlp2, wpos, lds + STG_OFF};
            int kq = DFF / 2; asm volatile("" : "+s"(kq));
            g8::gemm_phase<g8::EpiMoe2F8, g8::MoeOrder, false>(lds, (const bf*)hid8, DFF / 2, (const bf*)w2q, DFF / 2, kq, nullptr, S, E); }
        SEAM(12);
    }
    if (IN(13)) {
        PH_VARS
        PTRS
        const bf* o0 = (const bf*)(ws + WS_OUT2); const bf* o1 = o0; const bf* o2 = o0; const bf* o3 = o0;
        for (int r = gw; r < T; r += NGW) { float4 v[4]; const int4 ps = *(const int4*)(posof + (size_t)r * 4);
#pragma unroll
            for (int j = 0; j < 4; ++j) { const int c = 4 * lane + 256 * j;
                const g8::u32x2 hh = __builtin_nontemporal_load((const g8::u32x2*)(h2b + (size_t)r * D + c)), a0 = __builtin_nontemporal_load((const g8::u32x2*)(o0 + (size_t)ps.x * D + c)), a1 = __builtin_nontemporal_load((const g8::u32x2*)(o1 + (size_t)ps.y * D + c)),
                                a2 = __builtin_nontemporal_load((const g8::u32x2*)(o2 + (size_t)ps.z * D + c)), a3 = __builtin_nontemporal_load((const g8::u32x2*)(o3 + (size_t)ps.w * D + c));
#define LO(u) __uint_as_float((u) << 16)
#define HI(u) __uint_as_float((u) & 0xffff0000u)
                v[j].x = ALPHA * LO(hh.x) + ((LO(a0.x) + LO(a1.x)) + (LO(a2.x) + LO(a3.x)));
                v[j].y = ALPHA * HI(hh.x) + ((HI(a0.x) + HI(a1.x)) + (HI(a2.x) + HI(a3.x)));
                v[j].z = ALPHA * LO(hh.y) + ((LO(a0.y) + LO(a1.y)) + (LO(a2.y) + LO(a3.y)));
                v[j].w = ALPHA * HI(hh.y) + ((HI(a0.y) + HI(a1.y)) + (HI(a2.y) + HI(a3.y)));
#undef LO
#undef HI
            }
            ln_wave(v, ln3_g, ln3_b, lane);
#pragma unroll
            for (int j = 0; j < 4; ++j) stnt4(out + (size_t)r * D + 4 * lane + 256 * j, v[j]); }
    }
#undef IN
#undef SEAM
}

extern "C" void kernel_launch(void* const* d_in, const int* in_sizes, int n_in, void* d_out, int out_size, void* d_ws, size_t ws_size, hipStream_t stream) {
    static int grid = 0;
    if (grid == 0) {
        if (n_in != 26 || out_size != T * D || ws_size < WS_END) { fprintf(stderr, "kernel_launch: unexpected shapes (n_in %d out %d ws %zu)\n", n_in, out_size, ws_size); grid = -1; return; }
        int dev = 0, cus = 0, per_cu = 0;
        if (hipGetDevice(&dev) != hipSuccess || hipDeviceGetAttribute(&cus, hipDeviceAttributeMultiprocessorCount, dev) != hipSuccess) { grid = -1; return; }
        if (hipFuncSetAttribute((const void*)fwd, hipFuncAttributeMaxDynamicSharedMemorySize, LDS_BYTES) != hipSuccess) { fprintf(stderr, "kernel_launch: hipFuncSetAttribute failed\n"); grid = -1; return; }
        if (hipOccupancyMaxActiveBlocksPerMultiprocessor(&per_cu, (const void*)fwd, NTHR, LDS_BYTES) != hipSuccess || per_cu < 1) fprintf(stderr, "kernel_launch: occupancy query reports %d\n", per_cu);
        (void)hipGetLastError();
        grid = cus;
    }
    if (grid < 0) return;
    (void)hipMemsetAsync((char*)d_ws + WS_CTL, 0, CTL_ZERO_BYTES, stream);
    (void)hipMemsetAsync((char*)d_ws + WS_LNZ, 0, LNZ_BYTES, stream);
    Args a{};
    for (int i = 0; i < 26; ++i) a.in[i] = (const float*)d_in[i];
    a.out = (float*)d_out; a.ws = (unsigned char*)d_ws;
#if ONE_LAUNCH
#ifdef EXP_PREFIX
    a.ph_lo = 0; a.ph_hi = EXP_PREFIX + 1; hipLaunchKernelGGL(fwd, dim3(grid), dim3(NTHR), LDS_BYTES, stream, a);
    (void)hipMemsetAsync((char*)d_ws + WS_CTL, 0, CTL_ZERO_BYTES, stream); (void)hipMemsetAsync((char*)d_ws + WS_LNZ, 0, LNZ_BYTES, stream);
#endif
#ifndef EXP_LIST
    a.ph_lo = 0; a.ph_hi = NPH;
    hipLaunchKernelGGL(fwd, dim3(grid), dim3(NTHR), LDS_BYTES, stream, a);
#else
    { const int reps[] = {EXP_LIST}; int lo = 0;
      for (unsigned i = 0; i <= sizeof(reps) / sizeof(int); ++i) { const int hi = (i < sizeof(reps) / sizeof(int)) ? reps[i] + 1 : NPH;
          if (i) (void)hipMemsetAsync((char*)d_ws + WS_CTL + CW_BAR * 4, 0, (CW_CNT - CW_BAR) * 4, stream);
          a.ph_lo = lo; a.ph_hi = hi; hipLaunchKernelGGL(fwd, dim3(grid), dim3(NTHR), LDS_BYTES, stream, a); lo = hi - 1; } }
#endif
#else
    for (int p = 0; p < NPH; ++p) { a.ph_lo = p; a.ph_hi = p + 1; hipLaunchKernelGGL(fwd, dim3(grid), dim3(NTHR), LDS_BYTES, stream, a); }
#endif
}
```

```cpp
#include <hip/hip_runtime.h>
#include <hip/hip_bf16.h>
#include <cmath>
#include <cstdio>
#include <cstdint>

#ifndef ONE_LAUNCH
#define ONE_LAUNCH 1
#endif

constexpr int BATCH = 32, SEQ = 2048, D = 1024, T = BATCH * SEQ;
constexpr int MEML = 256, TM = BATCH * MEML;
constexpr int NPROJ = 3072;
constexpr int NEXP = 32, TOPK = 4, DFF = 1024;
constexpr float ALPHA = 1.189207115002721f;
constexpr float LN_EPS = 1e-5f;
constexpr int NTHR = 512, NWAVES = 8;

#define GAS __attribute__((address_space(1)))
#define LAS __attribute__((address_space(3)))
typedef LAS float lfloat;
typedef float f32x4 __attribute__((ext_vector_type(4)));
#define WSYNC() asm volatile("s_waitcnt lgkmcnt(0)" ::: "memory")

constexpr size_t MiB = 1u << 20;
constexpr size_t WS_CTL = 0, CTL_ZERO_BYTES = 1 * MiB;
constexpr size_t WS_ROPE = 1 * MiB;
constexpr size_t WS_KMEAN = 2 * MiB;
constexpr size_t WS_LNZ = 10 * MiB, LNZ_BYTES = 2 * MiB;
constexpr float FXS = 16777216.0f, FXI = 1.0f / 16777216.0f;
__device__ __forceinline__ void fx_add(long long* p, float v) { atomicAdd((unsigned long long*)p, (unsigned long long)(long long)rintf(v * FXS)); }
__device__ __forceinline__ float fx_get(const long long* p) { return (float)(*p) * FXI; }
constexpr size_t WS_SX = 13 * MiB, WS_SWIN = 14 * MiB;
constexpr size_t WS_SAPOS = 12 * MiB;
constexpr size_t WS_SA = 8 * MiB, WS_SB = 9 * MiB;
constexpr size_t WS_H2Q = 96 * MiB;
constexpr size_t WS_TOPI = 3 * MiB, WS_TOPW = 4 * MiB, WS_LIST = 5 * MiB, WS_WPOS = 6 * MiB, WS_POSOF = 7 * MiB;
constexpr size_t WS_WINT = 16 * MiB, WS_WOUTT = 22 * MiB, WS_WQB = 24 * MiB, WS_WKVT = 26 * MiB, WS_WOT = 30 * MiB, WS_W1T = 32 * MiB, WS_W2T = 160 * MiB;
constexpr size_t WS_XB = 224 * MiB;
constexpr size_t WS_PROJ = 352 * MiB;
constexpr size_t WS_MEMN = 736 * MiB, WS_KVM = 752 * MiB;
constexpr size_t WS_GT = 784 * MiB, WS_VWT = 848 * MiB;
constexpr size_t WS_H1B = 224 * MiB;
constexpr size_t WS_P = 608 * MiB;
constexpr size_t WS_H2B = 224 * MiB;
constexpr size_t WS_OUT2 = 352 * MiB;
constexpr size_t WS_END = 912 * MiB;
constexpr int CW_BAR = 4096, CW_CNT = 8192, CW_FILL = 8448;
constexpr float C2Q = 0.125f * 1.4426950408889634f;
constexpr float C2M = 0.0625f * 1.4426950408889634f;

#define XB_TMO      128
#define XB_XCNT(j)  (256  + 64 * (j))
#define XB_XSUB(j)  (1280 + 64 * (j))
#define XB_XGEN(j)  (2304 + 64 * (j))
#define XB_TOP      3328
#define XB_TOPGEN   3392
#define XCD_BAR_WORDS 3456
#define XB_SPIN_CAP (1u << 24)

__device__ __forceinline__ unsigned xb_ld(unsigned* p)              { return __hip_atomic_load(p, __ATOMIC_RELAXED, __HIP_MEMORY_SCOPE_AGENT); }
__device__ __forceinline__ unsigned xb_add(unsigned* p, unsigned v) { return __hip_atomic_fetch_add(p, v, __ATOMIC_RELAXED, __HIP_MEMORY_SCOPE_AGENT); }
__device__ __forceinline__ unsigned xb_xcc_id() { return (unsigned)__builtin_amdgcn_s_getreg((3 << 11) | 20) & 0xFu; }
#define XB_SPIN(cond, bar) do { unsigned _sp = 0; while (cond) { __builtin_amdgcn_s_sleep(1); \
    if ((++_sp & 255u) == 0u) { if (xb_ld(&(bar)[XB_TMO])) break; if (_sp > XB_SPIN_CAP) { atomicAdd(&(bar)[XB_TMO], 1u); break; } } } } while (0)

struct XcdBarrier { unsigned* bar; unsigned x; volatile LAS unsigned* st; };

__device__ __forceinline__ XcdBarrier xcd_barrier_post(unsigned* bar, volatile LAS unsigned* st) {
    XcdBarrier b; b.bar = bar; b.x = xb_xcc_id(); b.st = st;
    if (threadIdx.x == 0) (void)xb_add(&bar[XB_XCNT(b.x)], 1u);
    return b;
}
__device__ __forceinline__ void xcd_barrier_complete(unsigned* bar, unsigned x, unsigned& nloc, unsigned& nx) {
    const unsigned G = gridDim.x * gridDim.y * gridDim.z;
    unsigned sum, cnt, mine, sp = 0u;
    for (;;) {
        sum = 0u; cnt = 0u; mine = 0u;
#pragma unroll
        for (unsigned j = 0; j < 16; ++j) { const unsigned c = xb_ld(&bar[XB_XCNT(j)]); sum += c; cnt += (c > 0u) ? 1u : 0u; mine = (j == x) ? c : mine; }
        if (sum == G) break;
        __builtin_amdgcn_s_sleep(1);
        if ((++sp & 255u) == 0u) { if (xb_ld(&bar[XB_TMO])) break; if (sp > XB_SPIN_CAP) { atomicAdd(&bar[XB_TMO], 1u); break; } }
    }
    nloc = mine > 0u ? mine : 1u; nx = cnt > 0u ? cnt : 1u;
}
__device__ __forceinline__ void xcd_barrier(const XcdBarrier& b) {
    asm volatile("s_waitcnt vmcnt(0)" ::: "memory");
    __syncthreads();
    if (threadIdx.x == 0) {
        unsigned* bar = b.bar;
        __builtin_amdgcn_s_waitcnt(0);
        unsigned nloc = b.st[0], nx = b.st[1];
        if (nloc == 0u) { xcd_barrier_complete(bar, b.x, nloc, nx); b.st[0] = nloc; b.st[1] = nx; }
        const unsigned old = xb_add(&bar[XB_XSUB(b.x)], 1u);
        const unsigned gen = old / nloc;
        if (old + 1u == (gen + 1u) * nloc) {
            __builtin_amdgcn_fence(__ATOMIC_RELEASE, "agent");
            asm volatile("s_waitcnt vmcnt(0)" ::: "memory");
            const unsigned og = xb_add(&bar[XB_TOP], 1u);
            const unsigned tg = og / nx;
            if (og + 1u == (tg + 1u) * nx) xb_add(&bar[XB_TOPGEN], 1u);
            else XB_SPIN(xb_ld(&bar[XB_TOPGEN]) == tg, bar);
            __builtin_amdgcn_fence(__ATOMIC_ACQUIRE, "agent");
            xb_add(&bar[XB_XGEN(b.x)], 1u);
            asm volatile("s_waitcnt vmcnt(0)" ::: "memory");
        } else {
            XB_SPIN(xb_ld(&bar[XB_XGEN(b.x)]) == gen, bar);
            __builtin_amdgcn_fence(__ATOMIC_ACQUIRE, "agent");
            asm volatile("s_waitcnt vmcnt(0)" ::: "memory");
        }
    }
    __syncthreads();
}

__device__ __forceinline__ float wave_sum(float v) {
#pragma unroll
    for (int o = 1; o < 64; o <<= 1) v += __shfl_xor(v, o);
    return v;
}
__device__ __forceinline__ float wave_max(float v) {
#pragma unroll
    for (int o = 1; o < 64; o <<= 1) v = fmaxf(v, __shfl_xor(v, o));
    return v;
}
__device__ __forceinline__ void sincos_d(double a, double& s, double& c) {
    const double TWO_PI_HI = 6.283185307179586232, TWO_PI_LO = 2.4492935982947064e-16;
    const double k = rint(a / TWO_PI_HI);
    double r = (a - k * TWO_PI_HI) - k * TWO_PI_LO;
    const double r2 = r * r;
    double ts = 1.0, tc = 1.0;
#pragma unroll
    for (int n = 16; n >= 1; --n) {
        ts = 1.0 - ts * r2 / (double)((2 * n) * (2 * n + 1));
        tc = 1.0 - tc * r2 / (double)((2 * n - 1) * (2 * n));
    }
    s = r * ts; c = tc;
}
__constant__ double INV_FREQ[8] = {1.0, 0.19392274474868576, 0.03760603093086393, 0.007292664737217109,
                                   0.001414213562373095, 0.0002742481756762073, 5.318295896944988e-05, 1.031338537721246e-05};

namespace g8 {
typedef unsigned short bf16_t;
typedef short bf16x8 __attribute__((ext_vector_type(8)));
typedef unsigned u32x4 __attribute__((ext_vector_type(4)));
typedef unsigned u32x2 __attribute__((ext_vector_type(2)));
typedef int i32x4 __attribute__((ext_vector_type(4)));
constexpr int BM = 256, BK = 64, HALF = 128, HTB = HALF * BK * 2, STAGE_BYTES = 8 * HTB, NXCD = 8, WGM = 8;
__host__ __device__ __forceinline__ int lds_byte(int r, int c) { const int st = (r >> 4) * 2 + (c >> 5), rr = r & 15, cc = c & 31, ob = rr * 64 + cc * 2; return st * 1024 + (ob ^ (((ob >> 9) & 1) << 5)); }
__host__ __device__ __forceinline__ void stage_rc(int b, int& R, int& C) { const int st = b / 1024, sb = b % 1024, swz = sb ^ (((sb >> 9) & 1) << 5); R = (st >> 1) * 16 + swz / 64; C = (st & 1) * 32 + (swz % 64) / 2; }
__host__ __device__ __forceinline__ int perm32(int rho) { const int n = rho >> 4, i = rho & 15; return 8 * (i >> 2) + 4 * n + (i & 3); }
__device__ __forceinline__ unsigned cvt_pk_bf16(float lo, float hi) { unsigned r; asm volatile("v_cvt_pk_bf16_f32 %0, %1, %2" : "=v"(r) : "v"(lo), "v"(hi)); return r; }

struct Unit { int arow0, nrows, acol0, orow0, ocol0, aux; size_t boff; };

struct DenseOrder {
    int nM, nN, nwg, G, c, ldb;
    __device__ void init(int M, int N, int ldb_, int G_, int c_) { nM = M / BM; nN = N / BM; nwg = nM * nN; G = G_; c = c_; ldb = ldb_; }
    __device__ bool tile(int i, int& pm, int& pn) const {
        const long L = (long)i * G + c; if (L >= nwg) return false;
        int wgid = (int)L; { const int q = nwg / NXCD, r = nwg % NXCD, xcd = wgid % NXCD, off = wgid / NXCD; wgid = (xcd < r ? xcd * (q + 1) : r * (q + 1) + (xcd - r) * q) + off; }
        const int nig = WGM * nN, gid = wgid / nig, fm = gid * WGM, gsz = (nM - fm) < WGM ? (nM - fm) : WGM;
        pm = fm + ((wgid % nig) % gsz); pn = (wgid % nig) / gsz; return true;
    }
    __device__ bool next(int i, Unit& u) const { int pm, pn; if (!tile(i, pm, pn)) return false;
        u.arow0 = pm * BM; u.nrows = BM; u.acol0 = 0; u.orow0 = pm * BM; u.ocol0 = pn * BM; u.aux = 0; u.boff = (size_t)pn * BM * ldb; return true; }
};
struct MoeOrder {
    const LAS int* goff; int nct, G, c, ldb;
    mutable int e_ = 0, base_ = 0, lo_ = -1, hi_ = 0;
    __device__ __forceinline__ int g(int e) const { return __builtin_amdgcn_readfirstlane(goff[e]); }
    __device__ bool next(int i, Unit& u) const {
        const int L = i * G + c;
        if (lo_ < 0) { lo_ = g(0); hi_ = g(1); }
        for (;;) { if (e_ >= 32) return false; const int n = ((hi_ - lo_ + 255) >> 8) * nct; if (L < base_ + n) break; base_ += n; ++e_; lo_ = hi_; hi_ = e_ < 32 ? g(e_ + 1) : hi_; }
        const int li = L - base_, rt = li / nct, ct = li - rt * nct;
        u.arow0 = lo_ + rt * BM; u.nrows = min(BM, hi_ - u.arow0); u.acol0 = 0; u.orow0 = u.arow0; u.ocol0 = ct * BM; u.aux = e_;
        u.boff = ((size_t)e_ * nct + ct) * BM * ldb; return true; }
};

__device__ __forceinline__ f32x4 mma_bf16(bf16x8 b, bf16x8 a, f32x4 c) { return __builtin_amdgcn_mfma_f32_16x16x32_bf16(b, a, c, 0, 0, 0); }
__device__ __forceinline__ i32x4 mma_bf16(bf16x8, bf16x8, i32x4 c) { return c; }
__device__ __forceinline__ i32x4 mma_i8(bf16x8 b, bf16x8 a, i32x4 c) { return __builtin_amdgcn_mfma_i32_16x16x64_i8(__builtin_bit_cast(i32x4, b), __builtin_bit_cast(i32x4, a), c, 0, 0, 0); }
__device__ __forceinline__ f32x4 mma_i8(bf16x8, bf16x8, f32x4 c) { return c; }
typedef int i32x8 __attribute__((ext_vector_type(8)));
__device__ __forceinline__ f32x4 mma_f8(i32x8 b, i32x8 a, f32x4 c) { const int one = 127; asm volatile("v_mfma_scale_f32_16x16x128_f8f6f4 %0, %1, %2, %0, %3, %3 op_sel_hi:[0,0,0]" : "+v"(c) : "v"(b), "v"(a), "v"(one)); return c; }
__device__ __forceinline__ i32x4 mma_f8(i32x8, i32x8, i32x4 c) { return c; }
template <class Epi, class Sched, bool GATHER>
__device__ __forceinline__ void gemm_phase(LAS unsigned char* lds, const bf16_t* A, int lda, const bf16_t* Bt, int ldb, int K, const int* list, const Sched& S, const Epi& E) {
    int tid_ = threadIdx.x; asm volatile("" : "+v"(tid_));
    const int tid = tid_, wid = __builtin_amdgcn_readfirstlane(tid >> 6), lane = tid & 63, wr = wid >> 2, wc = wid & 3, fr = lane & 15, fq = lane >> 4;
    const int nt = K / BK;
    unsigned voffB[2];
#pragma unroll
    for (int i = 0; i < 2; ++i) { int R, C; stage_rc(tid * 16 + i * 8192, R, C); const int Rb = 64 * (R >> 5) + (Epi::PERM ? perm32(R & 31) : (R & 31));   voffB[i] = (unsigned)(Rb * ldb + C) * 2u; }
    const size_t kstep = (size_t)(BK * 2);
    const size_t hstepB = (size_t)32 * ldb * 2;
    const unsigned ldsw = (unsigned)wid * 1024u;
    const int aoff = lds_byte(wr * 64 + fr, fq * 8), boff = lds_byte(wc * 32 + fr, fq * 8);
#define G8_MKRAW(V, U) do { _Pragma("unroll") for (int _h = 0; _h < 2; ++_h) _Pragma("unroll") for (int _i = 0; _i < 2; ++_i) { int _R, _C; stage_rc(tid * 16 + _i * 8192, _R, _C); int _r = 128 * _h + _R; _r = _r < (U).nrows ? _r : (U).nrows - 1; \
            V[_h][_i] = GATHER ? (unsigned)list[(U).arow0 + _r] : (unsigned)((U).arow0 + _r); } } while (0)
#define G8_MKCONV(V, U) do { _Pragma("unroll") for (int _h = 0; _h < 2; ++_h) _Pragma("unroll") for (int _i = 0; _i < 2; ++_i) { int _R, _C; stage_rc(tid * 16 + _i * 8192, _R, _C); V[_h][_i] = (V[_h][_i] * (unsigned)lda + (unsigned)((U).acol0 + _C)) * 2u; } } while (0)
#define G8_MKOFF(V, U) do { G8_MKRAW(V, U); G8_MKCONV(V, U); } while (0)
#define G8_SA(b, h) (((b) * 2 + (h)) * HTB)
#define G8_SB(b, h) ((4 + (b) * 2 + (h)) * HTB)
#define G8_STAGE_B(bufoff, gbase) do { _Pragma("unroll") for (int _i = 0; _i < 2; ++_i) \
        __builtin_amdgcn_global_load_lds((const unsigned*)((const char*)(gbase) + voffB[_i]), (LAS unsigned*)(lds + (bufoff) + ldsw + _i * 8192), 16, 0, 0); } while (0)
#define G8_STAGE_A(bufoff, kb, V, h) do { _Pragma("unroll") for (int _i = 0; _i < 2; ++_i) \
        __builtin_amdgcn_global_load_lds((const unsigned*)((const char*)A + (kb) + V[h][_i]), (LAS unsigned*)(lds + (bufoff) + ldsw + _i * 8192), 16, 0, 0); } while (0)
#define G8_STAGE_A2(bufoff, kb, h) do { _Pragma("unroll") for (int _i = 0; _i < 2; ++_i) \
        __builtin_amdgcn_global_load_lds((const unsigned*)((const char*)A + (kb) + (last ? vN[h][_i] : vC[h][_i])), (LAS unsigned*)(lds + (bufoff) + ldsw + _i * 8192), 16, 0, 0); } while (0)
#define G8_LDA(dst, b, h) do { if constexpr (Epi::F8) { _Pragma("unroll") for (int m = 0; m < 4; ++m) { const i32x4 _l = *(const LAS i32x4*)(lds + G8_SA(b, h) + aoff + m * 2048), _h = *(const LAS i32x4*)(lds + G8_SA(b, h) + aoff + m * 2048 + 1024); dst##8[m] = __builtin_shufflevector(_l, _h, 0, 1, 2, 3, 4, 5, 6, 7); } } \
        else { _Pragma("unroll") for (int m = 0; m < 4; ++m) _Pragma("unroll") for (int k = 0; k < 2; ++k) dst[m][k] = *(const LAS bf16x8*)(lds + G8_SA(b, h) + aoff + m * 2048 + k * 1024); } } while (0)
#define G8_LDB(dst, b, h) do { if constexpr (Epi::F8) { _Pragma("unroll") for (int n = 0; n < 2; ++n) { const i32x4 _l = *(const LAS i32x4*)(lds + G8_SB(b, h) + boff + n * 2048), _h = *(const LAS i32x4*)(lds + G8_SB(b, h) + boff + n * 2048 + 1024); dst##8[n] = __builtin_shufflevector(_l, _h, 0, 1, 2, 3, 4, 5, 6, 7); } } \
        else { _Pragma("unroll") for (int n = 0; n < 2; ++n) _Pragma("unroll") for (int k = 0; k < 2; ++k) dst[n][k] = *(const LAS bf16x8*)(lds + G8_SB(b, h) + boff + n * 2048 + k * 1024); } } while (0)
#define G8_MMA(ai, bj, At, Bt_) do { __builtin_amdgcn_s_setprio(1); _Pragma("unroll") for (int m = 0; m < 4; ++m) _Pragma("unroll") for (int n = 0; n < 2; ++n) { \
        if constexpr (Epi::F8) acc[ai][bj][m][n] = mma_f8(Bt_##8[n], At##8[m], acc[ai][bj][m][n]); \
        else { _Pragma("unroll") for (int k = 0; k < 2; ++k) { if constexpr (Epi::I8) acc[ai][bj][m][n] = mma_i8(Bt_[n][k], At[m][k], acc[ai][bj][m][n]); else acc[ai][bj][m][n] = mma_bf16(Bt_[n][k], At[m][k], acc[ai][bj][m][n]); } } } \
        if constexpr (Epi::F8) asm volatile("s_nop 15\n\ts_nop 7" ::: "memory");     \
        __builtin_amdgcn_s_setprio(0); } while (0)
#define G8_WAIT_V(n) asm volatile("s_waitcnt vmcnt(" #n ")" ::: "memory")
#define G8_WAIT_L(n) asm volatile("s_waitcnt lgkmcnt(" #n ")" ::: "memory")
#define G8_BAR __builtin_amdgcn_s_barrier()
#define G8_SCHED __builtin_amdgcn_sched_barrier(0)
    Unit cur, nxt; int ui = 0;
    if (!S.next(0, cur)) return;
    typedef typename Epi::acc_t acc_t;
    acc_t acc[2][2][4][2];
#pragma unroll
    for (int a = 0; a < 2; ++a)
#pragma unroll
        for (int b = 0; b < 2; ++b)
#pragma unroll
            for (int m = 0; m < 4; ++m)
#pragma unroll
                for (int n = 0; n < 2; ++n) acc[a][b][m][n] = (acc_t){0, 0, 0, 0};
    bf16x8 At[4][2], B0[2][2], B1[2][2];
    i32x8 At8[4], B08[2], B18[2];
    (void)At; (void)B0; (void)B1; (void)At8; (void)B08; (void)B18;
    unsigned vC[2][2], vN[2][2];
    G8_MKOFF(vC, cur);
    const char* cB = (const char*)Bt + cur.boff * 2;
    G8_STAGE_B(G8_SB(0, 0), cB); G8_STAGE_B(G8_SB(0, 1), cB + hstepB); G8_STAGE_A(G8_SA(0, 0), 0, vC, 0); G8_STAGE_A(G8_SA(0, 1), 0, vC, 1);
    if (wr == 1) G8_BAR;
    G8_WAIT_V(2); G8_BAR;
    G8_STAGE_B(G8_SB(1, 0), cB + kstep); G8_STAGE_A(G8_SA(1, 0), kstep, vC, 0); G8_STAGE_B(G8_SB(1, 1), cB + hstepB + kstep);
    G8_WAIT_V(6); G8_BAR;
    for (;;) {
        const bool has_next = S.next(ui + 1, nxt);
        const int tconv = (GATHER && nt > 2) ? 2 : 0;
        if (has_next) { if (GATHER) { G8_MKRAW(vN, nxt); } else { G8_MKOFF(vN, nxt); } } else {
#pragma unroll
            for (int h = 0; h < 2; ++h)
#pragma unroll
                for (int i = 0; i < 2; ++i) vN[h][i] = vC[h][i]; }
        const char* nB = has_next ? (const char*)Bt + nxt.boff * 2 : cB;
        for (int t = 0; t < nt; t += 2) {
            const bool last = (t == nt - 2);
            const size_t kb1 = (size_t)(t + 1) * kstep;
            const size_t kb2 = last ? 0 : (size_t)(t + 2) * kstep, kb3 = kb2 + kstep;
            const char* b2 = last ? nB : cB + (size_t)(t + 2) * kstep; const char* b3 = b2 + kstep;
            G8_LDB(B0, 0, 0); G8_LDB(B1, 0, 1); G8_SCHED; G8_LDA(At, 0, 0); G8_STAGE_A(G8_SA(1, 1), kb1, vC, 1);
            if (GATHER) { if (t == tconv && has_next) { G8_MKCONV(vN, nxt); } }
            G8_WAIT_V(8); G8_WAIT_L(0); G8_BAR; G8_MMA(0, 0, At, B0); G8_MMA(0, 1, At, B1); G8_BAR; G8_SCHED;
            G8_LDA(At, 0, 1); G8_STAGE_B(G8_SB(0, 0), b2); G8_STAGE_B(G8_SB(0, 1), b2 + hstepB); G8_STAGE_A2(G8_SA(0, 0), kb2, 0);
            G8_WAIT_V(8); G8_WAIT_L(0); G8_BAR; G8_MMA(1, 0, At, B0); G8_MMA(1, 1, At, B1); G8_BAR; G8_SCHED;
            G8_LDB(B0, 1, 0); G8_LDB(B1, 1, 1); G8_SCHED; G8_LDA(At, 1, 0); G8_STAGE_A2(G8_SA(0, 1), kb2, 1);
            G8_WAIT_V(8); G8_WAIT_L(0); G8_BAR; G8_MMA(0, 0, At, B0); G8_MMA(0, 1, At, B1); G8_BAR; G8_SCHED;
            G8_LDA(At, 1, 1); G8_STAGE_B(G8_SB(1, 0), b3); G8_STAGE_B(G8_SB(1, 1), b3 + hstepB); G8_STAGE_A2(G8_SA(1, 0), kb3, 0);
            G8_WAIT_V(8); G8_WAIT_L(0); G8_BAR; G8_MMA(1, 0, At, B0); G8_MMA(1, 1, At, B1); G8_BAR; G8_SCHED;
        }
        if (wr == 0) G8_BAR;
        E(acc, cur, wr, wc, fr, fq);
        if (!has_next) break;
#pragma unroll
        for (int a = 0; a < 2; ++a)
#pragma unroll
            for (int b = 0; b < 2; ++b)
#pragma unroll
                for (int m = 0; m < 4; ++m)
#pragma unroll
                    for (int n = 0; n < 2; ++n) acc[a][b][m][n] = (acc_t){0, 0, 0, 0};
        cur = nxt; cB = nB; ++ui;
#pragma unroll
        for (int h = 0; h < 2; ++h)
#pragma unroll
            for (int i = 0; i < 2; ++i) vC[h][i] = vN[h][i];
        if (wr == 1) G8_BAR;
    }
    G8_WAIT_V(0);
    G8_BAR;
#undef G8_MKOFF
#undef G8_MKRAW
#undef G8_MKCONV
#undef G8_SA
#undef G8_SB
#undef G8_STAGE_A
#undef G8_STAGE_A2
#undef G8_STAGE_B
#undef G8_LDA
#undef G8_LDB
#undef G8_MMA
#undef G8_WAIT_V
#undef G8_WAIT_L
#undef G8_BAR
#undef G8_SCHED
}

constexpr float HID_SCALE = 4.0f, W2_SCALE = 64.0f;
__device__ __forceinline__ void store_rows128(LAS unsigned char* stg, bf16_t* gp  , size_t ldc, u32x4 p0, u32x4 p1, int fr, int fq, int nvalid) {
    const int sw = fr & 7, lane = fr + 16 * fq, r0 = lane >> 3, c = lane & 7;
    *(LAS u32x4*)(stg + fr * 128 + ((fq ^ sw) << 4)) = p0;
    *(LAS u32x4*)(stg + fr * 128 + (((4 + fq) ^ sw) << 4)) = p1;
    asm volatile("s_waitcnt lgkmcnt(0)" ::: "memory");
    const u32x4 o0 = *(const LAS u32x4*)(stg + r0 * 128 + ((c ^ (r0 & 7)) << 4)), o1 = *(const LAS u32x4*)(stg + (8 + r0) * 128 + ((c ^ (r0 & 7)) << 4));
    asm volatile("s_waitcnt lgkmcnt(0)" ::: "memory");
    if (r0 < nvalid) *(u32x4*)(gp + (size_t)r0 * ldc + c * 8) = o0;
    if (8 + r0 < nvalid) *(u32x4*)(gp + (size_t)(8 + r0) * ldc + c * 8) = o1;
}
__device__ __forceinline__ float swiglu_f(float g, float l) {
    g = fminf(g, 7.0f); l = fminf(fmaxf(l, -7.0f), 7.0f);
    return g * __builtin_amdgcn_rcpf(1.0f + __expf(-1.702f * g)) * (l + 1.0f);
}
struct EpiSwigluB { typedef f32x4 acc_t; static constexpr bool I8 = false, F8 = false; static constexpr bool PERM = true;
    bf16_t* H; const float* b1;
    __device__ __forceinline__ void operator()(const f32x4 (&acc)[2][2][4][2], const Unit& u, int wr, int wc, int fr, int fq) const {
        const int col0 = u.ocol0 + wc * 64 + 8 * fq; const float* bp = b1 + (size_t)u.aux * 2048 + col0;
        f32x4 bv[2][2];
#pragma unroll
        for (int bj = 0; bj < 2; ++bj)
#pragma unroll
            for (int n = 0; n < 2; ++n) bv[bj][n] = *(const f32x4*)(bp + bj * 32 + 4 * n);
#pragma unroll
        for (int ai = 0; ai < 2; ++ai)
#pragma unroll
            for (int m = 0; m < 4; ++m) { const int r = ai * HALF + wr * 64 + m * 16 + fr; if (r < u.nrows) { bf16_t* rowp = H + (size_t)(u.orow0 + r) * 1024 + (col0 >> 1);
#pragma unroll
                for (int bj = 0; bj < 2; ++bj) { const f32x4 v0 = acc[ai][bj][m][0] + bv[bj][0], v1 = acc[ai][bj][m][1] + bv[bj][1];
                    u32x2 w; w.x = cvt_pk_bf16(swiglu_f(v0[0], v0[1]), swiglu_f(v0[2], v0[3])); w.y = cvt_pk_bf16(swiglu_f(v1[0], v1[1]), swiglu_f(v1[2], v1[3]));
                    *(u32x2*)(rowp + bj * 16) = w; } } }
    }
};
struct EpiSwigluI8 { typedef i32x4 acc_t; static constexpr bool I8 = true, F8 = false; static constexpr bool PERM = true;
    unsigned char* H; const float* b1; const float* sa; const float* sb;
    typedef float f2 __attribute__((ext_vector_type(2)));
    static __device__ __forceinline__ f2 swiglu2(f2 g, f2 l) {
        g.x = fminf(g.x, 7.0f); g.y = fminf(g.y, 7.0f); l.x = fminf(fmaxf(l.x, -7.0f), 7.0f); l.y = fminf(fmaxf(l.y, -7.0f), 7.0f);
        f2 t = g * (-1.702f * 1.4426950408889634f); t.x = __builtin_amdgcn_exp2f(t.x); t.y = __builtin_amdgcn_exp2f(t.y); t = t + 1.0f;
        f2 r; r.x = __builtin_amdgcn_rcpf(t.x); r.y = __builtin_amdgcn_rcpf(t.y);
        return (g * r) * (l * HID_SCALE + HID_SCALE); }
    __device__ __forceinline__ void operator()(const i32x4 (&acc)[2][2][4][2], const Unit& u, int wr, int wc, int fr, int fq) const {
        const int col0 = u.ocol0 + wc * 64 + 8 * fq; const float* bp = b1 + (size_t)u.aux * 2048 + col0; const float* sp = sb + (size_t)u.aux * 2048 + col0;
        f32x4 bv[2][2], sv[2][2]; float av[2][4];
#pragma unroll
        for (int bj = 0; bj < 2; ++bj)
#pragma unroll
            for (int n = 0; n < 2; ++n) { bv[bj][n] = *(const f32x4*)(bp + bj * 32 + 4 * n); sv[bj][n] = *(const f32x4*)(sp + bj * 32 + 4 * n); }
#pragma unroll
        for (int ai = 0; ai < 2; ++ai)
#pragma unroll
            for (int m = 0; m < 4; ++m) { const int r = ai * HALF + wr * 64 + m * 16 + fr; av[ai][m] = sa[u.orow0 + (r < u.nrows ? r : u.nrows - 1)]; }
#pragma unroll
        for (int ai = 0; ai < 2; ++ai) asm volatile("" : "+v"(av[ai][0]), "+v"(av[ai][1]), "+v"(av[ai][2]), "+v"(av[ai][3]));
#pragma unroll
        for (int ai = 0; ai < 2; ++ai)
#pragma unroll
            for (int m = 0; m < 4; ++m) { const int r = ai * HALF + wr * 64 + m * 16 + fr; if (r < u.nrows) { unsigned char* rowp = H + (size_t)(u.orow0 + r) * 1024 + (col0 >> 1); const float a = av[ai][m];
#pragma unroll
                for (int bj = 0; bj < 2; ++bj) { f32x4 c0, c1;
#pragma unroll
                    for (int q = 0; q < 4; ++q) { c0[q] = (float)acc[ai][bj][m][0][q]; c1[q] = (float)acc[ai][bj][m][1][q]; }
                    const f32x4 v0 = c0 * (sv[bj][0] * a) + bv[bj][0], v1 = c1 * (sv[bj][1] * a) + bv[bj][1];
                    const f2 h0 = swiglu2((f2){v0[0], v0[2]}, (f2){v0[1], v0[3]}), h1 = swiglu2((f2){v1[0], v1[2]}, (f2){v1[1], v1[3]});
                    unsigned w = 0u; w = __builtin_amdgcn_cvt_pk_fp8_f32(h0.x, h0.y, w, false); w = __builtin_amdgcn_cvt_pk_fp8_f32(h1.x, h1.y, w, true);
                    *(unsigned*)(rowp + bj * 16) = w; } } }
    }
};
struct EpiMoe2B { typedef f32x4 acc_t; static constexpr bool I8 = false, F8 = false; static constexpr bool PERM = true;
    bf16_t* O; const float* b2; const float* wpos;
    __device__ __forceinline__ void operator()(const f32x4 (&acc)[2][2][4][2], const Unit& u, int wr, int wc, int fr, int fq) const {
        const int col0 = u.ocol0 + wc * 64 + 8 * fq; const float* bp = b2 + (size_t)u.aux * 1024 + col0;
        f32x4 bv[2][2];
#pragma unroll
        for (int bj = 0; bj < 2; ++bj)
#pragma unroll
            for (int n = 0; n < 2; ++n) bv[bj][n] = *(const f32x4*)(bp + bj * 32 + 4 * n);
        float wv[2][4];
#pragma unroll
        for (int ai = 0; ai < 2; ++ai)
#pragma unroll
            for (int m = 0; m < 4; ++m) { const int r = ai * HALF + wr * 64 + m * 16 + fr; wv[ai][m] = wpos[u.orow0 + (r < u.nrows ? r : u.nrows - 1)]; }
#pragma unroll
        for (int ai = 0; ai < 2; ++ai) asm volatile("" : "+v"(wv[ai][0]), "+v"(wv[ai][1]), "+v"(wv[ai][2]), "+v"(wv[ai][3]));
#pragma unroll
        for (int ai = 0; ai < 2; ++ai)
#pragma unroll
            for (int m = 0; m < 4; ++m) { const int r = ai * HALF + wr * 64 + m * 16 + fr; if (r < u.nrows) { const float w = wv[ai][m]; bf16_t* rowp = O + (size_t)(u.orow0 + r) * 1024 + col0;
#pragma unroll
                for (int bj = 0; bj < 2; ++bj) { const f32x4 v0 = (acc[ai][bj][m][0] + bv[bj][0]) * w, v1 = (acc[ai][bj][m][1] + bv[bj][1]) * w;
                    u32x4 o; o.x = cvt_pk_bf16(v0[0], v0[1]); o.y = cvt_pk_bf16(v0[2], v0[3]); o.z = cvt_pk_bf16(v1[0], v1[1]); o.w = cvt_pk_bf16(v1[2], v1[3]);
                    *(u32x4*)(rowp + bj * 32) = o; } } }
    }
};

struct BatchOrder : DenseOrder { int bbatch_rows;
    __device__ bool next(int i, Unit& u) const { int pm, pn; if (!tile(i, pm, pn)) return false;
        u.arow0 = pm * BM; u.nrows = BM; u.acol0 = 0; u.orow0 = pm * BM; u.ocol0 = pn * BM; u.aux = 0; u.boff = ((size_t)(pm >> 3) * bbatch_rows + (size_t)pn * BM) * ldb; return true; } };
struct GtOrder { int G, c;
    __device__ bool next(int i, Unit& u) const { const int L = i * G + c; if (L >= 512) return false; const int h = L >> 7, b = (L >> 2) & 31, pn = L & 3;
        u.arow0 = b * 256; u.nrows = 256; u.acol0 = h * 256; u.boff = (size_t)pn * 256 * 1024 + h * 256; u.orow0 = b * 1024 + h * 256; u.ocol0 = pn * 256; u.aux = 0; return true; } };
struct VwtOrder { int G, c;
    __device__ bool next(int i, Unit& u) const { const int L = i * G + c; if (L >= 512) return false; const int b = L >> 4, h = (L >> 2) & 3, pm = L & 3;
        u.arow0 = pm * 256; u.nrows = 256; u.acol0 = h * 256; u.boff = (size_t)(b * 256) * 2048 + 1024 + h * 256; u.orow0 = b * 1024 + pm * 256; u.ocol0 = h * 256; u.aux = 0; return true; } };

struct EpiMoe2F8 { typedef f32x4 acc_t; static constexpr bool I8 = false, F8 = true; static constexpr bool PERM = true;
    bf16_t* O; const float* b2; const float* wpos; LAS unsigned char* stg;
    __device__ __forceinline__ void operator()(const f32x4 (&acc)[2][2][4][2], const Unit& u, int wr, int wc, int fr, int fq) const {
        const int col0 = u.ocol0 + wc * 64 + 8 * fq; const float* bp = b2 + (size_t)u.aux * 1024 + col0; const float is = 1.0f / (HID_SCALE * W2_SCALE);
        f32x4 bv[2][2];
#pragma unroll
        for (int bj = 0; bj < 2; ++bj)
#pragma unroll
            for (int n = 0; n < 2; ++n) bv[bj][n] = *(const f32x4*)(bp + bj * 32 + 4 * n);
        float wv[2][4];
#pragma unroll
        for (int ai = 0; ai < 2; ++ai)
#pragma unroll
            for (int m = 0; m < 4; ++m) { const int r = ai * HALF + wr * 64 + m * 16 + fr; wv[ai][m] = wpos[u.orow0 + (r < u.nrows ? r : u.nrows - 1)]; }
#pragma unroll
        for (int ai = 0; ai < 2; ++ai) asm volatile("" : "+v"(wv[ai][0]), "+v"(wv[ai][1]), "+v"(wv[ai][2]), "+v"(wv[ai][3]));
        LAS unsigned char* sw_ = stg + (wr * 4 + wc) * 2048;
#pragma unroll
        for (int ai = 0; ai < 2; ++ai)
#pragma unroll
            for (int m = 0; m < 4; ++m) { const int rg = ai * HALF + wr * 64 + m * 16; const float w = wv[ai][m]; u32x4 o[2];
#pragma unroll
                for (int bj = 0; bj < 2; ++bj) { const f32x4 v0 = (acc[ai][bj][m][0] * is + bv[bj][0]) * w, v1 = (acc[ai][bj][m][1] * is + bv[bj][1]) * w;
                    o[bj].x = cvt_pk_bf16(v0[0], v0[1]); o[bj].y = cvt_pk_bf16(v0[2], v0[3]); o[bj].z = cvt_pk_bf16(v1[0], v1[1]); o[bj].w = cvt_pk_bf16(v1[2], v1[3]); }
                store_rows128(sw_, O + (size_t)(u.orow0 + rg) * 1024 + u.ocol0 + wc * 64, 1024, o[0], o[1], fr, fq, u.nrows - rg); }
    }
};
struct EpiProj { typedef i32x4 acc_t; static constexpr bool I8 = true, F8 = false; static constexpr bool PERM = true;
    bf16_t* O; const float* ropec; const float* ropes; LAS unsigned char* stg; const float* sx; const float* sw; LAS unsigned char* tab;
    __device__ __forceinline__ void operator()(const i32x4 (&acc)[2][2][4][2], const Unit& u, int wr, int wc, int fr, int fq) const {
        const int region = u.ocol0 >> 9;
        const bool rope = (region != 2 && region != 5);
        const float sc = (region == 0 || region == 3) ? C2Q : 1.0f;
        const float sg = (fq == 0) ? -1.0f : 1.0f;
        const int tid = (wr * 4 + wc) * 64 + fr + 16 * fq;
        f32x4 swv[2][2]; float sxv[2][4];
#pragma unroll
        for (int bj = 0; bj < 2; ++bj)
#pragma unroll
            for (int n = 0; n < 2; ++n) swv[bj][n] = *(const f32x4*)(sw + u.ocol0 + wc * 64 + 8 * fq + bj * 32 + 4 * n) * sc;
#pragma unroll
        for (int ai = 0; ai < 2; ++ai)
#pragma unroll
            for (int m = 0; m < 4; ++m) sxv[ai][m] = sx[u.orow0 + ai * HALF + wr * 64 + m * 16 + fr];
#pragma unroll
        for (int ai = 0; ai < 2; ++ai) {
            if (rope) { const int trow = tid >> 2, tq = tid & 3, pos = (u.orow0 + ai * HALF + trow) & (SEQ - 1);
                const f32x4 tv = *(const f32x4*)((tq < 2 ? ropec : ropes) + pos * 8 + (tq & 1) * 4);
                *(LAS f32x4*)(tab + trow * 64 + tq * 16) = tv;
                asm volatile("s_waitcnt lgkmcnt(0)" ::: "memory"); __builtin_amdgcn_s_barrier(); asm volatile("" ::: "memory"); }
#pragma unroll
            for (int m = 0; m < 4; ++m) { f32x4 cs[4]; const float sxr_ = sxv[ai][m];
                if (rope) { const LAS unsigned char* tp = tab + (wr * 64 + m * 16 + fr) * 64;
                    cs[0] = *(const LAS f32x4*)(tp); cs[1] = *(const LAS f32x4*)(tp + 16); cs[2] = *(const LAS f32x4*)(tp + 32); cs[3] = *(const LAS f32x4*)(tp + 48); }
                u32x4 w[2];
#pragma unroll
                for (int bj = 0; bj < 2; ++bj) { f32x4 v0, v1;
#pragma unroll
                    for (int q = 0; q < 4; ++q) { v0[q] = (float)acc[ai][bj][m][0][q]; v1[q] = (float)acc[ai][bj][m][1][q]; }
                    v0 = v0 * (swv[bj][0] * sxr_); v1 = v1 * (swv[bj][1] * sxr_);
                    if (rope && bj == 0) { f32x4 p0, p1;
#pragma unroll
                        for (int e = 0; e < 4; ++e) { p0[e] = __shfl_xor(v0[e], 16); p1[e] = __shfl_xor(v1[e], 16); }
                        if (fq < 2) { v0 = v0 * cs[0] + p0 * (cs[2] * sg); v1 = v1 * cs[1] + p1 * (cs[3] * sg); } }
                    w[bj].x = cvt_pk_bf16(v0[0], v0[1]); w[bj].y = cvt_pk_bf16(v0[2], v0[3]); w[bj].z = cvt_pk_bf16(v1[0], v1[1]); w[bj].w = cvt_pk_bf16(v1[2], v1[3]); }
                store_rows128(stg + (wr * 4 + wc) * 2048, O + (size_t)(u.orow0 + ai * HALF + wr * 64 + m * 16) * NPROJ + u.ocol0 + wc * 64, (size_t)NPROJ, w[0], w[1], fr, fq, 16); }
            if (rope) { asm volatile("s_waitcnt lgkmcnt(0)" ::: "memory"); __builtin_amdgcn_s_barrier(); asm volatile("" ::: "memory"); }
        }
    }
};
struct EpiPlainB { typedef f32x4 acc_t; static constexpr bool I8 = false, F8 = false; static constexpr bool PERM = true;
    bf16_t* O; int ldc; LAS unsigned char* stg;
    __device__ __forceinline__ void operator()(const f32x4 (&acc)[2][2][4][2], const Unit& u, int wr, int wc, int fr, int fq) const {
        LAS unsigned char* sw_ = stg + (wr * 4 + wc) * 2048;
#pragma unroll
        for (int ai = 0; ai < 2; ++ai)
#pragma unroll
            for (int m = 0; m < 4; ++m) { u32x4 w[2];
#pragma unroll
                for (int bj = 0; bj < 2; ++bj) { const f32x4 v0 = acc[ai][bj][m][0], v1 = acc[ai][bj][m][1];
                    w[bj].x = cvt_pk_bf16(v0[0], v0[1]); w[bj].y = cvt_pk_bf16(v0[2], v0[3]); w[bj].z = cvt_pk_bf16(v1[0], v1[1]); w[bj].w = cvt_pk_bf16(v1[2], v1[3]); }
                store_rows128(sw_, O + (size_t)(u.orow0 + ai * HALF + wr * 64 + m * 16) * ldc + u.ocol0 + wc * 64, (size_t)ldc, w[0], w[1], fr, fq, 16); }
    }
};
struct EpiResidF { typedef f32x4 acc_t; static constexpr bool I8 = false, F8 = false; static constexpr bool PERM = false;
    float* O; const float* R; float alpha;
    __device__ __forceinline__ void operator()(const f32x4 (&acc)[2][2][4][2], const Unit& u, int wr, int wc, int fr, int fq) const {
        const int col0 = u.ocol0 + wc * 64 + 4 * fq;
#pragma unroll
        for (int ai = 0; ai < 2; ++ai) { f32x4 pre[4][2][2];
#pragma unroll
            for (int m = 0; m < 4; ++m) { const size_t off = (size_t)(u.orow0 + ai * HALF + wr * 64 + m * 16 + fr) * 1024 + col0;
#pragma unroll
                for (int bj = 0; bj < 2; ++bj)
#pragma unroll
                    for (int n = 0; n < 2; ++n) pre[m][bj][n] = *(const f32x4*)(R + off + bj * 32 + n * 16); }
#pragma unroll
            for (int m = 0; m < 4; ++m)
#pragma unroll
                for (int bj = 0; bj < 2; ++bj) asm volatile("" : "+v"(pre[m][bj][0]), "+v"(pre[m][bj][1]));
#pragma unroll
            for (int m = 0; m < 4; ++m) { const size_t off = (size_t)(u.orow0 + ai * HALF + wr * 64 + m * 16 + fr) * 1024 + col0;
#pragma unroll
                for (int bj = 0; bj < 2; ++bj)
#pragma unroll
                    for (int n = 0; n < 2; ++n) *(f32x4*)(O + off + bj * 32 + n * 16) = pre[m][bj][n] * alpha + acc[ai][bj][m][n]; }
            asm volatile("" ::: "memory"); }
    }
};
struct EpiResidStats { typedef f32x4 acc_t; static constexpr bool I8 = false, F8 = false; static constexpr bool PERM = false;
    bf16_t* Ob; const float* R; long long* st; float alpha;
    __device__ __forceinline__ void operator()(const f32x4 (&acc)[2][2][4][2], const Unit& u, int wr, int wc, int fr, int fq) const {
        const int col0 = u.ocol0 + wc * 64 + 4 * fq;
#pragma unroll
        for (int ai = 0; ai < 2; ++ai) { f32x4 pre[4][2][2];
#pragma unroll
            for (int m = 0; m < 4; ++m) { const size_t off = (size_t)(u.orow0 + ai * HALF + wr * 64 + m * 16 + fr) * 1024 + col0;
#pragma unroll
                for (int bj = 0; bj < 2; ++bj)
#pragma unroll
                    for (int n = 0; n < 2; ++n) pre[m][bj][n] = __builtin_nontemporal_load((const f32x4*)(R + off + bj * 32 + n * 16)); }
#pragma unroll
            for (int m = 0; m < 4; ++m)
#pragma unroll
                for (int bj = 0; bj < 2; ++bj) asm volatile("" : "+v"(pre[m][bj][0]), "+v"(pre[m][bj][1]));
#pragma unroll
            for (int m = 0; m < 4; ++m) { const int row = u.orow0 + ai * HALF + wr * 64 + m * 16 + fr; const size_t off = (size_t)row * 1024 + col0; float s1 = 0.f, s2 = 0.f;
#pragma unroll
                for (int bj = 0; bj < 2; ++bj)
#pragma unroll
                    for (int n = 0; n < 2; ++n) { const f32x4 v = pre[m][bj][n] * alpha + acc[ai][bj][m][n];
                        u32x2 w; w.x = cvt_pk_bf16(v[0], v[1]); w.y = cvt_pk_bf16(v[2], v[3]); *(u32x2*)(Ob + off + bj * 32 + n * 16) = w;
                        s1 += (v[0] + v[1]) + (v[2] + v[3]); s2 += (v[0] * v[0] + v[1] * v[1]) + (v[2] * v[2] + v[3] * v[3]); }
                s1 += __shfl_xor(s1, 16); s1 += __shfl_xor(s1, 32); s2 += __shfl_xor(s2, 16); s2 += __shfl_xor(s2, 32);
                if (fq == 0) { fx_add(st + 2 * (size_t)row, s1); fx_add(st + 2 * (size_t)row + 1, s2); } }
            asm volatile("" ::: "memory"); }
    }
};
struct EpiResidLN { typedef f32x4 acc_t; static constexpr bool I8 = false, F8 = false; static constexpr bool PERM = false;
    bf16_t* O; const bf16_t* R; const long long* st; const float* g; const float* bb; float alpha;
    __device__ __forceinline__ void operator()(const f32x4 (&acc)[2][2][4][2], const Unit& u, int wr, int wc, int fr, int fq) const {
        const int col0 = u.ocol0 + wc * 64 + 4 * fq;
        f32x4 gv[2][2], bv[2][2];
#pragma unroll
        for (int bj = 0; bj < 2; ++bj)
#pragma unroll
            for (int n = 0; n < 2; ++n) { gv[bj][n] = *(const f32x4*)(g + col0 + bj * 32 + n * 16); bv[bj][n] = *(const f32x4*)(bb + col0 + bj * 32 + n * 16); }
#pragma unroll
        for (int ai = 0; ai < 2; ++ai) { u32x2 pre[4][2][2]; float mu[4], rs[4];
#pragma unroll
            for (int m = 0; m < 4; ++m) { const int row = u.orow0 + ai * HALF + wr * 64 + m * 16 + fr; const size_t off = (size_t)row * 1024 + col0;
                mu[m] = fx_get(st + 2 * (size_t)row); rs[m] = fx_get(st + 2 * (size_t)row + 1);
#pragma unroll
                for (int bj = 0; bj < 2; ++bj)
#pragma unroll
                    for (int n = 0; n < 2; ++n) pre[m][bj][n] = *(const u32x2*)(R + off + bj * 32 + n * 16); }
#pragma unroll
            for (int m = 0; m < 4; ++m) { asm volatile("" : "+v"(mu[m]), "+v"(rs[m]));
#pragma unroll
                for (int bj = 0; bj < 2; ++bj) asm volatile("" : "+v"(pre[m][bj][0]), "+v"(pre[m][bj][1])); }
#pragma unroll
            for (int m = 0; m < 4; ++m) { const size_t off = (size_t)(u.orow0 + ai * HALF + wr * 64 + m * 16 + fr) * 1024 + col0;
                const float mean = mu[m] * (1.0f / 1024.0f), rstd = 1.0f / sqrtf(fmaxf(rs[m] * (1.0f / 1024.0f) - mean * mean, 0.f) + LN_EPS);
#pragma unroll
                for (int bj = 0; bj < 2; ++bj)
#pragma unroll
                    for (int n = 0; n < 2; ++n) { const u32x2 p = pre[m][bj][n]; const f32x4 t = {__uint_as_float(p.x << 16), __uint_as_float(p.x & 0xffff0000u), __uint_as_float(p.y << 16), __uint_as_float(p.y & 0xffff0000u)};
                        const f32x4 v = ((t - mean) * rstd * gv[bj][n] + bv[bj][n]) * alpha + acc[ai][bj][m][n];
                        u32x2 w; w.x = cvt_pk_bf16(v[0], v[1]); w.y = cvt_pk_bf16(v[2], v[3]); *(u32x2*)(O + off + bj * 32 + n * 16) = w; } }
            asm volatile("" ::: "memory"); }
    }
};
struct EpiGT { typedef f32x4 acc_t; static constexpr bool I8 = false, F8 = false; static constexpr bool PERM = true;
    bf16_t* O; const float* g; const float* bb; long long* cs; long long* bfs; LAS unsigned char* stg;
    __device__ __forceinline__ void operator()(const f32x4 (&acc)[2][2][4][2], const Unit& u, int wr, int wc, int fr, int fq) const {
        const int col0 = u.ocol0 + wc * 64 + 8 * fq;
        f32x4 gv[2][2], bv[2][2];
#pragma unroll
        for (int bj = 0; bj < 2; ++bj)
#pragma unroll
            for (int n = 0; n < 2; ++n) { gv[bj][n] = *(const f32x4*)(g + col0 + bj * 32 + 4 * n); bv[bj][n] = *(const f32x4*)(bb + col0 + bj * 32 + 4 * n); }
#pragma unroll
        for (int ai = 0; ai < 2; ++ai)
#pragma unroll
            for (int m = 0; m < 4; ++m) { const int row = u.orow0 + ai * HALF + wr * 64 + m * 16 + fr; float s1 = 0.f, s2 = 0.f; u32x4 wq[2];
#pragma unroll
                for (int bj = 0; bj < 2; ++bj) { const f32x4 a0 = acc[ai][bj][m][0], a1 = acc[ai][bj][m][1]; const f32x4 v0 = a0 * gv[bj][0], v1 = a1 * gv[bj][1], w0 = a0 * bv[bj][0], w1 = a1 * bv[bj][1];
                    wq[bj].x = cvt_pk_bf16(v0[0], v0[1]); wq[bj].y = cvt_pk_bf16(v0[2], v0[3]); wq[bj].z = cvt_pk_bf16(v1[0], v1[1]); wq[bj].w = cvt_pk_bf16(v1[2], v1[3]);
                    s1 += ((v0[0] + v0[1]) + (v0[2] + v0[3])) + ((v1[0] + v1[1]) + (v1[2] + v1[3])); s2 += ((w0[0] + w0[1]) + (w0[2] + w0[3])) + ((w1[0] + w1[1]) + (w1[2] + w1[3])); }
                store_rows128(stg + (wr * 4 + wc) * 2048, O + (size_t)(row - fr) * 1024 + u.ocol0 + wc * 64, 1024, wq[0], wq[1], fr, fq, 16);
                s1 += __shfl_xor(s1, 16); s1 += __shfl_xor(s1, 32); s2 += __shfl_xor(s2, 16); s2 += __shfl_xor(s2, 32);
                if (fq == 0) { fx_add(cs + row, s1); fx_add(bfs + row, s2); } }
    }
};
struct EpiSoftmaxP { typedef f32x4 acc_t; static constexpr bool I8 = false, F8 = false; static constexpr bool PERM = true;
    bf16_t* O; LAS unsigned char* xs; LAS unsigned char* stg; const long long* st; const long long* cs; const long long* bfs;
    __device__ __forceinline__ void operator()(const f32x4 (&acc)[2][2][4][2], const Unit& u, int wr, int wc, int fr, int fq) const {
        typedef float f32x2v __attribute__((ext_vector_type(2)));
        LAS f32x2v* X = (LAS f32x2v*)xs;
        f32x4 e[2][4][2][2]; float mw[2][4];
        const int cc0 = (u.orow0 >> 11) * 1024 + u.ocol0 + wc * 64 + 8 * fq;
        f32x4 cv[2][2], fv[2][2]; float mu[2][4], rs[2][4];
#pragma unroll
        for (int bj = 0; bj < 2; ++bj)
#pragma unroll
            for (int n = 0; n < 2; ++n)
#pragma unroll
                for (int q = 0; q < 4; ++q) { cv[bj][n][q] = fx_get(cs + cc0 + bj * 32 + 4 * n + q); fv[bj][n][q] = fx_get(bfs + cc0 + bj * 32 + 4 * n + q); }
#pragma unroll
        for (int ai = 0; ai < 2; ++ai)
#pragma unroll
            for (int m = 0; m < 4; ++m) { const size_t row = (size_t)(u.orow0 + ai * HALF + wr * 64 + m * 16 + fr); mu[ai][m] = fx_get(st + 2 * row); rs[ai][m] = fx_get(st + 2 * row + 1); }
#pragma unroll
        for (int ai = 0; ai < 2; ++ai) asm volatile("" : "+v"(mu[ai][0]), "+v"(mu[ai][1]), "+v"(mu[ai][2]), "+v"(mu[ai][3]), "+v"(rs[ai][0]), "+v"(rs[ai][1]), "+v"(rs[ai][2]), "+v"(rs[ai][3]));
#pragma unroll
        for (int ai = 0; ai < 2; ++ai)
#pragma unroll
            for (int m = 0; m < 4; ++m) { float mx = -INFINITY; const float mean = mu[ai][m] * (1.0f / 1024.0f), rstd = 1.0f / sqrtf(fmaxf(rs[ai][m] * (1.0f / 1024.0f) - mean * mean, 0.f) + LN_EPS);
#pragma unroll
                for (int bj = 0; bj < 2; ++bj)
#pragma unroll
                    for (int n = 0; n < 2; ++n) { const f32x4 v = ((acc[ai][bj][m][n] - cv[bj][n] * mean) * rstd + fv[bj][n]) * C2M; e[ai][m][bj][n] = v; mx = fmaxf(mx, fmaxf(fmaxf(v[0], v[1]), fmaxf(v[2], v[3]))); }
                mx = fmaxf(mx, __shfl_xor(mx, 16)); mx = fmaxf(mx, __shfl_xor(mx, 32)); float sm = 0.f;
#pragma unroll
                for (int bj = 0; bj < 2; ++bj)
#pragma unroll
                    for (int n = 0; n < 2; ++n) { f32x4 v = e[ai][m][bj][n];
#pragma unroll
                        for (int q = 0; q < 4; ++q) { v[q] = __builtin_amdgcn_exp2f(v[q] - mx); sm += v[q]; }
                        e[ai][m][bj][n] = v; }
                sm += __shfl_xor(sm, 16); sm += __shfl_xor(sm, 32); mw[ai][m] = mx;
                if (fq == 0) X[(ai * HALF + wr * 64 + m * 16 + fr) * 4 + wc] = (f32x2v){mx, sm}; }
        asm volatile("s_waitcnt lgkmcnt(0)" ::: "memory"); __builtin_amdgcn_s_barrier(); asm volatile("" ::: "memory");
        const int col0 = u.ocol0 + wc * 64 + 8 * fq;
#pragma unroll
        for (int ai = 0; ai < 2; ++ai)
#pragma unroll
            for (int m = 0; m < 4; ++m) { const int r = ai * HALF + wr * 64 + m * 16 + fr;
                const f32x2v a = X[r * 4 + 0], b = X[r * 4 + 1], c = X[r * 4 + 2], d = X[r * 4 + 3];
                const float mt = fmaxf(fmaxf(a.x, b.x), fmaxf(c.x, d.x));
                const float st = a.y * __builtin_amdgcn_exp2f(a.x - mt) + b.y * __builtin_amdgcn_exp2f(b.x - mt) + c.y * __builtin_amdgcn_exp2f(c.x - mt) + d.y * __builtin_amdgcn_exp2f(d.x - mt);
                const float f = __builtin_amdgcn_exp2f(mw[ai][m] - mt) / st;
                u32x4 w[2];
#pragma unroll
                for (int bj = 0; bj < 2; ++bj) { const f32x4 v0 = e[ai][m][bj][0] * f, v1 = e[ai][m][bj][1] * f;
                    w[bj].x = cvt_pk_bf16(v0[0], v0[1]); w[bj].y = cvt_pk_bf16(v0[2], v0[3]); w[bj].z = cvt_pk_bf16(v1[0], v1[1]); w[bj].w = cvt_pk_bf16(v1[2], v1[3]); }
                store_rows128(stg + (wr * 4 + wc) * 2048, O + (size_t)(u.orow0 + r - fr) * 1024 + u.ocol0 + wc * 64, 1024, w[0], w[1], fr, fq, 16); }
    }
};
}


__device__ __forceinline__ float4 ldnt4(const float* p) { const f32x4 v = __builtin_nontemporal_load((const f32x4*)p); return make_float4(v[0], v[1], v[2], v[3]); }
__device__ __forceinline__ void stnt4(float* p, float4 v) { __builtin_nontemporal_store((f32x4){v.x, v.y, v.z, v.w}, (f32x4*)p); }
__device__ __forceinline__ void transpose_item(const float* W, int K, int N, unsigned short* WT, LAS float* scr, int item, int lane) {
    const int nblk = N / 32, kb = item / nblk, nb = item % nblk, k0 = 64 * kb, n0 = 32 * nb;
#pragma unroll
    for (int i = 0; i < 8; ++i) { const int kk = 8 * i + (lane >> 3); const float4 v = ldnt4(W + (size_t)(k0 + kk) * N + n0 + 4 * (lane & 7));
        LAS float* d = scr + kk * 33 + 4 * (lane & 7); d[0] = v.x; d[1] = v.y; d[2] = v.z; d[3] = v.w; }
    WSYNC();
    const int c = lane & 7;
#pragma unroll
    for (int j = 0; j < 4; ++j) { const int n = (lane >> 3) + 8 * j; const LAS float* sp = scr + (8 * c) * 33 + n;
        g8::u32x4 o; o.x = g8::cvt_pk_bf16(sp[0 * 33], sp[1 * 33]); o.y = g8::cvt_pk_bf16(sp[2 * 33], sp[3 * 33]); o.z = g8::cvt_pk_bf16(sp[4 * 33], sp[5 * 33]); o.w = g8::cvt_pk_bf16(sp[6 * 33], sp[7 * 33]);
        *(g8::u32x4*)(WT + (size_t)(n0 + n) * K + k0 + 8 * c) = o; }
    WSYNC();
}
__device__ __forceinline__ void quant_w1_block(const float* W, int N, signed char* Q, float* sbo, LAS float* stage, LAS float* red, int nb, int tid) {
    const int lane = tid & 63, wave = tid >> 6, n0 = 32 * nb;
    float4 m4 = make_float4(0.f, 0.f, 0.f, 0.f);
    const float* wp = W + (size_t)(128 * wave + (lane >> 3)) * N + n0 + 4 * (lane & 7);
    LAS float* dp = stage + (128 * wave + (lane >> 3)) * 33 + 4 * (lane & 7);
#pragma unroll 8
    for (int i = 0; i < 16; ++i) { const float4 v = ldnt4(wp + (size_t)i * 8 * N); LAS float* d = dp + i * 8 * 33; d[0] = v.x; d[1] = v.y; d[2] = v.z; d[3] = v.w;
        m4.x = fmaxf(m4.x, fabsf(v.x)); m4.y = fmaxf(m4.y, fabsf(v.y)); m4.z = fmaxf(m4.z, fabsf(v.z)); m4.w = fmaxf(m4.w, fabsf(v.w)); }
#pragma unroll
    for (int o = 8; o < 64; o <<= 1) { m4.x = fmaxf(m4.x, __shfl_xor(m4.x, o)); m4.y = fmaxf(m4.y, __shfl_xor(m4.y, o)); m4.z = fmaxf(m4.z, __shfl_xor(m4.z, o)); m4.w = fmaxf(m4.w, __shfl_xor(m4.w, o)); }
    if (lane < 8) { LAS float* r = red + wave * 32 + 4 * lane; r[0] = m4.x; r[1] = m4.y; r[2] = m4.z; r[3] = m4.w; }
    __syncthreads();
    const int n = tid & 31, kc = tid >> 5;
    float mx = 0.f;
#pragma unroll
    for (int w = 0; w < 8; ++w) mx = fmaxf(mx, red[w * 32 + n]);
    mx = fmaxf(mx, 1e-30f);
    const float iv = 127.0f / mx;
    if (tid < 32) sbo[n0 + tid] = mx * (1.0f / 127.0f);
    const LAS float* sp = stage + (64 * kc) * 33 + n;
#pragma unroll
    for (int j = 0; j < 4; ++j) { g8::u32x4 o;
#pragma unroll
        for (int d = 0; d < 4; ++d) { unsigned w = 0u;
#pragma unroll
            for (int q = 0; q < 4; ++q) w |= ((unsigned)(int)rintf(sp[(16 * j + 4 * d + q) * 33] * iv) & 0xffu) << (8 * q);
            o[d] = w; }
        *(g8::u32x4*)(Q + (size_t)(n0 + n) * 1024 + 64 * kc + 16 * j) = o; }
    __syncthreads();
}
__device__ __forceinline__ void quant_w1_item(const float* W, int N, signed char* Q, float* sbo, LAS float* scr, int nb, int lane) {
    const int n0 = 32 * nb;
    float4 m4 = make_float4(0.f, 0.f, 0.f, 0.f);
    const float* wp = W + (size_t)(lane >> 3) * N + n0 + 4 * (lane & 7);
#pragma unroll 1
    for (int kb = 0; kb < 16; ++kb) {
#pragma unroll
        for (int i = 0; i < 8; ++i) { const float4 v = *(const float4*)(wp + (size_t)i * 8 * N); m4.x = fmaxf(m4.x, fabsf(v.x)); m4.y = fmaxf(m4.y, fabsf(v.y)); m4.z = fmaxf(m4.z, fabsf(v.z)); m4.w = fmaxf(m4.w, fabsf(v.w)); }
        wp += (size_t)64 * N; }
#pragma unroll
    for (int o = 8; o < 64; o <<= 1) { m4.x = fmaxf(m4.x, __shfl_xor(m4.x, o)); m4.y = fmaxf(m4.y, __shfl_xor(m4.y, o)); m4.z = fmaxf(m4.z, __shfl_xor(m4.z, o)); m4.w = fmaxf(m4.w, __shfl_xor(m4.w, o)); }
    float mx; { const int src = (lane & 31) >> 2, cmp = lane & 3; const float a = __shfl(m4.x, src), b = __shfl(m4.y, src), c2 = __shfl(m4.z, src), d = __shfl(m4.w, src); mx = cmp == 0 ? a : cmp == 1 ? b : cmp == 2 ? c2 : d; }
    mx = fmaxf(mx, 1e-30f);
    const float inv = 127.0f / mx;
    if (lane < 32) sbo[n0 + lane] = mx * (1.0f / 127.0f);
    const int c = lane & 7;
    wp = W + (size_t)(lane >> 3) * N + n0 + 4 * (lane & 7);
#pragma unroll 1
    for (int kb = 0; kb < 16; ++kb) { const int k0 = 64 * kb;
#pragma unroll
        for (int i = 0; i < 8; ++i) { const float4 v = ldnt4(wp + (size_t)i * 8 * N); LAS float* d = scr + (8 * i + (lane >> 3)) * 33 + 4 * (lane & 7); d[0] = v.x; d[1] = v.y; d[2] = v.z; d[3] = v.w; }
        wp += (size_t)64 * N;
        WSYNC();
#pragma unroll
        for (int j = 0; j < 4; ++j) { const int n = (lane >> 3) + 8 * j; const LAS float* sp = scr + (8 * c) * 33 + n; const float iv = __shfl(inv, n);
            unsigned lo = 0u, hi = 0u;
#pragma unroll
            for (int q = 0; q < 4; ++q) { lo |= ((unsigned)(int)rintf(sp[q * 33] * iv) & 0xffu) << (8 * q); hi |= ((unsigned)(int)rintf(sp[(q + 4) * 33] * iv) & 0xffu) << (8 * q); }
            g8::u32x2 o; o.x = lo; o.y = hi; *(g8::u32x2*)(Q + (size_t)(n0 + n) * 1024 + k0 + 8 * c) = o; }
        WSYNC(); }
}
__device__ __forceinline__ void transpose_item_f8(const float* W, int K, int N, unsigned char* WT, float scale, LAS float* scr, int item, int lane) {
    const int nblk = N / 32, kb = item / nblk, nb = item % nblk, k0 = 64 * kb, n0 = 32 * nb;
#pragma unroll
    for (int i = 0; i < 8; ++i) { const int kk = 8 * i + (lane >> 3); const float4 v = ldnt4(W + (size_t)(k0 + kk) * N + n0 + 4 * (lane & 7));
        LAS float* d = scr + kk * 33 + 4 * (lane & 7); d[0] = v.x; d[1] = v.y; d[2] = v.z; d[3] = v.w; }
    WSYNC();
    const int c = lane & 7;
#pragma unroll
    for (int j = 0; j < 4; ++j) { const int n = (lane >> 3) + 8 * j; const LAS float* sp = scr + (8 * c) * 33 + n;
        unsigned lo = 0u, hi = 0u;
        lo = __builtin_amdgcn_cvt_pk_fp8_f32(sp[0 * 33] * scale, sp[1 * 33] * scale, lo, false); lo = __builtin_amdgcn_cvt_pk_fp8_f32(sp[2 * 33] * scale, sp[3 * 33] * scale, lo, true);
        hi = __builtin_amdgcn_cvt_pk_fp8_f32(sp[4 * 33] * scale, sp[5 * 33] * scale, hi, false); hi = __builtin_amdgcn_cvt_pk_fp8_f32(sp[6 * 33] * scale, sp[7 * 33] * scale, hi, true);
        g8::u32x2 o; o.x = lo; o.y = hi; *(g8::u32x2*)(WT + (size_t)(n0 + n) * K + k0 + 8 * c) = o; }
    WSYNC();
}
__device__ __forceinline__ float bf2f(unsigned short h) { return __uint_as_float((unsigned)h << 16); }
__device__ __forceinline__ void ln_wave(float4 (&v)[4], const float* g, const float* bta, int lane) {
    float s = 0.f;
#pragma unroll
    for (int j = 0; j < 4; ++j) s += (v[j].x + v[j].y) + (v[j].z + v[j].w);
    const float mean = wave_sum(s) * (1.f / D); float s2 = 0.f;
#pragma unroll
    for (int j = 0; j < 4; ++j) { v[j].x -= mean; v[j].y -= mean; v[j].z -= mean; v[j].w -= mean; s2 += (v[j].x * v[j].x + v[j].y * v[j].y) + (v[j].z * v[j].z + v[j].w * v[j].w); }
    const float rstd = 1.f / sqrtf(wave_sum(s2) * (1.f / D) + LN_EPS);
#pragma unroll
    for (int j = 0; j < 4; ++j) { const float4 gg = *(const float4*)(g + 4 * lane + 256 * j), bb = *(const float4*)(bta + 4 * lane + 256 * j);
        v[j].x = v[j].x * rstd * gg.x + bb.x; v[j].y = v[j].y * rstd * gg.y + bb.y; v[j].z = v[j].z * rstd * gg.z + bb.z; v[j].w = v[j].w * rstd * gg.w + bb.w; }
}


__device__ __forceinline__ float dot64_bf16(const unsigned short* kp, const LAS float* qv) {
    float s = 0.f;
#pragma unroll
    for (int c = 0; c < 8; ++c) { const g8::u32x4 kk = *(const g8::u32x4*)(kp + c * 8); const f32x4 q0 = *(const LAS f32x4*)(qv + c * 8), q1 = *(const LAS f32x4*)(qv + c * 8 + 4);
        s += __uint_as_float(kk.x << 16) * q0[0] + __uint_as_float(kk.x & 0xffff0000u) * q0[1] + __uint_as_float(kk.y << 16) * q0[2] + __uint_as_float(kk.y & 0xffff0000u) * q0[3]
           + __uint_as_float(kk.z << 16) * q1[0] + __uint_as_float(kk.z & 0xffff0000u) * q1[1] + __uint_as_float(kk.w << 16) * q1[2] + __uint_as_float(kk.w & 0xffff0000u) * q1[3]; }
    return s;
}
__device__ __forceinline__ unsigned short f2bf(float f) { return (unsigned short)(g8::cvt_pk_bf16(f, 0.f) & 0xffffu); }


namespace attn2 {
using bf16=__hip_bfloat16;
using bf16x8=__attribute__((ext_vector_type(8)))short;
using s16x4=__attribute__((ext_vector_type(4)))short;
using f32x16=__attribute__((ext_vector_type(16)))float;
using u32x4=__attribute__((ext_vector_type(4)))unsigned;
constexpr int SEQ=2048,D=64,PQ=3072,PO=1024;
constexpr int NW=8,QBLK=32,QB=QBLK*NW,KVBLK=64,NQB=SEQ/QB;
__device__ __forceinline__ int crow(int r,int hi){return (r&3)+8*(r>>2)+4*hi;}
#define SBAR() __builtin_amdgcn_sched_barrier(0)
__device__ __forceinline__ void cmask(f32x16&p0,f32x16&p1,int jb,int qrel,int hi){
  const float NEG=-INFINITY; int kb=64*jb+4*hi;
  #pragma unroll
  for(int r=0;r<16;++r){int kv=kb+(r&3)+8*(r>>2); if(kv>qrel)p0[r]=NEG; if(kv+32>qrel)p1[r]=NEG;}
}

constexpr int NSLOT=3, SLOTB=8192;
constexpr int LDS_K=0, LDS_V=NSLOT*SLOTB, LDS_WS=2*NSLOT*SLOTB, LDS_OST=LDS_WS+NW*64*4, LDS_BYTES=LDS_OST+NW*4096;
constexpr float C2=0.125f*1.4426950408889634f;
__device__ __forceinline__ void glds16(const void*gsrc,unsigned lds_dst){unsigned keep;
  asm volatile("s_mov_b32 %0, m0\n\ts_mov_b32 m0, %2\n\ts_nop 0\n\tglobal_load_lds_dwordx4 %1, off\n\ts_mov_b32 m0, %0":"=&s"(keep):"v"(gsrc),"s"(lds_dst):"memory");}
__device__ __forceinline__ float max3f(float a,float b,float c){float r;asm("v_max3_f32 %0, %1, %2, %3":"=v"(r):"v"(a),"v"(b),"v"(c));return r;}
__device__ __forceinline__ float max2f(float a,float b){float r;asm("v_max_f32_e32 %0, %1, %2":"=v"(r):"v"(a),"v"(b));return r;}
__device__ __forceinline__ float fadd_s(float a,float b){float r;asm("v_add_f32_e32 %0, %1, %2":"=v"(r):"v"(a),"v"(b));return r;}
__device__ __forceinline__ float fsub_s(float a,float b){float r;asm("v_sub_f32_e32 %0, %1, %2":"=v"(r):"v"(a),"v"(b));return r;}
typedef float f32x4_t __attribute__((ext_vector_type(4)));
__device__ __forceinline__ float bfs(short h){return __uint_as_float(((unsigned)(unsigned short)h)<<16);}
typedef float f32x2_t __attribute__((ext_vector_type(2))); typedef __bf16 bf16x2_t __attribute__((ext_vector_type(2)));
__device__ __forceinline__ unsigned cvtpk_s(float lo,float hi){f32x2_t v={lo,hi};bf16x2_t b=__builtin_convertvector(v,bf16x2_t);return __builtin_bit_cast(unsigned,b);}
#define WAIT_BAR(N) asm volatile("s_waitcnt vmcnt(" #N ") lgkmcnt(0)\n\ts_barrier":::"memory")

__device__ __forceinline__ void qkt(f32x16&p0,f32x16&p1,const char*Kslot,const bf16x8*qr,int r32,int hi){ const f32x16 negm=f32x16{};
  const char*kb=Kslot+hi*1024+r32*16;
  #pragma unroll
  for(int d0=0;d0<4;++d0){
    const bf16x8 b0=*reinterpret_cast<const bf16x8*>(kb+d0*2048);
    const bf16x8 b1=*reinterpret_cast<const bf16x8*>(kb+d0*2048+512);
    if(d0==0){p0=__builtin_amdgcn_mfma_f32_32x32x16_bf16(b0,qr[0],negm,0,0,0);p1=__builtin_amdgcn_mfma_f32_32x32x16_bf16(b1,qr[0],negm,0,0,0);}
    else{p0=__builtin_amdgcn_mfma_f32_32x32x16_bf16(b0,qr[d0],p0,0,0,0);p1=__builtin_amdgcn_mfma_f32_32x32x16_bf16(b1,qr[d0],p1,0,0,0);}}
}
typedef __attribute__((address_space(3))) const char* lds_cptr;
typedef short v4i16_t __attribute__((ext_vector_type(4)));
__device__ __forceinline__ void kload8(bf16x8*kf,lds_cptr kp){
  kf[0]=*(const __attribute__((address_space(3))) bf16x8*)(kp);      kf[1]=*(const __attribute__((address_space(3))) bf16x8*)(kp+512);
  kf[2]=*(const __attribute__((address_space(3))) bf16x8*)(kp+2048); kf[3]=*(const __attribute__((address_space(3))) bf16x8*)(kp+2560);
  kf[4]=*(const __attribute__((address_space(3))) bf16x8*)(kp+4096); kf[5]=*(const __attribute__((address_space(3))) bf16x8*)(kp+4608);
  kf[6]=*(const __attribute__((address_space(3))) bf16x8*)(kp+6144); kf[7]=*(const __attribute__((address_space(3))) bf16x8*)(kp+6656);
}
__device__ __forceinline__ void kload2(bf16x8*kf,lds_cptr kp,int j){ kf[2*j]=*(const __attribute__((address_space(3))) bf16x8*)(kp+j*2048); kf[2*j+1]=*(const __attribute__((address_space(3))) bf16x8*)(kp+j*2048+512); }
__device__ __forceinline__ s16x4 vtr(lds_cptr p){ return __builtin_bit_cast(s16x4,__builtin_amdgcn_ds_read_tr16_b64_v4i16((__attribute__((address_space(3))) v4i16_t*)p)); }
__device__ __forceinline__ float rowmax(const f32x16&p0,const f32x16&p1){
  float a=max3f(p0[0],p0[1],p1[0]),b=max3f(p0[2],p0[3],p1[1]);a=max3f(a,p1[2],p1[3]);
  #pragma unroll
  for(int r=4;r<16;r+=4){a=max3f(a,p0[r],p0[r+1]);b=max3f(b,p0[r+2],p0[r+3]);a=max3f(a,p1[r],p1[r+1]);b=max3f(b,p1[r+2],p1[r+3]);}
  const float m=max2f(a,b);
  auto rr=__builtin_amdgcn_permlane32_swap(__float_as_uint(m),__float_as_uint(m),false,false);
  return max2f(__uint_as_float(rr[0]),__uint_as_float(rr[1]));
}
__device__ __forceinline__ void pv(f32x16*o,int vb,bf16x8 pa0,bf16x8 pa1,bf16x8 pa2,bf16x8 pa3){
  #pragma unroll
  for(int d0=0;d0<2;++d0){s16x4 lo[4],hi[4];
    #pragma unroll
    for(int ks=0;ks<4;++ks){
      asm volatile("ds_read_b64_tr_b16 %0,%1 offset:%c2":"=&v"(lo[ks]):"v"(vb),"i"(d0*4096+ks*1024):"memory");
      asm volatile("ds_read_b64_tr_b16 %0,%1 offset:%c2":"=&v"(hi[ks]):"v"(vb),"i"(d0*4096+ks*1024+512):"memory");}
    asm volatile("s_waitcnt lgkmcnt(0)":::"memory");SBAR();
    #define PK(k) (bf16x8){lo[k][0],lo[k][1],lo[k][2],lo[k][3],hi[k][0],hi[k][1],hi[k][2],hi[k][3]}
    o[d0]=__builtin_amdgcn_mfma_f32_32x32x16_bf16(pa0,PK(0),o[d0],0,0,0);
    o[d0]=__builtin_amdgcn_mfma_f32_32x32x16_bf16(pa1,PK(1),o[d0],0,0,0);
    o[d0]=__builtin_amdgcn_mfma_f32_32x32x16_bf16(pa2,PK(2),o[d0],0,0,0);
    o[d0]=__builtin_amdgcn_mfma_f32_32x32x16_bf16(pa3,PK(3),o[d0],0,0,0);
    #undef PK
  }
}

#ifndef ATTN_STORE16
#define ATTN_STORE16(p,v) (*(u32x4*)(p)=(v))
#endif
template<int THRL> __device__ __forceinline__ void attn_unit(int b,int qb,const bool MOBA,const bf16*Qp,const bf16*__restrict__ Kp,const bf16*__restrict__ Vp,bf16*Op,const float*kmean_bh,char*shm){
  int tid_=threadIdx.x; asm volatile("":"+v"(tid_));
  const int tid=tid_,lane=tid&63,r32=lane&31,hi=lane>>5; const int wid=__builtin_amdgcn_readfirstlane(tid>>6);
  const long rowbase=(long)b*SEQ; const int q0=qb*QB;
  const bf16*Qw=Qp+(rowbase+q0+wid*QBLK)*PQ;
  const bf16*Kh=Kp+rowbase*PQ,*Vh=Vp+rowbase*PQ;
  const unsigned lds0=(unsigned)(uintptr_t)shm;
  float*wsf=(float*)(shm+LDS_WS)+wid*64;
  const bf16*ksrc=Kh+(long)lane*PQ+wid*8;
  const bf16*vsrc=Vh+(long)(16*(wid&3)+(lane>>2))*PQ+(wid>>2)*32+(lane&3)*8;
  const unsigned kdst=lds0+LDS_K+wid*1024, vdst=lds0+LDS_V+wid*1024;
  #define TILE(t) (((t)<4)?(NT-4+(t)):((t)-4))
  #define DMA_K(t,slot) glds16(ksrc+(long)TILE(t)*KVBLK*PQ,(unsigned)__builtin_amdgcn_readfirstlane(kdst+(slot)))
  #define DMA_V(t,slot) glds16(vsrc+(long)TILE(t)*KVBLK*PQ,(unsigned)__builtin_amdgcn_readfirstlane(vdst+(slot)))
  const int vb0=(int)(lds0+LDS_V)+((lane>>4)&1)*32+(lane&3)*8+(4*hi+((lane&15)>>2))*64;
  const char*Kbase=shm+LDS_K; bf16x8 kf[8];
  const lds_cptr shm3=(lds_cptr)shm; const lds_cptr kp0=shm3+LDS_K+hi*1024+r32*16; const lds_cptr vp0=shm3+LDS_V+((lane>>4)&1)*32+(lane&3)*8+(4*hi+((lane&15)>>2))*64;
  const int NT=(q0+QB)/KVBLK;
  DMA_K(0,0);DMA_V(0,0);DMA_K(1,SLOTB);
  bf16x8 qr[4];
  #pragma unroll
  for(int d0=0;d0<4;++d0)qr[d0]=*reinterpret_cast<const bf16x8*>(&Qw[(long)r32*PQ+d0*16+hi*8]);
  unsigned selmask=0xffu;
  if(MOBA&&qb>=4){ float g[8];
    #pragma unroll
    for(int n=0;n<8;++n){ g[n]=-INFINITY; if(n<qb){ float s=0.f; const float*km=kmean_bh+n*64+hi*8;
        #pragma unroll
        for(int d0=0;d0<4;++d0){ const f32x4_t k0=*reinterpret_cast<const f32x4_t*>(km+d0*16),k1=*reinterpret_cast<const f32x4_t*>(km+d0*16+4); const bf16x8 qq=qr[d0];
          s+=bfs(qq[0])*k0[0]+bfs(qq[1])*k0[1]+bfs(qq[2])*k0[2]+bfs(qq[3])*k0[3]+bfs(qq[4])*k1[0]+bfs(qq[5])*k1[1]+bfs(qq[6])*k1[2]+bfs(qq[7])*k1[3]; }
        auto rr=__builtin_amdgcn_permlane32_swap(__float_as_uint(s),__float_as_uint(s),false,false); g[n]=__uint_as_float(rr[0])+__uint_as_float(rr[1]); } }
    selmask=0u;
    #pragma unroll
    for(int r=0;r<3;++r){ int best=-1; float bv=0.f;
      #pragma unroll
      for(int n=0;n<8;++n) if(n<qb&&!((selmask>>n)&1u)&&(best<0||g[n]>bv)){best=n;bv=g[n];}
      selmask|=1u<<best; } }
  float mhat=0.f,l_reg=0.f;f32x16 o[2];o[0]=f32x16{};o[1]=f32x16{};
  const int qrel=wid*QBLK+r32;
  const int jw=wid>>1;
  #define CMASK_SUB(P0,P1,t,SUB) do{ SUB=mhat; if((t)<4){ if((t)==jw)cmask(P0,P1,(t),qrel,hi); else if((t)>jw)SUB=INFINITY; } \
      else if(MOBA&&qb>=4){ if(!((selmask>>(((t)-4)>>2))&1u))SUB=INFINITY; } }while(0)
  bool resc=false;
  #define START(P0,P1) do{ const float rm=rowmax(P0,P1); resc=false; \
    { const float dl=(__builtin_fabsf(rm)>(float)THRL)?rm:0.f; mhat=dl;     \
      if(__any(dl!=0.f)){ _Pragma("unroll") for(int r=0;r<16;++r){P0[r]=fsub_s(P0[r],dl);P1[r]=fsub_s(P1[r],dl);} } \
    } \
    _Pragma("unroll") for(int r=0;r<16;++r)P0[r]=__builtin_amdgcn_exp2f(P0[r]); }while(0)
  #define RESC() do{ if(resc){ asm volatile("s_waitcnt lgkmcnt(0)":::"memory"); \
      _Pragma("unroll") for(int d_=0;d_<2;++d_) _Pragma("unroll") for(int r=0;r<16;++r)o[d_][r]*=wsf[crow(r,hi)]; } }while(0)
  f32x16 pA0,pA1,pB0,pB1;
  int sl_prev=0,sl_cur=0,sl_next=SLOTB;
  #define ROT() do{sl_prev=sl_cur;sl_cur=sl_next;sl_next=(sl_next==(NSLOT-1)*SLOTB)?0:sl_next+SLOTB;}while(0)
  DMA_K(2,2*SLOTB);
  WAIT_BAR(3);
  qkt(pA0,pA1,Kbase,qr,r32,hi);asm volatile("s_nop 15\n\ts_nop 7":"+v"(pA0),"+v"(pA1));if(jw==0)cmask(pA0,pA1,0,qrel,hi);
  START(pA0,pA1);
  _Pragma("unroll") for(int r=0;r<16;++r)pA1[r]=__builtin_amdgcn_exp2f(pA1[r]);
  WAIT_BAR(0);
  DMA_K(3,0);DMA_V(1,SLOTB);
  ROT();
  kload8(kf,kp0+sl_cur);
  WAIT_BAR(2);
  s16x4 vlo[8],vhi[8]; u32x4 pw0,pw1,pw2,pw3;
  #define PKW(P,B) cvtpk_s(P[B],P[B+1])
  #define PAF(k) __builtin_bit_cast(bf16x8,pw##k)
  #define VFR(i) (bf16x8){vlo[i][0],vlo[i][1],vlo[i][2],vlo[i][3],vhi[i][0],vhi[i][1],vhi[i][2],vhi[i][3]}
  #define PIN(x) asm volatile("":"+v"(x))
  #define MX3(a,b,c) __builtin_fmaxf(__builtin_fmaxf((a),(b)),(c))
  #define GAPA(MF,A0,A1,A2,A3,W0,W1,PW) do{ MF; sacc+=A0; sacc+=A1; sacc+=A2; sacc+=A3; PIN(sacc); W0; W1; PIN(PW); SBAR(); }while(0)
  #define EX(v) __builtin_amdgcn_exp2f(v)
  #define GAPB(MF,X,B) do{ MF; X[B]=EX(X[B]); X[B+1]=EX(X[B+1]); X[B+2]=EX(X[B+2]); X[B+3]=EX(X[B+3]); PIN(X); SBAR(); }while(0)
  #define VRD(i) do{ vlo[i]=vtr(vp_+(((i)>>2)*4096+((i)&3)*1024)); vhi[i]=vtr(vp_+(((i)>>2)*4096+((i)&3)*1024+512)); }while(0)
  #define KRD(G,j) do{ if(G){ kload2(kf,kp0+sl_next,j); SBAR(); } }while(0)
  #define STEP(C0,C1,P0,P1,t,GK,GV,GL) do{ SBAR(); \
    const lds_cptr vp_=vp0+sl_prev; \
    VRD(0); SBAR(); float sacc=(P0[0]+P0[1]); \
    GAPA(C0=__builtin_amdgcn_mfma_f32_32x32x16_bf16(kf[0],qr[0],f32x16{},0,0,0), P0[2],P0[3],P0[4],P0[5],     pw0[0]=PKW(P0,0), pw0[1]=PKW(P0,2), pw0); \
    VRD(4); SBAR(); GAPA(C1=__builtin_amdgcn_mfma_f32_32x32x16_bf16(kf[1],qr[0],f32x16{},0,0,0), P0[6],P0[7],P0[8],P0[9],     pw0[2]=PKW(P0,4), pw0[3]=PKW(P0,6), pw0); \
    VRD(1); SBAR(); GAPA(C0=__builtin_amdgcn_mfma_f32_32x32x16_bf16(kf[2],qr[1],C0,0,0,0),   P0[10],P0[11],P0[12],P0[13], pw1[0]=PKW(P0,8), pw1[1]=PKW(P0,10), pw1); \
    VRD(5); SBAR(); GAPA(C1=__builtin_amdgcn_mfma_f32_32x32x16_bf16(kf[3],qr[1],C1,0,0,0),   P0[14],P0[15],P1[0],P1[1],   pw1[2]=PKW(P0,12),pw1[3]=PKW(P0,14), pw1); \
    VRD(2); SBAR(); GAPA(C0=__builtin_amdgcn_mfma_f32_32x32x16_bf16(kf[4],qr[2],C0,0,0,0),   P1[2],P1[3],P1[4],P1[5],     pw2[0]=PKW(P1,0), pw2[1]=PKW(P1,2), pw2); \
    VRD(6); SBAR(); GAPA(C1=__builtin_amdgcn_mfma_f32_32x32x16_bf16(kf[5],qr[2],C1,0,0,0),   P1[6],P1[7],P1[8],P1[9],     pw2[2]=PKW(P1,4), pw2[3]=PKW(P1,6), pw2); \
    VRD(3); SBAR(); GAPA(C0=__builtin_amdgcn_mfma_f32_32x32x16_bf16(kf[6],qr[3],C0,0,0,0),   P1[10],P1[11],P1[12],P1[13], pw3[0]=PKW(P1,8), pw3[1]=PKW(P1,10), pw3); \
    VRD(7); SBAR(); GAPA(C1=__builtin_amdgcn_mfma_f32_32x32x16_bf16(kf[7],qr[3],C1,0,0,0),   P1[14],P1[15],0.f,0.f,       pw3[2]=PKW(P1,12),pw3[3]=PKW(P1,14), pw3); \
    l_reg+=sacc; \
    if(GK){DMA_K((t)+3,sl_cur);} if(GV){DMA_V((t)+1,sl_next);} \
    { float sub_; CMASK_SUB(C0,C1,t,sub_); \
    if(__any(sub_!=0.f)){ _Pragma("unroll") for(int r=0;r<16;++r){C0[r]=fsub_s(C0[r],sub_);C1[r]=fsub_s(C1[r],sub_);} } }   \
    { float a=MX3(C0[0],C0[1],C1[0]),b=MX3(C0[2],C0[3],C1[1]); a=MX3(a,C1[2],C1[3]); \
      _Pragma("unroll") for(int r=4;r<16;r+=4){a=MX3(a,C0[r],C0[r+1]);b=MX3(b,C0[r+2],C0[r+3]);a=MX3(a,C1[r],C1[r+1]);b=MX3(b,C1[r+2],C1[r+3]);} \
      float rm=__builtin_fmaxf(a,b); { auto rr=__builtin_amdgcn_permlane32_swap(__float_as_uint(rm),__float_as_uint(rm),false,false); rm=__builtin_fmaxf(__uint_as_float(rr[0]),__uint_as_float(rr[1])); } \
      resc=false; \
      if(__builtin_expect(__any(rm>(float)THRL),0)){ const float dl=__builtin_fmaxf(rm,0.f); mhat+=dl; \
        _Pragma("unroll") for(int r=0;r<16;++r){C0[r]-=dl;C1[r]-=dl;} \
        const float f=__builtin_amdgcn_exp2f(-dl); l_reg*=f; if(hi==0)wsf[r32]=f; resc=true; } } \
    SBAR(); \
    GAPB(o[0]=__builtin_amdgcn_mfma_f32_32x32x16_bf16(PAF(0),VFR(0),o[0],0,0,0), C0,0); \
    GAPB(o[1]=__builtin_amdgcn_mfma_f32_32x32x16_bf16(PAF(0),VFR(4),o[1],0,0,0), C0,4); \
    KRD(GL,0); GAPB(o[0]=__builtin_amdgcn_mfma_f32_32x32x16_bf16(PAF(1),VFR(1),o[0],0,0,0), C0,8); \
    KRD(GL,1); GAPB(o[1]=__builtin_amdgcn_mfma_f32_32x32x16_bf16(PAF(1),VFR(5),o[1],0,0,0), C0,12); \
    KRD(GL,2); GAPB(o[0]=__builtin_amdgcn_mfma_f32_32x32x16_bf16(PAF(2),VFR(2),o[0],0,0,0), C1,0); \
    KRD(GL,3); GAPB(o[1]=__builtin_amdgcn_mfma_f32_32x32x16_bf16(PAF(2),VFR(6),o[1],0,0,0), C1,4); \
    GAPB(o[0]=__builtin_amdgcn_mfma_f32_32x32x16_bf16(PAF(3),VFR(3),o[0],0,0,0), C1,8); \
    GAPB(o[1]=__builtin_amdgcn_mfma_f32_32x32x16_bf16(PAF(3),VFR(7),o[1],0,0,0), C1,12); \
    }while(0)
  int t=1;
  for(;t+5<NT;t+=2){
    STEP(pB0,pB1,pA0,pA1,t,true,true,true);     WAIT_BAR(2); RESC(); ROT();
    STEP(pA0,pA1,pB0,pB1,t+1,true,true,true);   WAIT_BAR(2); RESC(); ROT();
  }
  #define ENDW(tt) do{ if((tt)+3<NT){WAIT_BAR(2);} else if((tt)+2<NT){WAIT_BAR(1);} else {WAIT_BAR(0);} }while(0)
  for(;t+1<NT;t+=2){
    STEP(pB0,pB1,pA0,pA1,t,(t+3<NT),(t+1<NT),(t+1<NT));       ENDW(t);   RESC(); ROT();
    STEP(pA0,pA1,pB0,pB1,t+1,(t+4<NT),(t+2<NT),(t+2<NT));     ENDW(t+1); RESC(); ROT();
  }
  STEP(pB0,pB1,pA0,pA1,NT-1,false,false,false); RESC();
  { float sacc=pB0[0]+pB0[1]; _Pragma("unroll") for(int r=2;r<16;++r)sacc+=pB0[r]; _Pragma("unroll") for(int r=0;r<16;++r)sacc+=pB1[r]; l_reg+=sacc;
    pw0=(u32x4){PKW(pB0,0),PKW(pB0,2),PKW(pB0,4),PKW(pB0,6)};pw1=(u32x4){PKW(pB0,8),PKW(pB0,10),PKW(pB0,12),PKW(pB0,14)};pw2=(u32x4){PKW(pB1,0),PKW(pB1,2),PKW(pB1,4),PKW(pB1,6)};pw3=(u32x4){PKW(pB1,8),PKW(pB1,10),PKW(pB1,12),PKW(pB1,14)};
    SBAR(); pv(o,vb0+sl_cur,PAF(0),PAF(1),PAF(2),PAF(3)); }
  #undef PKW
  #undef PAF
  #undef VFR
  #undef PIN
  #undef MX3
  #undef GAPA
  #undef GAPB
  #undef EX
  #undef VRD
  #undef KRD
  #undef STEP
  #undef ENDW
  {auto rr=__builtin_amdgcn_permlane32_swap(__float_as_uint(l_reg),__float_as_uint(l_reg),false,false);l_reg=__uint_as_float(rr[0])+__uint_as_float(rr[1]);}
  if(hi==0)wsf[32+r32]=l_reg;asm volatile("s_waitcnt lgkmcnt(0)":::"memory");
  float rli[16];
  #pragma unroll
  for(int r=0;r<16;++r)rli[r]=__builtin_amdgcn_rcpf(wsf[32+crow(r,hi)]);
  bf16*Ow=Op+(rowbase+q0+wid*QBLK)*PO;
  { bf16*stg=(bf16*)(shm+LDS_OST)+wid*2048;
    #pragma unroll
    for(int r=0;r<16;++r){const int orow=crow(r,hi);
      #pragma unroll
      for(int d0=0;d0<2;++d0)stg[orow*64+d0*32+r32]=__float2bfloat16(o[d0][r]*rli[r]);}
    asm volatile("s_waitcnt lgkmcnt(0)":::"memory");
    #pragma unroll
    for(int i=0;i<4;++i){const int row=i*8+(lane>>3),ch=lane&7; const u32x4 v=*(const u32x4*)(stg+row*64+ch*8); ATTN_STORE16(Ow+(long)row*PO+ch*8,v);} }
  asm volatile("s_waitcnt lgkmcnt(0)\n\ts_barrier":::"memory");
  #undef DMA_K
  #undef TILE
  #undef DMA_V
  #undef CMASK_SUB
  #undef START
  #undef RESC
  #undef ROT
}
constexpr int ATTN_LDS_BYTES=LDS_BYTES;
#undef SBAR
#undef WAIT_BAR
}
__device__ __forceinline__ void attn_phase(char* lds, const unsigned short* projb_, unsigned short* tmpb_, unsigned short* mixb_, const float* kmean, int G, int blk,
                                           const float* lq1, const float* lk1, const float* lq2, const float* lk2, const float* subln_g) {
    using attn2::bf16;
    const bf16* projb = (const bf16*)projb_; bf16* tmpb = (bf16*)tmpb_; bf16* mixb = (bf16*)mixb_;
    const int vcu = (G % 8 == 0) ? (blk % 8) * (G / 8) + blk / 8 : blk;
    for (int it = vcu; it < 1536; it += G) {
        const bool moba = it >= 512; const int q = moba ? it - 512 : it;
        const int s = q & 3, h = moba ? (q >> 2) & 7 : (q >> 2) & 3, b = moba ? q >> 5 : q >> 4, nun = moba ? 2 : 8;
        const float* km = kmean + (size_t)((b * 8 + (moba ? h : 0)) * 8) * 64;
        for (int k = 0; k < nun; ++k) {
            const int u = moba ? k : k >> 2, cv = k & 3, c = cv >> 1, vh = cv & 1, qb = u ? s : 7 - s;
            const int qcol = moba ? 1536 + h * 64 : h * 128 + c * 64, kcol = moba ? 2048 + h * 64 : 512 + h * 128 + c * 64, vcol = moba ? 2560 + h * 64 : 1024 + h * 128 + vh * 64;
            bf16* op = moba ? mixb + 512 + h * 64 : tmpb + (h * 2 + c) * 128 + vh * 64;
            attn2::attn_unit<8>(b, qb, moba, projb + qcol, projb + kcol, projb + vcol, op, km, lds);
            if (!moba && cv == 3) {
                const int lane = threadIdx.x & 63, wave = threadIdx.x >> 6, tk = lane >> 4, sg = lane & 15;
                float l4[4] = {lq1[lane], lk1[lane], lq2[lane], lk2[lane]}; float gg[8];
#pragma unroll
                for (int i = 0; i < 8; ++i) gg[i] = subln_g[sg * 8 + i] * 0.8f;
                asm volatile("s_waitcnt vmcnt(0)" : "+v"(l4[0]), "+v"(l4[1]), "+v"(l4[2]), "+v"(l4[3]) :: "memory"); __syncthreads();
                float lam; { const float a = wave_sum(l4[0] * l4[1]), b2 = wave_sum(l4[2] * l4[3]); lam = expf(a) - expf(b2) + 0.2f; }
                const unsigned short* tb = tmpb_; unsigned short* mb = mixb_;
                g8::u32x4 ua[8], ub[8];
#pragma unroll
                for (int g = 0; g < 8; ++g) { const size_t r = (size_t)b * SEQ + qb * 256 + wave * 4 + 32 * g + tk;
                    const unsigned short* p1 = tb + r * D + (h * 2) * 128 + sg * 8; const unsigned short* p2 = tb + r * D + (h * 2 + 1) * 128 + sg * 8;
                    asm volatile("global_load_dwordx4 %0, %1, off sc0 sc1" : "=v"(ua[g]) : "v"(p1) : "memory");
                    asm volatile("global_load_dwordx4 %0, %1, off sc0 sc1" : "=v"(ub[g]) : "v"(p2) : "memory"); }
                asm volatile("s_waitcnt vmcnt(0)" : "+v"(ua[0]), "+v"(ua[1]), "+v"(ua[2]), "+v"(ua[3]), "+v"(ua[4]), "+v"(ua[5]), "+v"(ua[6]), "+v"(ua[7]), "+v"(ub[0]), "+v"(ub[1]), "+v"(ub[2]), "+v"(ub[3]), "+v"(ub[4]), "+v"(ub[5]), "+v"(ub[6]), "+v"(ub[7]) :: "memory");
#pragma unroll
                for (int g = 0; g < 8; ++g) { const size_t r = (size_t)b * SEQ + qb * 256 + wave * 4 + 32 * g + tk;
                    unsigned u1[4], u2[4];
#pragma unroll
                    for (int i = 0; i < 4; ++i) { u1[i] = ua[g][i]; u2[i] = ub[g][i]; }
                    float a[8];
#pragma unroll
                    for (int i = 0; i < 4; ++i) { a[2 * i] = __uint_as_float(u1[i] << 16) - lam * __uint_as_float(u2[i] << 16); a[2 * i + 1] = __uint_as_float(u1[i] & 0xffff0000u) - lam * __uint_as_float(u2[i] & 0xffff0000u); }
                    float ss = 0.f;
#pragma unroll
                    for (int i = 0; i < 8; ++i) ss += a[i] * a[i];
                    ss += __shfl_xor(ss, 1); ss += __shfl_xor(ss, 2); ss += __shfl_xor(ss, 4); ss += __shfl_xor(ss, 8);
                    const float rr = 1.0f / sqrtf(ss * (1.0f / 128.0f) + 1e-5f);
                    g8::u32x4 o;
#pragma unroll
                    for (int i = 0; i < 4; ++i) o[i] = g8::cvt_pk_bf16(a[2 * i] * rr * gg[2 * i], a[2 * i + 1] * rr * gg[2 * i + 1]);
                    *(g8::u32x4*)(mb + r * D + h * 128 + sg * 8) = o; }
            }
        }
    }
}

struct Args { const float* in[26]; float* out; unsigned char* ws; int ph_lo, ph_hi; };
constexpr int LDS_BYTES = 163840, MISC_OFF = 144 * 1024 - 256, XS_OFF = 131072, GOFF_OFF = 140 * 1024, STG_OFF = 147456;
constexpr int NPH = 14;

__global__ void __launch_bounds__(NTHR, 2) fwd(Args args) {
    extern __shared__ __attribute__((aligned(16))) unsigned char lds_arr[];
    LAS unsigned char* lds = (LAS unsigned char*)lds_arr;
    volatile LAS unsigned* MISC = (volatile LAS unsigned*)(lds + MISC_OFF);
#define PH_VARS const int tid = threadIdx.x, lane = tid & 63, wave = __builtin_amdgcn_readfirstlane(tid >> 6); \
    const int gw = blockIdx.x * NWAVES + wave, NGW = gridDim.x * NWAVES; const int gt = blockIdx.x * NTHR + tid, NGT = gridDim.x * NTHR; (void)lane; (void)gw; (void)NGW; (void)gt; (void)NGT;
#define PTRS \
    unsigned char* ws = (unsigned char*)KA->ws; \
    unsigned* ctl = (unsigned*)(ws + WS_CTL); \
    const float* x = (const float*)KA->in[0]; const float* mem = (const float*)KA->in[1]; const float* w_in = (const float*)KA->in[2]; \
    const float* lq1 = (const float*)KA->in[3]; const float* lk1 = (const float*)KA->in[4]; const float* lq2 = (const float*)KA->in[5]; const float* lk2 = (const float*)KA->in[6]; \
    const float* subln_g = (const float*)KA->in[7]; const float* w_out = (const float*)KA->in[8]; const float* ln1_g = (const float*)KA->in[9]; const float* ln1_b = (const float*)KA->in[10]; \
    const float* mem_g = (const float*)KA->in[11]; const float* mem_b = (const float*)KA->in[12]; const float* w_q = (const float*)KA->in[13]; const float* w_kv = (const float*)KA->in[14]; \
    const float* w_o = (const float*)KA->in[15]; const float* ln2_g = (const float*)KA->in[16]; const float* ln2_b = (const float*)KA->in[17]; const float* w_router = (const float*)KA->in[18]; \
    const float* b_router = (const float*)KA->in[19]; const float* w_mlp1 = (const float*)KA->in[20]; const float* b_mlp1 = (const float*)KA->in[21]; const float* w_mlp2 = (const float*)KA->in[22]; \
    const float* b_mlp2 = (const float*)KA->in[23]; const float* ln3_g = (const float*)KA->in[24]; const float* ln3_b = (const float*)KA->in[25]; \
    float* out = (float*)KA->out; \
    float* ropec = (float*)(ws + WS_ROPE); float* ropes = ropec + SEQ * 8; \
    float* kmean = (float*)(ws + WS_KMEAN); \
    int* topi = (int*)(ws + WS_TOPI); float* topw = (float*)(ws + WS_TOPW); int* list = (int*)(ws + WS_LIST); float* wpos = (float*)(ws + WS_WPOS); int* posof = (int*)(ws + WS_POSOF); \
    bf* wint = (bf*)(ws + WS_WINT); bf* woutt = (bf*)(ws + WS_WOUTT); bf* wqb = (bf*)(ws + WS_WQB); bf* wkvt = (bf*)(ws + WS_WKVT); bf* wot = (bf*)(ws + WS_WOT); bf* w1t = (bf*)(ws + WS_W1T); bf* w2t = (bf*)(ws + WS_W2T); \
    bf* xb = (bf*)(ws + WS_XB); bf* projb = (bf*)(ws + WS_PROJ); bf* memn = (bf*)(ws + WS_MEMN); bf* kvmb = (bf*)(ws + WS_KVM); bf* gtb = (bf*)(ws + WS_GT); bf* vwtb = (bf*)(ws + WS_VWT); \
    bf* h1b = (bf*)(ws + WS_H1B); bf* t2b = (bf*)(ws + WS_OUT2); bf* pb = (bf*)(ws + WS_P); bf* h2b = (bf*)(ws + WS_H2B); \
    bf* mixb = (bf*)out + (size_t)T * D; \
    float* t2 = out; long long* lnst = (long long*)(ws + WS_LNZ); long long* gcs = (long long*)(ws + WS_LNZ + 1024 * 1024); long long* gbf = (long long*)(ws + WS_LNZ + 1280 * 1024); bf* hidb = (bf*)out; signed char* w1q = (signed char*)(ws + WS_W1T); unsigned char* w2q = (unsigned char*)(ws + WS_W2T); unsigned char* hid8 = (unsigned char*)out; signed char* h2q = (signed char*)(ws + WS_H2Q); float* sa = (float*)(ws + WS_SA); float* sbw = (float*)(ws + WS_SB); float* sapos = (float*)(ws + WS_SAPOS); float* sxr = (float*)(ws + WS_SX); float* swin = (float*)(ws + WS_SWIN); signed char* xq = (signed char*)(ws + WS_XB); \
    unsigned* cnt = ctl + CW_CNT; unsigned* fill = ctl + CW_FILL; \
    const int G = (int)gridDim.x, cB = (int)blockIdx.x; (void)ctl; (void)cnt; (void)fill; (void)G; (void)cB;
    typedef unsigned short bf;
    const volatile __attribute__((address_space(4))) Args* const KA = (const volatile __attribute__((address_space(4))) Args*)__builtin_amdgcn_kernarg_segment_ptr();
    unsigned* const ctl0 = (unsigned*)((unsigned char*)KA->ws + WS_CTL);
    if (threadIdx.x < 64) MISC[threadIdx.x] = 0u;
    __syncthreads();
    const int lo = KA->ph_lo, hi = KA->ph_hi;
    XcdBarrier bar; bar.bar = ctl0 + CW_BAR; bar.x = 0; bar.st = MISC + 8;
    if (hi - lo > 1) bar = xcd_barrier_post(ctl0 + CW_BAR, MISC + 8);
#define OPQ(x) ({ int _v = (x); asm volatile("" : "+s"(_v)); _v; })
#define IN(k) (OPQ(lo) <= (k) && (k) < OPQ(hi))
#define SEAM(k) do { if (IN(k) && IN((k) + 1)) xcd_barrier(bar); } while (0)

    if (IN(0)) {
        PH_VARS
        PTRS
        for (int i = gt; i < SEQ * 8; i += NGT) { double s, c; sincos_d((double)(i >> 3) * INV_FREQ[i & 7], s, c); ropec[i] = (float)c; ropes[i] = (float)s; }
        for (int r = gw; r < TM; r += NGW) { float4 v[4];
#pragma unroll
            for (int j = 0; j < 4; ++j) v[j] = *(const float4*)(mem + (size_t)r * D + 4 * lane + 256 * j);
            ln_wave(v, mem_g, mem_b, lane);
#pragma unroll
            for (int j = 0; j < 4; ++j) { g8::u32x2 w; w.x = g8::cvt_pk_bf16(v[j].x, v[j].y); w.y = g8::cvt_pk_bf16(v[j].z, v[j].w); *(g8::u32x2*)(memn + (size_t)r * D + 4 * lane + 256 * j) = w; } }
        for (int r = gw; r < T; r += NGW) { float4 v[4];
#pragma unroll
            for (int j = 0; j < 4; ++j) v[j] = ldnt4(x + (size_t)r * D + 4 * lane + 256 * j);
            float am = 0.f;
#pragma unroll
            for (int j = 0; j < 4; ++j) am = fmaxf(am, fmaxf(fmaxf(fabsf(v[j].x), fabsf(v[j].y)), fmaxf(fabsf(v[j].z), fabsf(v[j].w))));
            am = fmaxf(wave_max(am), 1e-30f); const float iv = 127.0f / am; if (lane == 0) sxr[r] = am * (1.0f / 127.0f);
#pragma unroll
            for (int j = 0; j < 4; ++j) { const unsigned q = ((unsigned)(int)rintf(v[j].x * iv) & 0xffu) | (((unsigned)(int)rintf(v[j].y * iv) & 0xffu) << 8) | (((unsigned)(int)rintf(v[j].z * iv) & 0xffu) << 16) | (((unsigned)(int)rintf(v[j].w * iv) & 0xffu) << 24);
                *(unsigned*)(xq + (size_t)r * D + 4 * lane + 256 * j) = q; } }
        for (size_t i = (size_t)gt; i < (size_t)D * D / 8; i += (size_t)NGT) { const float* src = w_q + i * 8; bf* dst = wqb + i * 8;
            const float4 a = *(const float4*)src, b = *(const float4*)(src + 4);
            g8::u32x4 w; w.x = g8::cvt_pk_bf16(a.x, a.y); w.y = g8::cvt_pk_bf16(a.z, a.w); w.z = g8::cvt_pk_bf16(b.x, b.y); w.w = g8::cvt_pk_bf16(b.z, b.w); *(g8::u32x4*)dst = w; }
        LAS float* scr = (LAS float*)lds + wave * (64 * 33);
        constexpr int I_IN = NPROJ / 32  , I_SQ = (D / 64) * (D / 32), I_KV = (D / 64) * (2 * D / 32), I2 = (DFF / 64) * (D / 32);
        constexpr int I1Q = 2 * DFF / 32;
        constexpr int NIT = I_SQ + I_KV + I_SQ + NEXP * I2;
        for (int it = gw; it < NIT; it += NGW) { int r = it;
            const float* W; unsigned short* WT; int K_, N_, q; bool quant = false, f8 = false, quant_in = false; int qe = 0;
            if (r < I_SQ) { W = w_out; WT = woutt; K_ = D; N_ = D; q = r; }
            else if ((r -= I_SQ) < I_KV) { W = w_kv; WT = wkvt; K_ = D; N_ = 2 * D; q = r; }
            else if ((r -= I_KV) < I_SQ) { W = w_o; WT = wot; K_ = D; N_ = D; q = r; }
            else { r -= I_SQ; qe = r / I2; q = r - qe * I2; W = w_mlp2 + (size_t)qe * DFF * D; WT = nullptr; K_ = DFF; N_ = D; f8 = true; }
            (void)quant; (void)quant_in;
            if (f8) transpose_item_f8(W, K_, N_, w2q + (size_t)qe * D * DFF, g8::W2_SCALE, scr, q, lane);
            else transpose_item(W, K_, N_, WT, scr, q, lane); }
        __syncthreads();
        { lfloat* stage = (lfloat*)lds; lfloat* red = stage + 1024 * 33;
          for (int it = blockIdx.x; it < I_IN + NEXP * I1Q; it += gridDim.x) {
              if (it < I_IN) quant_w1_block(w_in, NPROJ, (signed char*)wint, swin, stage, red, it, tid);
              else { const int r = it - I_IN, qe = r / I1Q, q = r - qe * I1Q; quant_w1_block(w_mlp1 + (size_t)qe * D * 2 * DFF, 2 * DFF, w1q + (size_t)qe * 2 * DFF * D, sbw + (size_t)qe * 2 * DFF, stage, red, q, tid); } } }
    }
    SEAM(0);
    if (IN(1)) {
        PTRS
        { g8::DenseOrder S; S.init(T, NPROJ, D / 2, G, cB); g8::EpiProj E{projb, ropec, ropes, lds + STG_OFF, sxr, swin, lds + XS_OFF}; int kq = D / 2; asm volatile("" : "+s"(kq)); g8::gemm_phase<g8::EpiProj, g8::DenseOrder, false>(lds, (const bf*)xq, D / 2, (const bf*)wint, D / 2, kq, nullptr, S, E); }
        { g8::DenseOrder S; S.init(TM, 2 * D, D, G, cB); g8::EpiPlainB E{kvmb, 2 * D, lds + STG_OFF}; g8::gemm_phase<g8::EpiPlainB, g8::DenseOrder, false>(lds, memn, D, wkvt, D, D, nullptr, S, E); }
    }
    SEAM(1);
    if (IN(2)) {
        PH_VARS
        PTRS
        int k256 = 256; asm volatile("" : "+s"(k256));
        { g8::GtOrder S{G, cB}; g8::EpiGT E{gtb, ln1_g, ln1_b, gcs, gbf, lds + STG_OFF}; g8::gemm_phase<g8::EpiGT, g8::GtOrder, false>(lds, kvmb, 2 * D, wqb, D, k256, nullptr, S, E); }
        { g8::VwtOrder S{G, cB}; g8::EpiPlainB E{vwtb, D, lds + STG_OFF}; g8::gemm_phase<g8::EpiPlainB, g8::VwtOrder, false>(lds, wot, D, kvmb, 2 * D, k256, nullptr, S, E); }
        for (int it = gw; it < BATCH * 8 * 8; it += NGW) { const int n = it & 7, h = (it >> 3) & 7, b = it >> 6;
            const bf* kp = projb + ((size_t)b * SEQ + n * 256) * NPROJ + 2048 + h * 64 + lane; float s = 0.f;
            for (int j = 0; j < 256; ++j) s += bf2f(kp[(size_t)j * NPROJ]);
            kmean[((b * 8 + h) * 8 + n) * 64 + lane] = s * (1.0f / 256.0f); }
    }
    SEAM(2);
    if (IN(3)) { PTRS attn_phase((char*)lds_arr, projb, (bf*)out, mixb, kmean, G, cB, lq1, lk1, lq2, lk2, subln_g); }
    if (IN(3) && IN(5)) xcd_barrier(bar);
    if (IN(5)) { PTRS g8::DenseOrder S; S.init(T, D, D, G, cB); g8::EpiResidStats E{h1b, x, lnst, ALPHA}; g8::gemm_phase<g8::EpiResidStats, g8::DenseOrder, false>(lds, mixb, D, woutt, D, D, nullptr, S, E); }
    if (IN(5) && IN(7)) xcd_barrier(bar);
    if (IN(7)) { PTRS g8::BatchOrder S; S.init(T, D, D, G, cB); S.bbatch_rows = D; g8::EpiSoftmaxP E{pb, lds + XS_OFF, lds + STG_OFF, lnst, gcs, gbf}; g8::gemm_phase<g8::EpiSoftmaxP, g8::BatchOrder, false>(lds, h1b, D, gtb, D, D, nullptr, S, E); }
    SEAM(7);
    if (IN(8)) { PTRS g8::BatchOrder S; S.init(T, D, D, G, cB); S.bbatch_rows = D; g8::EpiPlainB E{t2b, D, lds + STG_OFF}; g8::gemm_phase<g8::EpiPlainB, g8::BatchOrder, false>(lds, pb, D, vwtb, D, D, nullptr, S, E); }
    SEAM(8);
    if (IN(9)) {
        PH_VARS
        PTRS
        lfloat* xs = (lfloat*)lds; lfloat* red = (lfloat*)(lds + 32 * 1028 * 4); LAS int* chist = (LAS int*)(lds + 32 * 1028 * 4 + 2 * 32 * 33 * 4);
        if (tid < NEXP) chist[tid] = 0;
        __syncthreads();
        const int rh = wave & 1, eh = (wave >> 1) & 1, kh = wave >> 2, li = lane & 15, hq = lane >> 4;
        float Bw[128];
        { const float* wp = w_router + (size_t)(512 * kh + 128 * hq) * NEXP + 16 * eh + li;
#pragma unroll
          for (int s2 = 0; s2 < 128; ++s2) Bw[s2] = wp[(size_t)s2 * NEXP]; }
        for (int rb = blockIdx.x; rb < T / 32; rb += gridDim.x) {
#pragma unroll 1
            for (int rp = 0; rp < 4; rp += 2) {
            g8::u32x2 pin[2][4], pc[2][4]; float s1[2], s2[2];
#pragma unroll
            for (int rr = 0; rr < 2; ++rr) { const size_t r = (size_t)rb * 32 + 4 * wave + rp + rr;
                const long long* sp = lnst + 2 * r; asm volatile("" : "+v"(sp));
                s1[rr] = fx_get(sp); s2[rr] = fx_get(sp + 1);
#pragma unroll
                for (int j = 0; j < 4; ++j) { pin[rr][j] = *(const g8::u32x2*)(h1b + r * D + 4 * lane + 256 * j); pc[rr][j] = *(const g8::u32x2*)(t2b + r * D + 4 * lane + 256 * j); } }
#pragma unroll
            for (int rr = 0; rr < 2; ++rr) asm volatile("" : "+v"(pin[rr][0]), "+v"(pin[rr][1]), "+v"(pin[rr][2]), "+v"(pin[rr][3]), "+v"(pc[rr][0]), "+v"(pc[rr][1]), "+v"(pc[rr][2]), "+v"(pc[rr][3]), "+v"(s1[rr]), "+v"(s2[rr]));
#pragma unroll
            for (int rr = 0; rr < 2; ++rr) { const int row = 4 * wave + rp + rr; const size_t r = (size_t)rb * 32 + row; float4 v[4];
                const float mean1 = s1[rr] * (1.0f / 1024.0f), rstd1 = 1.0f / sqrtf(fmaxf(s2[rr] * (1.0f / 1024.0f) - mean1 * mean1, 0.f) + LN_EPS);
#pragma unroll
                for (int j = 0; j < 4; ++j) { const g8::u32x2 p = pin[rr][j], c = pc[rr][j]; const float4 gg = *(const float4*)(ln1_g + 4 * lane + 256 * j), bb = *(const float4*)(ln1_b + 4 * lane + 256 * j);
                    v[j].x = ((__uint_as_float(p.x << 16) - mean1) * rstd1 * gg.x + bb.x) * ALPHA + __uint_as_float(c.x << 16);
                    v[j].y = ((__uint_as_float(p.x & 0xffff0000u) - mean1) * rstd1 * gg.y + bb.y) * ALPHA + __uint_as_float(c.x & 0xffff0000u);
                    v[j].z = ((__uint_as_float(p.y << 16) - mean1) * rstd1 * gg.z + bb.z) * ALPHA + __uint_as_float(c.y << 16);
                    v[j].w = ((__uint_as_float(p.y & 0xffff0000u) - mean1) * rstd1 * gg.w + bb.w) * ALPHA + __uint_as_float(c.y & 0xffff0000u); }
                ln_wave(v, ln2_g, ln2_b, lane);
#pragma unroll
                for (int j = 0; j < 4; ++j) { g8::u32x2 w; w.x = g8::cvt_pk_bf16(v[j].x, v[j].y); w.y = g8::cvt_pk_bf16(v[j].z, v[j].w); *(g8::u32x2*)(h2b + r * D + 4 * lane + 256 * j) = w;
                    *(LAS f32x4*)&xs[row * 1028 + 4 * lane + 256 * j] = (f32x4){v[j].x, v[j].y, v[j].z, v[j].w}; }
                { float am = 0.f;
#pragma unroll
                  for (int j = 0; j < 4; ++j) am = fmaxf(am, fmaxf(fmaxf(fabsf(v[j].x), fabsf(v[j].y)), fmaxf(fabsf(v[j].z), fabsf(v[j].w))));
                  am = fmaxf(wave_max(am), 1e-30f); const float iv = 127.0f / am; if (lane == 0) sa[r] = am * (1.0f / 127.0f);
#pragma unroll
                  for (int j = 0; j < 4; ++j) { const unsigned q = ((unsigned)(int)rintf(v[j].x * iv) & 0xffu) | (((unsigned)(int)rintf(v[j].y * iv) & 0xffu) << 8) | (((unsigned)(int)rintf(v[j].z * iv) & 0xffu) << 16) | (((unsigned)(int)rintf(v[j].w * iv) & 0xffu) << 24);
                      *(unsigned*)(h2q + r * D + 4 * lane + 256 * j) = q; } } }
            }
            __syncthreads();
            f32x4 acc = {0.f, 0.f, 0.f, 0.f};
            { const lfloat* xp = xs + (16 * rh + li) * 1028 + 512 * kh + 128 * hq;
#pragma unroll
              for (int s4 = 0; s4 < 32; ++s4) { const f32x4 a4 = *(const LAS f32x4*)(xp + 4 * s4);
#pragma unroll
                  for (int u = 0; u < 4; ++u) acc = __builtin_amdgcn_mfma_f32_16x16x4f32(a4[u], Bw[4 * s4 + u], acc, 0, 0, 0); } }
#pragma unroll
            for (int q = 0; q < 4; ++q) red[(kh * 32 + 16 * rh + 4 * hq + q) * 33 + 16 * eh + li] = acc[q];
            __syncthreads();
            if (wave == 0 && lane < 32) { const size_t r = (size_t)rb * 32 + lane; float l32[NEXP];
#pragma unroll
                for (int e = 0; e < NEXP; ++e) l32[e] = red[lane * 33 + e] + red[(32 + lane) * 33 + e] + b_router[e];
                int bi[4]; float bv[4]; unsigned used = 0u;
#pragma unroll
                for (int k = 0; k < 4; ++k) { int best = -1; float bval = 0.f;
#pragma unroll
                    for (int e = 0; e < NEXP; ++e) if (!((used >> e) & 1u) && (best < 0 || l32[e] > bval)) { best = e; bval = l32[e]; }
                    used |= 1u << best; bi[k] = best; bv[k] = bval; }
                const float e0 = 1.0f, e1 = expf(bv[1] - bv[0]), e2 = expf(bv[2] - bv[0]), e3 = expf(bv[3] - bv[0]), inv = 1.0f / (e0 + e1 + e2 + e3);
                *(int4*)(topi + r * 4) = make_int4(bi[0], bi[1], bi[2], bi[3]); *(float4*)(topw + r * 4) = make_float4(e0 * inv, e1 * inv, e2 * inv, e3 * inv);
                __hip_atomic_fetch_add(&chist[bi[0]], 1, __ATOMIC_RELAXED, __HIP_MEMORY_SCOPE_WORKGROUP); __hip_atomic_fetch_add(&chist[bi[1]], 1, __ATOMIC_RELAXED, __HIP_MEMORY_SCOPE_WORKGROUP);
                __hip_atomic_fetch_add(&chist[bi[2]], 1, __ATOMIC_RELAXED, __HIP_MEMORY_SCOPE_WORKGROUP); __hip_atomic_fetch_add(&chist[bi[3]], 1, __ATOMIC_RELAXED, __HIP_MEMORY_SCOPE_WORKGROUP); }
            __syncthreads();
        }
        if (tid < NEXP) { const int n = chist[tid]; if (n) atomicAdd(&cnt[tid], (unsigned)n); }
    }
    SEAM(9);
    LAS int* goff = (LAS int*)(lds + GOFF_OFF);
    if (hi > 10) { const int tid = threadIdx.x; unsigned* cnt = ctl0 + CW_CNT; __syncthreads(); if (tid < 1) { int a = 0; for (int e = 0; e < NEXP; ++e) { goff[tid * 33 + e] = a; a += (int)__hip_atomic_load(&cnt[tid * NEXP + e], __ATOMIC_RELAXED, __HIP_MEMORY_SCOPE_AGENT); } goff[tid * 33 + 32] = a; } __syncthreads(); }
    if (IN(10)) {
        PH_VARS
        PTRS
        LAS int* hist = (LAS int*)lds; LAS int* base = hist + 32;
        for (int ch = blockIdx.x; ch < T / 256; ch += gridDim.x) {
            if (tid < 32) hist[tid] = 0;
            __syncthreads();
            const int t = ch * 256 + tid; int ee[4] = {0, 0, 0, 0}, loc[4] = {0, 0, 0, 0}; float ww[4] = {0.f, 0.f, 0.f, 0.f};
            if (tid < 256) { const int4 e4 = *(const int4*)(topi + (size_t)t * 4); const float4 w4 = *(const float4*)(topw + (size_t)t * 4);
                ee[0] = e4.x; ee[1] = e4.y; ee[2] = e4.z; ee[3] = e4.w; ww[0] = w4.x; ww[1] = w4.y; ww[2] = w4.z; ww[3] = w4.w;
#pragma unroll
                for (int k = 0; k < 4; ++k) loc[k] = __hip_atomic_fetch_add(&hist[ee[k]], 1, __ATOMIC_RELAXED, __HIP_MEMORY_SCOPE_WORKGROUP); }
            __syncthreads();
            if (tid < 32) { const int n = hist[tid]; base[tid] = goff[tid] + (n ? (int)atomicAdd(&fill[tid], (unsigned)n) : 0); }
            __syncthreads();
            if (tid < 256) { int pp[4]; const float sat = sa[t];
#pragma unroll
                for (int k = 0; k < 4; ++k) { const int pos = base[ee[k]] + loc[k]; list[pos] = t; wpos[pos] = ww[k]; sapos[pos] = sat; pp[k] = pos; }
                *(int4*)(posof + (size_t)t * 4) = make_int4(pp[0], pp[1], pp[2], pp[3]); }
            __syncthreads();
        }
    }
    SEAM(10);
    {
        PTRS
        bf* out2_p = (bf*)(ws + WS_OUT2);
        if (IN(11)) { g8::MoeOrder S{goff, 8, G, cB, D / 2, 0, 0, -1, 0}; g8::EpiSwigluI8 E{hid8, b_mlp1, sapos, sbw};
            g8::gemm_phase<g8::EpiSwigluI8, g8::MoeOrder, true>(lds, (const bf*)h2q, D / 2, (const bf*)w1q, D / 2, D / 2, list, S, E); }
        SEAM(11);
        if (IN(12)) { g8::MoeOrder S{goff, 4, G, cB, DFF / 2, 0, 0, -1, 0}; g8::EpiMoe2F8 E{out2_p, b_mlp2, wpos, lds + STG_OFF};
            int kq = DFF / 2; asm volatile("" : "+s"(kq));
            g8::gemm_phase<g8::EpiMoe2F8, g8::MoeOrder, false>(lds, (const bf*)hid8, DFF / 2, (const bf*)w2q, DFF / 2, kq, nullptr, S, E); }
        SEAM(12);
    }
    if (IN(13)) {
        PH_VARS
        PTRS
        const bf* o0 = (const bf*)(ws + WS_OUT2); const bf* o1 = o0; const bf* o2 = o0; const bf* o3 = o0;
        for (int r = gw; r < T; r += NGW) { float4 v[4]; const int4 ps = *(const int4*)(posof + (size_t)r * 4);
#pragma unroll
            for (int j = 0; j < 4; ++j) { const int c = 4 * lane + 256 * j;
                const g8::u32x2 hh = __builtin_nontemporal_load((const g8::u32x2*)(h2b + (size_t)r * D + c)), a0 = __builtin_nontemporal_load((const g8::u32x2*)(o0 + (size_t)ps.x * D + c)), a1 = __builtin_nontemporal_load((const g8::u32x2*)(o1 + (size_t)ps.y * D + c)),
                                a2 = __builtin_nontemporal_load((const g8::u32x2*)(o2 + (size_t)ps.z * D + c)), a3 = __builtin_nontemporal_load((const g8::u32x2*)(o3 + (size_t)ps.w * D + c));
#define LO(u) __uint_as_float((u) << 16)
#define HI(u) __uint_as_float((u) & 0xffff0000u)
                v[j].x = ALPHA * LO(hh.x) + ((LO(a0.x) + LO(a1.x)) + (LO(a2.x) + LO(a3.x)));
                v[j].y = ALPHA * HI(hh.x) + ((HI(a0.x) + HI(a1.x)) + (HI(a2.x) + HI(a3.x)));
                v[j].z = ALPHA * LO(hh.y) + ((LO(a0.y) + LO(a1.y)) + (LO(a2.y) + LO(a3.y)));
                v[j].w = ALPHA * HI(hh.y) + ((HI(a0.y) + HI(a1.y)) + (HI(a2.y) + HI(a3.y)));
#undef LO
#undef HI
            }
            ln_wave(v, ln3_g, ln3_b, lane);
#pragma unroll
            for (int j = 0; j < 4; ++j) stnt4(out + (size_t)r * D + 4 * lane + 256 * j, v[j]); }
    }
#undef IN
#undef SEAM
}

extern "C" void kernel_launch(void* const* d_in, const int* in_sizes, int n_in, void* d_out, int out_size, void* d_ws, size_t ws_size, hipStream_t stream) {
    static int grid = 0;
    if (grid == 0) {
        if (n_in != 26 || out_size != T * D || ws_size < WS_END) { fprintf(stderr, "kernel_launch: unexpected shapes (n_in %d out %d ws %zu)\n", n_in, out_size, ws_size); grid = -1; return; }
        int dev = 0, cus = 0, per_cu = 0;
        if (hipGetDevice(&dev) != hipSuccess || hipDeviceGetAttribute(&cus, hipDeviceAttributeMultiprocessorCount, dev) != hipSuccess) { grid = -1; return; }
        if (hipFuncSetAttribute((const void*)fwd, hipFuncAttributeMaxDynamicSharedMemorySize, LDS_BYTES) != hipSuccess) { fprintf(stderr, "kernel_launch: hipFuncSetAttribute failed\n"); grid = -1; return; }
        if (hipOccupancyMaxActiveBlocksPerMultiprocessor(&per_cu, (const void*)fwd, NTHR, LDS_BYTES) != hipSuccess || per_cu < 1) fprintf(stderr, "kernel_launch: occupancy query reports %d\n", per_cu);
        (void)hipGetLastError();
        grid = cus;
    }
    if (grid < 0) return;
    (void)hipMemsetAsync((char*)d_ws + WS_CTL, 0, CTL_ZERO_BYTES, stream);
    (void)hipMemsetAsync((char*)d_ws + WS_LNZ, 0, LNZ_BYTES, stream);
    Args a{};
    for (int i = 0; i < 26; ++i) a.in[i] = (const float*)d_in[i];
    a.out = (float*)d_out; a.ws = (unsigned char*)d_ws;
#if ONE_LAUNCH
#ifdef EXP_PREFIX
    a.ph_lo = 0; a.ph_hi = EXP_PREFIX + 1; hipLaunchKernelGGL(fwd, dim3(grid), dim3(NTHR), LDS_BYTES, stream, a);
    (void)hipMemsetAsync((char*)d_ws + WS_CTL, 0, CTL_ZERO_BYTES, stream); (void)hipMemsetAsync((char*)d_ws + WS_LNZ, 0, LNZ_BYTES, stream);
#endif
#ifndef EXP_LIST
    a.ph_lo = 0; a.ph_hi = NPH;
    hipLaunchKernelGGL(fwd, dim3(grid), dim3(NTHR), LDS_BYTES, stream, a);
#else
    { const int reps[] = {EXP_LIST}; int lo = 0;
      for (unsigned i = 0; i <= sizeof(reps) / sizeof(int); ++i) { const int hi = (i < sizeof(reps) / sizeof(int)) ? reps[i] + 1 : NPH;
          if (i) (void)hipMemsetAsync((char*)d_ws + WS_CTL + CW_BAR * 4, 0, (CW_CNT - CW_BAR) * 4, stream);
          a.ph_lo = lo; a.ph_hi = hi; hipLaunchKernelGGL(fwd, dim3(grid), dim3(NTHR), LDS_BYTES, stream, a); lo = hi - 1; } }
#endif
#else
    for (int p = 0; p < NPH; ++p) { a.ph_lo = p; a.ph_hi = p + 1; hipLaunchKernelGGL(fwd, dim3(grid), dim3(NTHR), LDS_BYTES, stream, a); }
#endif
}
```

```cpp
#include <hip/hip_runtime.h>
#include <hip/hip_bf16.h>
#include <cmath>
#include <cstdio>
#include <cstdint>

#ifndef ONE_LAUNCH
#define ONE_LAUNCH 1
#endif

constexpr int BATCH = 32, SEQ = 2048, D = 1024, T = BATCH * SEQ;
constexpr int MEML = 256, TM = BATCH * MEML;
constexpr int NPROJ = 3072;
constexpr int NEXP = 32, TOPK = 4, DFF = 1024;
constexpr float ALPHA = 1.189207115002721f;
constexpr float LN_EPS = 1e-5f;
constexpr int NTHR = 512, NWAVES = 8;

#define GAS __attribute__((address_space(1)))
#define LAS __attribute__((address_space(3)))
typedef LAS float lfloat;
typedef float f32x4 __attribute__((ext_vector_type(4)));
#define WSYNC() asm volatile("s_waitcnt lgkmcnt(0)" ::: "memory")

constexpr size_t MiB = 1u << 20;
constexpr size_t WS_CTL = 0, CTL_ZERO_BYTES = 1 * MiB;
constexpr size_t WS_ROPE = 1 * MiB;
constexpr size_t WS_KMEAN = 2 * MiB;
constexpr size_t WS_LNZ = 10 * MiB, LNZ_BYTES = 2 * MiB;
constexpr float FXS = 16777216.0f, FXI = 1.0f / 16777216.0f;
__device__ __forceinline__ void fx_add(long long* p, float v) { atomicAdd((unsigned long long*)p, (unsigned long long)(long long)rintf(v * FXS)); }
__device__ __forceinline__ float fx_get(const long long* p) { const int2 v = *(const int2*)p; return ((float)v.y * 4294967296.0f + (float)(unsigned)v.x) * FXI; }
constexpr size_t WS_SX = 13 * MiB, WS_SWIN = 14 * MiB;
constexpr size_t WS_SAPOS = 12 * MiB;
constexpr size_t WS_SA = 8 * MiB, WS_SB = 9 * MiB;
constexpr size_t WS_H2Q = 96 * MiB;
constexpr size_t WS_TOPI = 3 * MiB, WS_TOPW = 4 * MiB, WS_LIST = 5 * MiB, WS_WPOS = 6 * MiB, WS_POSOF = 7 * MiB;
constexpr size_t WS_WINT = 16 * MiB, WS_WOUTT = 22 * MiB, WS_WQB = 24 * MiB, WS_WKVT = 26 * MiB, WS_WOT = 30 * MiB, WS_W1T = 32 * MiB, WS_W2T = 160 * MiB;
constexpr size_t WS_XB = 224 * MiB;
constexpr size_t WS_PROJ = 352 * MiB;
constexpr size_t WS_MEMN = 736 * MiB, WS_KVM = 752 * MiB;
constexpr size_t WS_GT = 784 * MiB, WS_VWT = 848 * MiB;
constexpr size_t WS_H1B = 224 * MiB;
constexpr size_t WS_P = 608 * MiB;
constexpr size_t WS_H2B = 224 * MiB;
constexpr size_t WS_OUT2 = 352 * MiB;
constexpr size_t WS_END = 912 * MiB;
constexpr int CW_BAR = 4096, CW_CNT = 8192, CW_FILL = 8448;
constexpr float C2Q = 0.125f * 1.4426950408889634f;
constexpr float C2M = 0.0625f * 1.4426950408889634f;

#define XB_TMO      128
#define XB_XCNT(j)  (256  + 64 * (j))
#define XB_XSUB(j)  (1280 + 64 * (j))
#define XB_XGEN(j)  (2304 + 64 * (j))
#define XB_TOP      3328
#define XB_TOPGEN   3392
#define XCD_BAR_WORDS 3456
#define XB_SPIN_CAP (1u << 24)

__device__ __forceinline__ unsigned xb_ld(unsigned* p)              { return __hip_atomic_load(p, __ATOMIC_RELAXED, __HIP_MEMORY_SCOPE_AGENT); }
__device__ __forceinline__ unsigned xb_add(unsigned* p, unsigned v) { return __hip_atomic_fetch_add(p, v, __ATOMIC_RELAXED, __HIP_MEMORY_SCOPE_AGENT); }
__device__ __forceinline__ unsigned xb_xcc_id() { return (unsigned)__builtin_amdgcn_s_getreg((3 << 11) | 20) & 0xFu; }
#define XB_SPIN(cond, bar) do { unsigned _sp = 0; while (cond) { __builtin_amdgcn_s_sleep(1); \
    if ((++_sp & 255u) == 0u) { if (xb_ld(&(bar)[XB_TMO])) break; if (_sp > XB_SPIN_CAP) { atomicAdd(&(bar)[XB_TMO], 1u); break; } } } } while (0)

struct XcdBarrier { unsigned* bar; unsigned x; volatile LAS unsigned* st; };

__device__ __forceinline__ XcdBarrier xcd_barrier_post(unsigned* bar, volatile LAS unsigned* st) {
    XcdBarrier b; b.bar = bar; b.x = xb_xcc_id(); b.st = st;
    if (threadIdx.x == 0) (void)xb_add(&bar[XB_XCNT(b.x)], 1u);
    return b;
}
__device__ __forceinline__ void xcd_barrier_complete(unsigned* bar, unsigned x, unsigned& nloc, unsigned& nx) {
    const unsigned G = gridDim.x * gridDim.y * gridDim.z;
    unsigned sum, cnt, mine, sp = 0u;
    for (;;) {
        sum = 0u; cnt = 0u; mine = 0u;
#pragma unroll
        for (unsigned j = 0; j < 16; ++j) { const unsigned c = xb_ld(&bar[XB_XCNT(j)]); sum += c; cnt += (c > 0u) ? 1u : 0u; mine = (j == x) ? c : mine; }
        if (sum == G) break;
        __builtin_amdgcn_s_sleep(1);
        if ((++sp & 255u) == 0u) { if (xb_ld(&bar[XB_TMO])) break; if (sp > XB_SPIN_CAP) { atomicAdd(&bar[XB_TMO], 1u); break; } }
    }
    nloc = mine > 0u ? mine : 1u; nx = cnt > 0u ? cnt : 1u;
}
__device__ __forceinline__ void xcd_barrier(const XcdBarrier& b) {
    asm volatile("s_waitcnt vmcnt(0)" ::: "memory");
    __syncthreads();
    if (threadIdx.x == 0) {
        unsigned* bar = b.bar;
        __builtin_amdgcn_s_waitcnt(0);
        unsigned nloc = b.st[0], nx = b.st[1];
        if (nloc == 0u) { xcd_barrier_complete(bar, b.x, nloc, nx); b.st[0] = nloc; b.st[1] = nx; }
        const unsigned old = xb_add(&bar[XB_XSUB(b.x)], 1u);
        const unsigned gen = old / nloc;
        if (old + 1u == (gen + 1u) * nloc) {
            __builtin_amdgcn_fence(__ATOMIC_RELEASE, "agent");
            asm volatile("s_waitcnt vmcnt(0)" ::: "memory");
            const unsigned og = xb_add(&bar[XB_TOP], 1u);
            const unsigned tg = og / nx;
            if (og + 1u == (tg + 1u) * nx) xb_add(&bar[XB_TOPGEN], 1u);
            else XB_SPIN(xb_ld(&bar[XB_TOPGEN]) == tg, bar);
            __builtin_amdgcn_fence(__ATOMIC_ACQUIRE, "agent");
            xb_add(&bar[XB_XGEN(b.x)], 1u);
            asm volatile("s_waitcnt vmcnt(0)" ::: "memory");
        } else {
            XB_SPIN(xb_ld(&bar[XB_XGEN(b.x)]) == gen, bar);
            __builtin_amdgcn_fence(__ATOMIC_ACQUIRE, "agent");
            asm volatile("s_waitcnt vmcnt(0)" ::: "memory");
        }
    }
    __syncthreads();
}

__device__ __forceinline__ float wave_sum(float v) {
#pragma unroll
    for (int o = 1; o < 64; o <<= 1) v += __shfl_xor(v, o);
    return v;
}
__device__ __forceinline__ float wave_max(float v) {
#pragma unroll
    for (int o = 1; o < 64; o <<= 1) v = fmaxf(v, __shfl_xor(v, o));
    return v;
}
__device__ __forceinline__ void sincos_d(double a, double& s, double& c) {
    const double TWO_PI_HI = 6.283185307179586232, TWO_PI_LO = 2.4492935982947064e-16;
    const double k = rint(a / TWO_PI_HI);
    double r = (a - k * TWO_PI_HI) - k * TWO_PI_LO;
    const double r2 = r * r;
    double ts = 1.0, tc = 1.0;
#pragma unroll
    for (int n = 16; n >= 1; --n) {
        ts = 1.0 - ts * r2 / (double)((2 * n) * (2 * n + 1));
        tc = 1.0 - tc * r2 / (double)((2 * n - 1) * (2 * n));
    }
    s = r * ts; c = tc;
}
__constant__ double INV_FREQ[8] = {1.0, 0.19392274474868576, 0.03760603093086393, 0.007292664737217109,
                                   0.001414213562373095, 0.0002742481756762073, 5.318295896944988e-05, 1.031338537721246e-05};

namespace g8 {
typedef unsigned short bf16_t;
typedef short bf16x8 __attribute__((ext_vector_type(8)));
typedef unsigned u32x4 __attribute__((ext_vector_type(4)));
typedef unsigned u32x2 __attribute__((ext_vector_type(2)));
typedef int i32x4 __attribute__((ext_vector_type(4)));
constexpr int BM = 256, BK = 64, HALF = 128, HTB = HALF * BK * 2, STAGE_BYTES = 8 * HTB, NXCD = 8, WGM = 8;
__host__ __device__ __forceinline__ int lds_byte(int r, int c) { const int st = (r >> 4) * 2 + (c >> 5), rr = r & 15, cc = c & 31, ob = rr * 64 + cc * 2; return st * 1024 + (ob ^ (((ob >> 9) & 1) << 5)); }
__host__ __device__ __forceinline__ void stage_rc(int b, int& R, int& C) { const int st = b / 1024, sb = b % 1024, swz = sb ^ (((sb >> 9) & 1) << 5); R = (st >> 1) * 16 + swz / 64; C = (st & 1) * 32 + (swz % 64) / 2; }
__host__ __device__ __forceinline__ int perm32(int rho) { const int n = rho >> 4, i = rho & 15; return 8 * (i >> 2) + 4 * n + (i & 3); }
__device__ __forceinline__ unsigned cvt_pk_bf16(float lo, float hi) { unsigned r; asm volatile("v_cvt_pk_bf16_f32 %0, %1, %2" : "=v"(r) : "v"(lo), "v"(hi)); return r; }

struct Unit { int arow0, nrows, acol0, orow0, ocol0, aux; size_t boff; };

struct DenseOrder {
    int nM, nN, nwg, G, c, ldb;
    __device__ void init(int M, int N, int ldb_, int G_, int c_) { nM = M / BM; nN = N / BM; nwg = nM * nN; G = G_; c = c_; ldb = ldb_; }
    __device__ bool tile(int i, int& pm, int& pn) const {
        const long L = (long)i * G + c; if (L >= nwg) return false;
        int wgid = (int)L; { const int q = nwg / NXCD, r = nwg % NXCD, xcd = wgid % NXCD, off = wgid / NXCD; wgid = (xcd < r ? xcd * (q + 1) : r * (q + 1) + (xcd - r) * q) + off; }
        const int nig = WGM * nN, gid = wgid / nig, fm = gid * WGM, gsz = (nM - fm) < WGM ? (nM - fm) : WGM;
        pm = fm + ((wgid % nig) % gsz); pn = (wgid % nig) / gsz; return true;
    }
    __device__ bool next(int i, Unit& u) const { int pm, pn; if (!tile(i, pm, pn)) return false;
        u.arow0 = pm * BM; u.nrows = BM; u.acol0 = 0; u.orow0 = pm * BM; u.ocol0 = pn * BM; u.aux = 0; u.boff = (size_t)pn * BM * ldb; return true; }
};
struct MoeOrder {
    const LAS int* goff; int nct, G, c, ldb;
    mutable int e_ = 0, base_ = 0, lo_ = -1, hi_ = 0;
    __device__ __forceinline__ int g(int e) const { return __builtin_amdgcn_readfirstlane(goff[e]); }
    __device__ bool next(int i, Unit& u) const {
        const int L = i * G + c;
        if (lo_ < 0) { lo_ = g(0); hi_ = g(1); }
        for (;;) { if (e_ >= 32) return false; const int n = ((hi_ - lo_ + 255) >> 8) * nct; if (L < base_ + n) break; base_ += n; ++e_; lo_ = hi_; hi_ = e_ < 32 ? g(e_ + 1) : hi_; }
        const int li = L - base_, rt = li / nct, ct = li - rt * nct;
        u.arow0 = lo_ + rt * BM; u.nrows = min(BM, hi_ - u.arow0); u.acol0 = 0; u.orow0 = u.arow0; u.ocol0 = ct * BM; u.aux = e_;
        u.boff = ((size_t)e_ * nct + ct) * BM * ldb; return true; }
};

__device__ __forceinline__ f32x4 mma_bf16(bf16x8 b, bf16x8 a, f32x4 c) { return __builtin_amdgcn_mfma_f32_16x16x32_bf16(b, a, c, 0, 0, 0); }
__device__ __forceinline__ i32x4 mma_bf16(bf16x8, bf16x8, i32x4 c) { return c; }
__device__ __forceinline__ i32x4 mma_i8(bf16x8 b, bf16x8 a, i32x4 c) { return __builtin_amdgcn_mfma_i32_16x16x64_i8(__builtin_bit_cast(i32x4, b), __builtin_bit_cast(i32x4, a), c, 0, 0, 0); }
__device__ __forceinline__ f32x4 mma_i8(bf16x8, bf16x8, f32x4 c) { return c; }
typedef int i32x8 __attribute__((ext_vector_type(8)));
__device__ __forceinline__ f32x4 mma_f8(i32x8 b, i32x8 a, f32x4 c) { const int one = 127; asm volatile("v_mfma_scale_f32_16x16x128_f8f6f4 %0, %1, %2, %0, %3, %3 op_sel_hi:[0,0,0]" : "+v"(c) : "v"(b), "v"(a), "v"(one)); return c; }
__device__ __forceinline__ i32x4 mma_f8(i32x8, i32x8, i32x4 c) { return c; }
template <class Epi, class Sched, bool GATHER>
__device__ __forceinline__ void gemm_phase(LAS unsigned char* lds, const bf16_t* A, int lda, const bf16_t* Bt, int ldb, int K, const int* list, const Sched& S, const Epi& E) {
    int tid_ = threadIdx.x; asm volatile("" : "+v"(tid_));
    const int tid = tid_, wid = __builtin_amdgcn_readfirstlane(tid >> 6), lane = tid & 63, wr = wid >> 2, wc = wid & 3, fr = lane & 15, fq = lane >> 4;
    const int nt = K / BK;
    unsigned voffB[2];
#pragma unroll
    for (int i = 0; i < 2; ++i) { int R, C; stage_rc(tid * 16 + i * 8192, R, C); const int Rb = 64 * (R >> 5) + (Epi::PERM ? perm32(R & 31) : (R & 31));   voffB[i] = (unsigned)(Rb * ldb + C) * 2u; }
    const size_t kstep = (size_t)(BK * 2);
    const size_t hstepB = (size_t)32 * ldb * 2;
    const unsigned ldsw = (unsigned)wid * 1024u;
    const int aoff = lds_byte(wr * 64 + fr, fq * 8), boff = lds_byte(wc * 32 + fr, fq * 8);
#define G8_MKRAW(V, U) do { _Pragma("unroll") for (int _h = 0; _h < 2; ++_h) _Pragma("unroll") for (int _i = 0; _i < 2; ++_i) { int _R, _C; stage_rc(tid * 16 + _i * 8192, _R, _C); int _r = 128 * _h + _R; _r = _r < (U).nrows ? _r : (U).nrows - 1; \
            V[_h][_i] = GATHER ? (unsigned)list[(U).arow0 + _r] : (unsigned)((U).arow0 + _r); } } while (0)
#define G8_MKCONV(V, U) do { _Pragma("unroll") for (int _h = 0; _h < 2; ++_h) _Pragma("unroll") for (int _i = 0; _i < 2; ++_i) { int _R, _C; stage_rc(tid * 16 + _i * 8192, _R, _C); V[_h][_i] = (V[_h][_i] * (unsigned)lda + (unsigned)((U).acol0 + _C)) * 2u; } } while (0)
#define G8_MKOFF(V, U) do { G8_MKRAW(V, U); G8_MKCONV(V, U); } while (0)
#define G8_SA(b, h) (((b) * 2 + (h)) * HTB)
#define G8_SB(b, h) ((4 + (b) * 2 + (h)) * HTB)
#define G8_STAGE_B(bufoff, gbase) do { _Pragma("unroll") for (int _i = 0; _i < 2; ++_i) \
        __builtin_amdgcn_global_load_lds((const unsigned*)((const char*)(gbase) + voffB[_i]), (LAS unsigned*)(lds + (bufoff) + ldsw + _i * 8192), 16, 0, 0); } while (0)
#define G8_STAGE_A(bufoff, kb, V, h) do { _Pragma("unroll") for (int _i = 0; _i < 2; ++_i) \
        __builtin_amdgcn_global_load_lds((const unsigned*)((const char*)A + (kb) + V[h][_i]), (LAS unsigned*)(lds + (bufoff) + ldsw + _i * 8192), 16, 0, 0); } while (0)
#define G8_STAGE_A2(bufoff, kb, h) do { _Pragma("unroll") for (int _i = 0; _i < 2; ++_i) \
        __builtin_amdgcn_global_load_lds((const unsigned*)((const char*)A + (kb) + (last ? vN[h][_i] : vC[h][_i])), (LAS unsigned*)(lds + (bufoff) + ldsw + _i * 8192), 16, 0, 0); } while (0)
#define G8_LDA(dst, b, h) do { if constexpr (Epi::F8) { _Pragma("unroll") for (int m = 0; m < 4; ++m) { const i32x4 _l = *(const LAS i32x4*)(lds + G8_SA(b, h) + aoff + m * 2048), _h = *(const LAS i32x4*)(lds + G8_SA(b, h) + aoff + m * 2048 + 1024); dst##8[m] = __builtin_shufflevector(_l, _h, 0, 1, 2, 3, 4, 5, 6, 7); } } \
        else { _Pragma("unroll") for (int m = 0; m < 4; ++m) _Pragma("unroll") for (int k = 0; k < 2; ++k) dst[m][k] = *(const LAS bf16x8*)(lds + G8_SA(b, h) + aoff + m * 2048 + k * 1024); } } while (0)
#define G8_LDB(dst, b, h) do { if constexpr (Epi::F8) { _Pragma("unroll") for (int n = 0; n < 2; ++n) { const i32x4 _l = *(const LAS i32x4*)(lds + G8_SB(b, h) + boff + n * 2048), _h = *(const LAS i32x4*)(lds + G8_SB(b, h) + boff + n * 2048 + 1024); dst##8[n] = __builtin_shufflevector(_l, _h, 0, 1, 2, 3, 4, 5, 6, 7); } } \
        else { _Pragma("unroll") for (int n = 0; n < 2; ++n) _Pragma("unroll") for (int k = 0; k < 2; ++k) dst[n][k] = *(const LAS bf16x8*)(lds + G8_SB(b, h) + boff + n * 2048 + k * 1024); } } while (0)
#define G8_MMA(ai, bj, At, Bt_) do { __builtin_amdgcn_s_setprio(1); _Pragma("unroll") for (int m = 0; m < 4; ++m) _Pragma("unroll") for (int n = 0; n < 2; ++n) { \
        if constexpr (Epi::F8) acc[ai][bj][m][n] = mma_f8(Bt_##8[n], At##8[m], acc[ai][bj][m][n]); \
        else { _Pragma("unroll") for (int k = 0; k < 2; ++k) { if constexpr (Epi::I8) acc[ai][bj][m][n] = mma_i8(Bt_[n][k], At[m][k], acc[ai][bj][m][n]); else acc[ai][bj][m][n] = mma_bf16(Bt_[n][k], At[m][k], acc[ai][bj][m][n]); } } } \
        if constexpr (Epi::F8) asm volatile("s_nop 15\n\ts_nop 7" ::: "memory");     \
        __builtin_amdgcn_s_setprio(0); } while (0)
#define G8_WAIT_V(n) asm volatile("s_waitcnt vmcnt(" #n ")" ::: "memory")
#define G8_WAIT_L(n) asm volatile("s_waitcnt lgkmcnt(" #n ")" ::: "memory")
#define G8_BAR __builtin_amdgcn_s_barrier()
#define G8_SCHED __builtin_amdgcn_sched_barrier(0)
    Unit cur, nxt; int ui = 0;
    if (!S.next(0, cur)) return;
    typedef typename Epi::acc_t acc_t;
    acc_t acc[2][2][4][2];
#pragma unroll
    for (int a = 0; a < 2; ++a)
#pragma unroll
        for (int b = 0; b < 2; ++b)
#pragma unroll
            for (int m = 0; m < 4; ++m)
#pragma unroll
                for (int n = 0; n < 2; ++n) acc[a][b][m][n] = (acc_t){0, 0, 0, 0};
    bf16x8 At[4][2], B0[2][2], B1[2][2];
    i32x8 At8[4], B08[2], B18[2];
    (void)At; (void)B0; (void)B1; (void)At8; (void)B08; (void)B18;
    unsigned vC[2][2], vN[2][2];
    G8_MKOFF(vC, cur);
    const char* cB = (const char*)Bt + cur.boff * 2;
    G8_STAGE_B(G8_SB(0, 0), cB); G8_STAGE_B(G8_SB(0, 1), cB + hstepB); G8_STAGE_A(G8_SA(0, 0), 0, vC, 0); G8_STAGE_A(G8_SA(0, 1), 0, vC, 1);
    if (wr == 1) G8_BAR;
    G8_WAIT_V(2); G8_BAR;
    G8_STAGE_B(G8_SB(1, 0), cB + kstep); G8_STAGE_A(G8_SA(1, 0), kstep, vC, 0); G8_STAGE_B(G8_SB(1, 1), cB + hstepB + kstep);
    G8_WAIT_V(6); G8_BAR;
    for (;;) {
        const bool has_next = S.next(ui + 1, nxt);
        const int tconv = (GATHER && nt > 2) ? 2 : 0;
        if (has_next) { if (GATHER) { G8_MKRAW(vN, nxt); } else { G8_MKOFF(vN, nxt); } } else {
#pragma unroll
            for (int h = 0; h < 2; ++h)
#pragma unroll
                for (int i = 0; i < 2; ++i) vN[h][i] = vC[h][i]; }
        const char* nB = has_next ? (const char*)Bt + nxt.boff * 2 : cB;
        for (int t = 0; t < nt; t += 2) {
            const bool last = (t == nt - 2);
            const size_t kb1 = (size_t)(t + 1) * kstep;
            const size_t kb2 = last ? 0 : (size_t)(t + 2) * kstep, kb3 = kb2 + kstep;
            const char* b2 = last ? nB : cB + (size_t)(t + 2) * kstep; const char* b3 = b2 + kstep;
            G8_LDB(B0, 0, 0); G8_LDB(B1, 0, 1); G8_SCHED; G8_LDA(At, 0, 0); G8_STAGE_A(G8_SA(1, 1), kb1, vC, 1);
            if (GATHER) { if (t == tconv && has_next) { G8_MKCONV(vN, nxt); } }
            G8_WAIT_V(8); G8_WAIT_L(0); G8_BAR; G8_MMA(0, 0, At, B0); G8_MMA(0, 1, At, B1); G8_BAR; G8_SCHED;
            G8_LDA(At, 0, 1); G8_STAGE_B(G8_SB(0, 0), b2); G8_STAGE_B(G8_SB(0, 1), b2 + hstepB); G8_STAGE_A2(G8_SA(0, 0), kb2, 0);
            G8_WAIT_V(8); G8_WAIT_L(0); G8_BAR; G8_MMA(1, 0, At, B0); G8_MMA(1, 1, At, B1); G8_BAR; G8_SCHED;
            G8_LDB(B0, 1, 0); G8_LDB(B1, 1, 1); G8_SCHED; G8_LDA(At, 1, 0); G8_STAGE_A2(G8_SA(0, 1), kb2, 1);
            G8_WAIT_V(8); G8_WAIT_L(0); G8_BAR; G8_MMA(0, 0, At, B0); G8_MMA(0, 1, At, B1); G8_BAR; G8_SCHED;
            G8_LDA(At, 1, 1); G8_STAGE_B(G8_SB(1, 0), b3); G8_STAGE_B(G8_SB(1, 1), b3 + hstepB); G8_STAGE_A2(G8_SA(1, 0), kb3, 0);
            G8_WAIT_V(8); G8_WAIT_L(0); G8_BAR; G8_MMA(1, 0, At, B0); G8_MMA(1, 1, At, B1); G8_BAR; G8_SCHED;
        }
        if (wr == 0) G8_BAR;
        E(acc, cur, wr, wc, fr, fq);
        if (!has_next) break;
#pragma unroll
        for (int a = 0; a < 2; ++a)
#pragma unroll
            for (int b = 0; b < 2; ++b)
#pragma unroll
                for (int m = 0; m < 4; ++m)
#pragma unroll
                    for (int n = 0; n < 2; ++n) acc[a][b][m][n] = (acc_t){0, 0, 0, 0};
        cur = nxt; cB = nB; ++ui;
#pragma unroll
        for (int h = 0; h < 2; ++h)
#pragma unroll
            for (int i = 0; i < 2; ++i) vC[h][i] = vN[h][i];
        if (wr == 1) G8_BAR;
    }
    G8_WAIT_V(0);
    G8_BAR;
#undef G8_MKOFF
#undef G8_MKRAW
#undef G8_MKCONV
#undef G8_SA
#undef G8_SB
#undef G8_STAGE_A
#undef G8_STAGE_A2
#undef G8_STAGE_B
#undef G8_LDA
#undef G8_LDB
#undef G8_MMA
#undef G8_WAIT_V
#undef G8_WAIT_L
#undef G8_BAR
#undef G8_SCHED
}

constexpr float HID_SCALE = 4.0f, W2_SCALE = 64.0f;
__device__ __forceinline__ void store_rows128(LAS unsigned char* stg, bf16_t* gp  , size_t ldc, u32x4 p0, u32x4 p1, int fr, int fq, int nvalid) {
    const int sw = fr & 7, lane = fr + 16 * fq, r0 = lane >> 3, c = lane & 7;
    *(LAS u32x4*)(stg + fr * 128 + ((fq ^ sw) << 4)) = p0;
    *(LAS u32x4*)(stg + fr * 128 + (((4 + fq) ^ sw) << 4)) = p1;
    asm volatile("s_waitcnt lgkmcnt(0)" ::: "memory");
    const u32x4 o0 = *(const LAS u32x4*)(stg + r0 * 128 + ((c ^ (r0 & 7)) << 4)), o1 = *(const LAS u32x4*)(stg + (8 + r0) * 128 + ((c ^ (r0 & 7)) << 4));
    asm volatile("s_waitcnt lgkmcnt(0)" ::: "memory");
    if (r0 < nvalid) *(u32x4*)(gp + (size_t)r0 * ldc + c * 8) = o0;
    if (8 + r0 < nvalid) *(u32x4*)(gp + (size_t)(8 + r0) * ldc + c * 8) = o1;
}
__device__ __forceinline__ float swiglu_f(float g, float l) {
    g = fminf(g, 7.0f); l = fminf(fmaxf(l, -7.0f), 7.0f);
    return g * __builtin_amdgcn_rcpf(1.0f + __expf(-1.702f * g)) * (l + 1.0f);
}
struct EpiSwigluB { typedef f32x4 acc_t; static constexpr bool I8 = false, F8 = false; static constexpr bool PERM = true;
    bf16_t* H; const float* b1;
    __device__ __forceinline__ void operator()(const f32x4 (&acc)[2][2][4][2], const Unit& u, int wr, int wc, int fr, int fq) const {
        const int col0 = u.ocol0 + wc * 64 + 8 * fq; const float* bp = b1 + (size_t)u.aux * 2048 + col0;
        f32x4 bv[2][2];
#pragma unroll
        for (int bj = 0; bj < 2; ++bj)
#pragma unroll
            for (int n = 0; n < 2; ++n) bv[bj][n] = *(const f32x4*)(bp + bj * 32 + 4 * n);
#pragma unroll
        for (int ai = 0; ai < 2; ++ai)
#pragma unroll
            for (int m = 0; m < 4; ++m) { const int r = ai * HALF + wr * 64 + m * 16 + fr; if (r < u.nrows) { bf16_t* rowp = H + (size_t)(u.orow0 + r) * 1024 + (col0 >> 1);
#pragma unroll
                for (int bj = 0; bj < 2; ++bj) { const f32x4 v0 = acc[ai][bj][m][0] + bv[bj][0], v1 = acc[ai][bj][m][1] + bv[bj][1];
                    u32x2 w; w.x = cvt_pk_bf16(swiglu_f(v0[0], v0[1]), swiglu_f(v0[2], v0[3])); w.y = cvt_pk_bf16(swiglu_f(v1[0], v1[1]), swiglu_f(v1[2], v1[3]));
                    *(u32x2*)(rowp + bj * 16) = w; } } }
    }
};
struct EpiSwigluI8 { typedef i32x4 acc_t; static constexpr bool I8 = true, F8 = false; static constexpr bool PERM = true;
    unsigned char* H; const float* b1; const float* sa; const float* sb;
    typedef float f2 __attribute__((ext_vector_type(2)));
    static __device__ __forceinline__ f2 swiglu2(f2 g, f2 l) {
        g.x = fminf(g.x, 7.0f); g.y = fminf(g.y, 7.0f); l.x = fminf(fmaxf(l.x, -7.0f), 7.0f); l.y = fminf(fmaxf(l.y, -7.0f), 7.0f);
        f2 t = g * (-1.702f * 1.4426950408889634f); t.x = __builtin_amdgcn_exp2f(t.x); t.y = __builtin_amdgcn_exp2f(t.y); t = t + 1.0f;
        f2 r; r.x = __builtin_amdgcn_rcpf(t.x); r.y = __builtin_amdgcn_rcpf(t.y);
        return (g * r) * (l * HID_SCALE + HID_SCALE); }
    __device__ __forceinline__ void operator()(const i32x4 (&acc)[2][2][4][2], const Unit& u, int wr, int wc, int fr, int fq) const {
        const int col0 = u.ocol0 + wc * 64 + 8 * fq; const float* bp = b1 + (size_t)u.aux * 2048 + col0; const float* sp = sb + (size_t)u.aux * 2048 + col0;
        f32x4 bv[2][2], sv[2][2]; float av[2][4];
#pragma unroll
        for (int bj = 0; bj < 2; ++bj)
#pragma unroll
            for (int n = 0; n < 2; ++n) { bv[bj][n] = *(const f32x4*)(bp + bj * 32 + 4 * n); sv[bj][n] = *(const f32x4*)(sp + bj * 32 + 4 * n); }
#pragma unroll
        for (int ai = 0; ai < 2; ++ai)
#pragma unroll
            for (int m = 0; m < 4; ++m) { const int r = ai * HALF + wr * 64 + m * 16 + fr; av[ai][m] = sa[u.orow0 + (r < u.nrows ? r : u.nrows - 1)]; }
#pragma unroll
        for (int ai = 0; ai < 2; ++ai) asm volatile("" : "+v"(av[ai][0]), "+v"(av[ai][1]), "+v"(av[ai][2]), "+v"(av[ai][3]));
#pragma unroll
        for (int ai = 0; ai < 2; ++ai)
#pragma unroll
            for (int m = 0; m < 4; ++m) { const int r = ai * HALF + wr * 64 + m * 16 + fr; if (r < u.nrows) { unsigned char* rowp = H + (size_t)(u.orow0 + r) * 1024 + (col0 >> 1); const float a = av[ai][m];
#pragma unroll
                for (int bj = 0; bj < 2; ++bj) { f32x4 c0, c1;
#pragma unroll
                    for (int q = 0; q < 4; ++q) { c0[q] = (float)acc[ai][bj][m][0][q]; c1[q] = (float)acc[ai][bj][m][1][q]; }
                    const f32x4 v0 = c0 * (sv[bj][0] * a) + bv[bj][0], v1 = c1 * (sv[bj][1] * a) + bv[bj][1];
                    const f2 h0 = swiglu2((f2){v0[0], v0[2]}, (f2){v0[1], v0[3]}), h1 = swiglu2((f2){v1[0], v1[2]}, (f2){v1[1], v1[3]});
                    unsigned w = 0u; w = __builtin_amdgcn_cvt_pk_fp8_f32(h0.x, h0.y, w, false); w = __builtin_amdgcn_cvt_pk_fp8_f32(h1.x, h1.y, w, true);
                    *(unsigned*)(rowp + bj * 16) = w; } } }
    }
};
struct EpiMoe2B { typedef f32x4 acc_t; static constexpr bool I8 = false, F8 = false; static constexpr bool PERM = true;
    bf16_t* O; const float* b2; const float* wpos;
    __device__ __forceinline__ void operator()(const f32x4 (&acc)[2][2][4][2], const Unit& u, int wr, int wc, int fr, int fq) const {
        const int col0 = u.ocol0 + wc * 64 + 8 * fq; const float* bp = b2 + (size_t)u.aux * 1024 + col0;
        f32x4 bv[2][2];
#pragma unroll
        for (int bj = 0; bj < 2; ++bj)
#pragma unroll
            for (int n = 0; n < 2; ++n) bv[bj][n] = *(const f32x4*)(bp + bj * 32 + 4 * n);
        float wv[2][4];
#pragma unroll
        for (int ai = 0; ai < 2; ++ai)
#pragma unroll
            for (int m = 0; m < 4; ++m) { const int r = ai * HALF + wr * 64 + m * 16 + fr; wv[ai][m] = wpos[u.orow0 + (r < u.nrows ? r : u.nrows - 1)]; }
#pragma unroll
        for (int ai = 0; ai < 2; ++ai) asm volatile("" : "+v"(wv[ai][0]), "+v"(wv[ai][1]), "+v"(wv[ai][2]), "+v"(wv[ai][3]));
#pragma unroll
        for (int ai = 0; ai < 2; ++ai)
#pragma unroll
            for (int m = 0; m < 4; ++m) { const int r = ai * HALF + wr * 64 + m * 16 + fr; if (r < u.nrows) { const float w = wv[ai][m]; bf16_t* rowp = O + (size_t)(u.orow0 + r) * 1024 + col0;
#pragma unroll
                for (int bj = 0; bj < 2; ++bj) { const f32x4 v0 = (acc[ai][bj][m][0] + bv[bj][0]) * w, v1 = (acc[ai][bj][m][1] + bv[bj][1]) * w;
                    u32x4 o; o.x = cvt_pk_bf16(v0[0], v0[1]); o.y = cvt_pk_bf16(v0[2], v0[3]); o.z = cvt_pk_bf16(v1[0], v1[1]); o.w = cvt_pk_bf16(v1[2], v1[3]);
                    *(u32x4*)(rowp + bj * 32) = o; } } }
    }
};

struct BatchOrder : DenseOrder { int bbatch_rows;
    __device__ bool next(int i, Unit& u) const { int pm, pn; if (!tile(i, pm, pn)) return false;
        u.arow0 = pm * BM; u.nrows = BM; u.acol0 = 0; u.orow0 = pm * BM; u.ocol0 = pn * BM; u.aux = 0; u.boff = ((size_t)(pm >> 3) * bbatch_rows + (size_t)pn * BM) * ldb; return true; } };
struct GtOrder { int G, c;
    __device__ bool next(int i, Unit& u) const { const int L = i * G + c; if (L >= 512) return false; const int h = L >> 7, b = (L >> 2) & 31, pn = L & 3;
        u.arow0 = b * 256; u.nrows = 256; u.acol0 = h * 256; u.boff = (size_t)pn * 256 * 1024 + h * 256; u.orow0 = b * 1024 + h * 256; u.ocol0 = pn * 256; u.aux = 0; return true; } };
struct VwtOrder { int G, c;
    __device__ bool next(int i, Unit& u) const { const int L = i * G + c; if (L >= 512) return false; const int b = L >> 4, h = (L >> 2) & 3, pm = L & 3;
        u.arow0 = pm * 256; u.nrows = 256; u.acol0 = h * 256; u.boff = (size_t)(b * 256) * 2048 + 1024 + h * 256; u.orow0 = b * 1024 + pm * 256; u.ocol0 = h * 256; u.aux = 0; return true; } };

struct EpiMoe2F8 { typedef f32x4 acc_t; static constexpr bool I8 = false, F8 = true; static constexpr bool PERM = true;
    bf16_t* O; const float* b2; const float* wpos; LAS unsigned char* stg;
    __device__ __forceinline__ void operator()(const f32x4 (&acc)[2][2][4][2], const Unit& u, int wr, int wc, int fr, int fq) const {
        const int col0 = u.ocol0 + wc * 64 + 8 * fq; const float* bp = b2 + (size_t)u.aux * 1024 + col0; const float is = 1.0f / (HID_SCALE * W2_SCALE);
        f32x4 bv[2][2];
#pragma unroll
        for (int bj = 0; bj < 2; ++bj)
#pragma unroll
            for (int n = 0; n < 2; ++n) bv[bj][n] = *(const f32x4*)(bp + bj * 32 + 4 * n);
        float wv[2][4];
#pragma unroll
        for (int ai = 0; ai < 2; ++ai)
#pragma unroll
            for (int m = 0; m < 4; ++m) { const int r = ai * HALF + wr * 64 + m * 16 + fr; wv[ai][m] = wpos[u.orow0 + (r < u.nrows ? r : u.nrows - 1)]; }
#pragma unroll
        for (int ai = 0; ai < 2; ++ai) asm volatile("" : "+v"(wv[ai][0]), "+v"(wv[ai][1]), "+v"(wv[ai][2]), "+v"(wv[ai][3]));
        LAS unsigned char* sw_ = stg + (wr * 4 + wc) * 2048;
#pragma unroll
        for (int ai = 0; ai < 2; ++ai)
#pragma unroll
            for (int m = 0; m < 4; ++m) { const int rg = ai * HALF + wr * 64 + m * 16; const float w = wv[ai][m]; u32x4 o[2];
#pragma unroll
                for (int bj = 0; bj < 2; ++bj) { const f32x4 v0 = (acc[ai][bj][m][0] * is + bv[bj][0]) * w, v1 = (acc[ai][bj][m][1] * is + bv[bj][1]) * w;
                    o[bj].x = cvt_pk_bf16(v0[0], v0[1]); o[bj].y = cvt_pk_bf16(v0[2], v0[3]); o[bj].z = cvt_pk_bf16(v1[0], v1[1]); o[bj].w = cvt_pk_bf16(v1[2], v1[3]); }
                store_rows128(sw_, O + (size_t)(u.orow0 + rg) * 1024 + u.ocol0 + wc * 64, 1024, o[0], o[1], fr, fq, u.nrows - rg); }
    }
};
struct EpiProj { typedef i32x4 acc_t; static constexpr bool I8 = true, F8 = false; static constexpr bool PERM = true;
    bf16_t* O; const float* ropec; const float* ropes; LAS unsigned char* stg; const float* sx; const float* sw; LAS unsigned char* tab;
    __device__ __forceinline__ void operator()(const i32x4 (&acc)[2][2][4][2], const Unit& u, int wr, int wc, int fr, int fq) const {
        const int region = u.ocol0 >> 9;
        const bool rope = (region != 2 && region != 5);
        const float sc = (region == 0 || region == 3) ? C2Q : 1.0f;
        const float sg = (fq == 0) ? -1.0f : 1.0f;
        const int tid = (wr * 4 + wc) * 64 + fr + 16 * fq;
        f32x4 swv[2][2]; float sxv[2][4];
#pragma unroll
        for (int bj = 0; bj < 2; ++bj)
#pragma unroll
            for (int n = 0; n < 2; ++n) swv[bj][n] = *(const f32x4*)(sw + u.ocol0 + wc * 64 + 8 * fq + bj * 32 + 4 * n) * sc;
#pragma unroll
        for (int ai = 0; ai < 2; ++ai)
#pragma unroll
            for (int m = 0; m < 4; ++m) sxv[ai][m] = sx[u.orow0 + ai * HALF + wr * 64 + m * 16 + fr];
#pragma unroll
        for (int ai = 0; ai < 2; ++ai) {
            if (rope) { const int trow = tid >> 2, tq = tid & 3, pos = (u.orow0 + ai * HALF + trow) & (SEQ - 1);
                const f32x4 tv = *(const f32x4*)((tq < 2 ? ropec : ropes) + pos * 8 + (tq & 1) * 4);
                *(LAS f32x4*)(tab + trow * 64 + tq * 16) = tv;
                asm volatile("s_waitcnt lgkmcnt(0)" ::: "memory"); __builtin_amdgcn_s_barrier(); asm volatile("" ::: "memory"); }
#pragma unroll
            for (int m = 0; m < 4; ++m) { f32x4 cs[4]; const float sxr_ = sxv[ai][m];
                if (rope) { const LAS unsigned char* tp = tab + (wr * 64 + m * 16 + fr) * 64;
                    cs[0] = *(const LAS f32x4*)(tp); cs[1] = *(const LAS f32x4*)(tp + 16); cs[2] = *(const LAS f32x4*)(tp + 32); cs[3] = *(const LAS f32x4*)(tp + 48); }
                u32x4 w[2];
#pragma unroll
                for (int bj = 0; bj < 2; ++bj) { f32x4 v0, v1;
#pragma unroll
                    for (int q = 0; q < 4; ++q) { v0[q] = (float)acc[ai][bj][m][0][q]; v1[q] = (float)acc[ai][bj][m][1][q]; }
                    v0 = v0 * (swv[bj][0] * sxr_); v1 = v1 * (swv[bj][1] * sxr_);
                    if (rope && bj == 0) { f32x4 p0, p1;
#pragma unroll
                        for (int e = 0; e < 4; ++e) { p0[e] = __shfl_xor(v0[e], 16); p1[e] = __shfl_xor(v1[e], 16); }
                        if (fq < 2) { v0 = v0 * cs[0] + p0 * (cs[2] * sg); v1 = v1 * cs[1] + p1 * (cs[3] * sg); } }
                    w[bj].x = cvt_pk_bf16(v0[0], v0[1]); w[bj].y = cvt_pk_bf16(v0[2], v0[3]); w[bj].z = cvt_pk_bf16(v1[0], v1[1]); w[bj].w = cvt_pk_bf16(v1[2], v1[3]); }
                store_rows128(stg + (wr * 4 + wc) * 2048, O + (size_t)(u.orow0 + ai * HALF + wr * 64 + m * 16) * NPROJ + u.ocol0 + wc * 64, (size_t)NPROJ, w[0], w[1], fr, fq, 16); }
            if (rope) { asm volatile("s_waitcnt lgkmcnt(0)" ::: "memory"); __builtin_amdgcn_s_barrier(); asm volatile("" ::: "memory"); }
        }
    }
};
struct EpiPlainB { typedef f32x4 acc_t; static constexpr bool I8 = false, F8 = false; static constexpr bool PERM = true;
    bf16_t* O; int ldc; LAS unsigned char* stg;
    __device__ __forceinline__ void operator()(const f32x4 (&acc)[2][2][4][2], const Unit& u, int wr, int wc, int fr, int fq) const {
        LAS unsigned char* sw_ = stg + (wr * 4 + wc) * 2048;
#pragma unroll
        for (int ai = 0; ai < 2; ++ai)
#pragma unroll
            for (int m = 0; m < 4; ++m) { u32x4 w[2];
#pragma unroll
                for (int bj = 0; bj < 2; ++bj) { const f32x4 v0 = acc[ai][bj][m][0], v1 = acc[ai][bj][m][1];
                    w[bj].x = cvt_pk_bf16(v0[0], v0[1]); w[bj].y = cvt_pk_bf16(v0[2], v0[3]); w[bj].z = cvt_pk_bf16(v1[0], v1[1]); w[bj].w = cvt_pk_bf16(v1[2], v1[3]); }
                store_rows128(sw_, O + (size_t)(u.orow0 + ai * HALF + wr * 64 + m * 16) * ldc + u.ocol0 + wc * 64, (size_t)ldc, w[0], w[1], fr, fq, 16); }
    }
};
struct EpiResidF { typedef f32x4 acc_t; static constexpr bool I8 = false, F8 = false; static constexpr bool PERM = false;
    float* O; const float* R; float alpha;
    __device__ __forceinline__ void operator()(const f32x4 (&acc)[2][2][4][2], const Unit& u, int wr, int wc, int fr, int fq) const {
        const int col0 = u.ocol0 + wc * 64 + 4 * fq;
#pragma unroll
        for (int ai = 0; ai < 2; ++ai) { f32x4 pre[4][2][2];
#pragma unroll
            for (int m = 0; m < 4; ++m) { const size_t off = (size_t)(u.orow0 + ai * HALF + wr * 64 + m * 16 + fr) * 1024 + col0;
#pragma unroll
                for (int bj = 0; bj < 2; ++bj)
#pragma unroll
                    for (int n = 0; n < 2; ++n) pre[m][bj][n] = *(const f32x4*)(R + off + bj * 32 + n * 16); }
#pragma unroll
            for (int m = 0; m < 4; ++m)
#pragma unroll
                for (int bj = 0; bj < 2; ++bj) asm volatile("" : "+v"(pre[m][bj][0]), "+v"(pre[m][bj][1]));
#pragma unroll
            for (int m = 0; m < 4; ++m) { const size_t off = (size_t)(u.orow0 + ai * HALF + wr * 64 + m * 16 + fr) * 1024 + col0;
#pragma unroll
                for (int bj = 0; bj < 2; ++bj)
#pragma unroll
                    for (int n = 0; n < 2; ++n) *(f32x4*)(O + off + bj * 32 + n * 16) = pre[m][bj][n] * alpha + acc[ai][bj][m][n]; }
            asm volatile("" ::: "memory"); }
    }
};
struct EpiResidStats { typedef f32x4 acc_t; static constexpr bool I8 = false, F8 = false; static constexpr bool PERM = false;
    bf16_t* Ob; const float* R; long long* st; float alpha;
    __device__ __forceinline__ void operator()(const f32x4 (&acc)[2][2][4][2], const Unit& u, int wr, int wc, int fr, int fq) const {
        const int col0 = u.ocol0 + wc * 64 + 4 * fq;
#pragma unroll
        for (int ai = 0; ai < 2; ++ai) { f32x4 pre[4][2][2];
#pragma unroll
            for (int m = 0; m < 4; ++m) { const size_t off = (size_t)(u.orow0 + ai * HALF + wr * 64 + m * 16 + fr) * 1024 + col0;
#pragma unroll
                for (int bj = 0; bj < 2; ++bj)
#pragma unroll
                    for (int n = 0; n < 2; ++n) pre[m][bj][n] = __builtin_nontemporal_load((const f32x4*)(R + off + bj * 32 + n * 16)); }
#pragma unroll
            for (int m = 0; m < 4; ++m)
#pragma unroll
                for (int bj = 0; bj < 2; ++bj) asm volatile("" : "+v"(pre[m][bj][0]), "+v"(pre[m][bj][1]));
#pragma unroll
            for (int m = 0; m < 4; ++m) { const int row = u.orow0 + ai * HALF + wr * 64 + m * 16 + fr; const size_t off = (size_t)row * 1024 + col0; float s1 = 0.f, s2 = 0.f;
#pragma unroll
                for (int bj = 0; bj < 2; ++bj)
#pragma unroll
                    for (int n = 0; n < 2; ++n) { const f32x4 v = pre[m][bj][n] * alpha + acc[ai][bj][m][n];
                        u32x2 w; w.x = cvt_pk_bf16(v[0], v[1]); w.y = cvt_pk_bf16(v[2], v[3]); *(u32x2*)(Ob + off + bj * 32 + n * 16) = w;
                        s1 += (v[0] + v[1]) + (v[2] + v[3]); s2 += (v[0] * v[0] + v[1] * v[1]) + (v[2] * v[2] + v[3] * v[3]); }
                s1 += __shfl_xor(s1, 16); s1 += __shfl_xor(s1, 32); s2 += __shfl_xor(s2, 16); s2 += __shfl_xor(s2, 32);
                if (fq == 0) { fx_add(st + 2 * (size_t)row, s1); fx_add(st + 2 * (size_t)row + 1, s2); } }
            asm volatile("" ::: "memory"); }
    }
};
struct EpiResidLN { typedef f32x4 acc_t; static constexpr bool I8 = false, F8 = false; static constexpr bool PERM = false;
    bf16_t* O; const bf16_t* R; const long long* st; const float* g; const float* bb; float alpha;
    __device__ __forceinline__ void operator()(const f32x4 (&acc)[2][2][4][2], const Unit& u, int wr, int wc, int fr, int fq) const {
        const int col0 = u.ocol0 + wc * 64 + 4 * fq;
        f32x4 gv[2][2], bv[2][2];
#pragma unroll
        for (int bj = 0; bj < 2; ++bj)
#pragma unroll
            for (int n = 0; n < 2; ++n) { gv[bj][n] = *(const f32x4*)(g + col0 + bj * 32 + n * 16); bv[bj][n] = *(const f32x4*)(bb + col0 + bj * 32 + n * 16); }
#pragma unroll
        for (int ai = 0; ai < 2; ++ai) { u32x2 pre[4][2][2]; float mu[4], rs[4];
#pragma unroll
            for (int m = 0; m < 4; ++m) { const int row = u.orow0 + ai * HALF + wr * 64 + m * 16 + fr; const size_t off = (size_t)row * 1024 + col0;
                mu[m] = fx_get(st + 2 * (size_t)row); rs[m] = fx_get(st + 2 * (size_t)row + 1);
#pragma unroll
                for (int bj = 0; bj < 2; ++bj)
#pragma unroll
                    for (int n = 0; n < 2; ++n) pre[m][bj][n] = *(const u32x2*)(R + off + bj * 32 + n * 16); }
#pragma unroll
            for (int m = 0; m < 4; ++m) { asm volatile("" : "+v"(mu[m]), "+v"(rs[m]));
#pragma unroll
                for (int bj = 0; bj < 2; ++bj) asm volatile("" : "+v"(pre[m][bj][0]), "+v"(pre[m][bj][1])); }
#pragma unroll
            for (int m = 0; m < 4; ++m) { const size_t off = (size_t)(u.orow0 + ai * HALF + wr * 64 + m * 16 + fr) * 1024 + col0;
                const float mean = mu[m] * (1.0f / 1024.0f), rstd = 1.0f / sqrtf(fmaxf(rs[m] * (1.0f / 1024.0f) - mean * mean, 0.f) + LN_EPS);
#pragma unroll
                for (int bj = 0; bj < 2; ++bj)
#pragma unroll
                    for (int n = 0; n < 2; ++n) { const u32x2 p = pre[m][bj][n]; const f32x4 t = {__uint_as_float(p.x << 16), __uint_as_float(p.x & 0xffff0000u), __uint_as_float(p.y << 16), __uint_as_float(p.y & 0xffff0000u)};
                        const f32x4 v = ((t - mean) * rstd * gv[bj][n] + bv[bj][n]) * alpha + acc[ai][bj][m][n];
                        u32x2 w; w.x = cvt_pk_bf16(v[0], v[1]); w.y = cvt_pk_bf16(v[2], v[3]); *(u32x2*)(O + off + bj * 32 + n * 16) = w; } }
            asm volatile("" ::: "memory"); }
    }
};
struct EpiGT { typedef f32x4 acc_t; static constexpr bool I8 = false, F8 = false; static constexpr bool PERM = true;
    bf16_t* O; const float* g; const float* bb; long long* cs; long long* bfs; LAS unsigned char* stg;
    __device__ __forceinline__ void operator()(const f32x4 (&acc)[2][2][4][2], const Unit& u, int wr, int wc, int fr, int fq) const {
        const int col0 = u.ocol0 + wc * 64 + 8 * fq;
        f32x4 gv[2][2], bv[2][2];
#pragma unroll
        for (int bj = 0; bj < 2; ++bj)
#pragma unroll
            for (int n = 0; n < 2; ++n) { gv[bj][n] = *(const f32x4*)(g + col0 + bj * 32 + 4 * n); bv[bj][n] = *(const f32x4*)(bb + col0 + bj * 32 + 4 * n); }
#pragma unroll
        for (int ai = 0; ai < 2; ++ai)
#pragma unroll
            for (int m = 0; m < 4; ++m) { const int row = u.orow0 + ai * HALF + wr * 64 + m * 16 + fr; float s1 = 0.f, s2 = 0.f; u32x4 wq[2];
#pragma unroll
                for (int bj = 0; bj < 2; ++bj) { const f32x4 a0 = acc[ai][bj][m][0], a1 = acc[ai][bj][m][1]; const f32x4 v0 = a0 * gv[bj][0], v1 = a1 * gv[bj][1], w0 = a0 * bv[bj][0], w1 = a1 * bv[bj][1];
                    wq[bj].x = cvt_pk_bf16(v0[0], v0[1]); wq[bj].y = cvt_pk_bf16(v0[2], v0[3]); wq[bj].z = cvt_pk_bf16(v1[0], v1[1]); wq[bj].w = cvt_pk_bf16(v1[2], v1[3]);
                    s1 += ((v0[0] + v0[1]) + (v0[2] + v0[3])) + ((v1[0] + v1[1]) + (v1[2] + v1[3])); s2 += ((w0[0] + w0[1]) + (w0[2] + w0[3])) + ((w1[0] + w1[1]) + (w1[2] + w1[3])); }
                store_rows128(stg + (wr * 4 + wc) * 2048, O + (size_t)(row - fr) * 1024 + u.ocol0 + wc * 64, 1024, wq[0], wq[1], fr, fq, 16);
                s1 += __shfl_xor(s1, 16); s1 += __shfl_xor(s1, 32); s2 += __shfl_xor(s2, 16); s2 += __shfl_xor(s2, 32);
                if (fq == 0) { fx_add(cs + row, s1); fx_add(bfs + row, s2); } }
    }
};
struct EpiSoftmaxP { typedef f32x4 acc_t; static constexpr bool I8 = false, F8 = false; static constexpr bool PERM = true;
    bf16_t* O; LAS unsigned char* xs; LAS unsigned char* stg; const long long* st; const long long* cs; const long long* bfs;
    __device__ __forceinline__ void operator()(const f32x4 (&acc)[2][2][4][2], const Unit& u, int wr, int wc, int fr, int fq) const {
        typedef float f32x2v __attribute__((ext_vector_type(2)));
        LAS f32x2v* X = (LAS f32x2v*)xs;
        f32x4 e[2][4][2][2]; float mw[2][4];
        const int cc0 = (u.orow0 >> 11) * 1024 + u.ocol0 + wc * 64 + 8 * fq;
        f32x4 cv[2][2], fv[2][2]; float mu[2][4], rs[2][4];
#pragma unroll
        for (int bj = 0; bj < 2; ++bj)
#pragma unroll
            for (int n = 0; n < 2; ++n)
#pragma unroll
                for (int q = 0; q < 4; ++q) { cv[bj][n][q] = fx_get(cs + cc0 + bj * 32 + 4 * n + q); fv[bj][n][q] = fx_get(bfs + cc0 + bj * 32 + 4 * n + q); }
#pragma unroll
        for (int ai = 0; ai < 2; ++ai)
#pragma unroll
            for (int m = 0; m < 4; ++m) { const size_t row = (size_t)(u.orow0 + ai * HALF + wr * 64 + m * 16 + fr); mu[ai][m] = fx_get(st + 2 * row); rs[ai][m] = fx_get(st + 2 * row + 1); }
#pragma unroll
        for (int ai = 0; ai < 2; ++ai) asm volatile("" : "+v"(mu[ai][0]), "+v"(mu[ai][1]), "+v"(mu[ai][2]), "+v"(mu[ai][3]), "+v"(rs[ai][0]), "+v"(rs[ai][1]), "+v"(rs[ai][2]), "+v"(rs[ai][3]));
#pragma unroll
        for (int ai = 0; ai < 2; ++ai)
#pragma unroll
            for (int m = 0; m < 4; ++m) { float mx = -INFINITY; const float mean = mu[ai][m] * (1.0f / 1024.0f), rstd = 1.0f / sqrtf(fmaxf(rs[ai][m] * (1.0f / 1024.0f) - mean * mean, 0.f) + LN_EPS);
#pragma unroll
                for (int bj = 0; bj < 2; ++bj)
#pragma unroll
                    for (int n = 0; n < 2; ++n) { const f32x4 v = ((acc[ai][bj][m][n] - cv[bj][n] * mean) * rstd + fv[bj][n]) * C2M; e[ai][m][bj][n] = v; mx = fmaxf(mx, fmaxf(fmaxf(v[0], v[1]), fmaxf(v[2], v[3]))); }
                mx = fmaxf(mx, __shfl_xor(mx, 16)); mx = fmaxf(mx, __shfl_xor(mx, 32)); float sm = 0.f;
#pragma unroll
                for (int bj = 0; bj < 2; ++bj)
#pragma unroll
                    for (int n = 0; n < 2; ++n) { f32x4 v = e[ai][m][bj][n];
#pragma unroll
                        for (int q = 0; q < 4; ++q) { v[q] = __builtin_amdgcn_exp2f(v[q] - mx); sm += v[q]; }
                        e[ai][m][bj][n] = v; }
                sm += __shfl_xor(sm, 16); sm += __shfl_xor(sm, 32); mw[ai][m] = mx;
                if (fq == 0) X[(ai * HALF + wr * 64 + m * 16 + fr) * 4 + wc] = (f32x2v){mx, sm}; }
        asm volatile("s_waitcnt lgkmcnt(0)" ::: "memory"); __builtin_amdgcn_s_barrier(); asm volatile("" ::: "memory");
        const int col0 = u.ocol0 + wc * 64 + 8 * fq;
#pragma unroll
        for (int ai = 0; ai < 2; ++ai)
#pragma unroll
            for (int m = 0; m < 4; ++m) { const int r = ai * HALF + wr * 64 + m * 16 + fr;
                const f32x2v a = X[r * 4 + 0], b = X[r * 4 + 1], c = X[r * 4 + 2], d = X[r * 4 + 3];
                const float mt = fmaxf(fmaxf(a.x, b.x), fmaxf(c.x, d.x));
                const float st = a.y * __builtin_amdgcn_exp2f(a.x - mt) + b.y * __builtin_amdgcn_exp2f(b.x - mt) + c.y * __builtin_amdgcn_exp2f(c.x - mt) + d.y * __builtin_amdgcn_exp2f(d.x - mt);
                const float f = __builtin_amdgcn_exp2f(mw[ai][m] - mt) / st;
                u32x4 w[2];
#pragma unroll
                for (int bj = 0; bj < 2; ++bj) { const f32x4 v0 = e[ai][m][bj][0] * f, v1 = e[ai][m][bj][1] * f;
                    w[bj].x = cvt_pk_bf16(v0[0], v0[1]); w[bj].y = cvt_pk_bf16(v0[2], v0[3]); w[bj].z = cvt_pk_bf16(v1[0], v1[1]); w[bj].w = cvt_pk_bf16(v1[2], v1[3]); }
                store_rows128(stg + (wr * 4 + wc) * 2048, O + (size_t)(u.orow0 + r - fr) * 1024 + u.ocol0 + wc * 64, 1024, w[0], w[1], fr, fq, 16); }
    }
};
}


__device__ __forceinline__ float4 ldnt4(const float* p) { const f32x4 v = __builtin_nontemporal_load((const f32x4*)p); return make_float4(v[0], v[1], v[2], v[3]); }
__device__ __forceinline__ void stnt4(float* p, float4 v) { __builtin_nontemporal_store((f32x4){v.x, v.y, v.z, v.w}, (f32x4*)p); }
__device__ __forceinline__ void transpose_item(const float* W, int K, int N, unsigned short* WT, LAS float* scr, int item, int lane) {
    const int nblk = N / 32, kb = item / nblk, nb = item % nblk, k0 = 64 * kb, n0 = 32 * nb;
#pragma unroll
    for (int i = 0; i < 8; ++i) { const int kk = 8 * i + (lane >> 3); const float4 v = ldnt4(W + (size_t)(k0 + kk) * N + n0 + 4 * (lane & 7));
        LAS float* d = scr + kk * 33 + 4 * (lane & 7); d[0] = v.x; d[1] = v.y; d[2] = v.z; d[3] = v.w; }
    WSYNC();
    const int c = lane & 7;
#pragma unroll
    for (int j = 0; j < 4; ++j) { const int n = (lane >> 3) + 8 * j; const LAS float* sp = scr + (8 * c) * 33 + n;
        g8::u32x4 o; o.x = g8::cvt_pk_bf16(sp[0 * 33], sp[1 * 33]); o.y = g8::cvt_pk_bf16(sp[2 * 33], sp[3 * 33]); o.z = g8::cvt_pk_bf16(sp[4 * 33], sp[5 * 33]); o.w = g8::cvt_pk_bf16(sp[6 * 33], sp[7 * 33]);
        *(g8::u32x4*)(WT + (size_t)(n0 + n) * K + k0 + 8 * c) = o; }
    WSYNC();
}
__device__ __forceinline__ void quant_w1_block(const float* W, int N, signed char* Q, float* sbo, LAS float* stage, LAS float* red, int nb, int tid) {
    const int lane = tid & 63, wave = tid >> 6, n0 = 32 * nb;
    float4 m4 = make_float4(0.f, 0.f, 0.f, 0.f);
    const float* wp = W + (size_t)(128 * wave + (lane >> 3)) * N + n0 + 4 * (lane & 7);
    LAS float* dp = stage + (128 * wave + (lane >> 3)) * 33 + 4 * (lane & 7);
#pragma unroll 8
    for (int i = 0; i < 16; ++i) { const float4 v = ldnt4(wp + (size_t)i * 8 * N); LAS float* d = dp + i * 8 * 33; d[0] = v.x; d[1] = v.y; d[2] = v.z; d[3] = v.w;
        m4.x = fmaxf(m4.x, fabsf(v.x)); m4.y = fmaxf(m4.y, fabsf(v.y)); m4.z = fmaxf(m4.z, fabsf(v.z)); m4.w = fmaxf(m4.w, fabsf(v.w)); }
#pragma unroll
    for (int o = 8; o < 64; o <<= 1) { m4.x = fmaxf(m4.x, __shfl_xor(m4.x, o)); m4.y = fmaxf(m4.y, __shfl_xor(m4.y, o)); m4.z = fmaxf(m4.z, __shfl_xor(m4.z, o)); m4.w = fmaxf(m4.w, __shfl_xor(m4.w, o)); }
    if (lane < 8) { LAS float* r = red + wave * 32 + 4 * lane; r[0] = m4.x; r[1] = m4.y; r[2] = m4.z; r[3] = m4.w; }
    __syncthreads();
    const int n = tid & 31, kc = tid >> 5;
    float mx = 0.f;
#pragma unroll
    for (int w = 0; w < 8; ++w) mx = fmaxf(mx, red[w * 32 + n]);
    mx = fmaxf(mx, 1e-30f);
    const float iv = 127.0f / mx;
    if (tid < 32) sbo[n0 + tid] = mx * (1.0f / 127.0f);
    const LAS float* sp = stage + (64 * kc) * 33 + n;
#pragma unroll
    for (int j = 0; j < 4; ++j) { g8::u32x4 o;
#pragma unroll
        for (int d = 0; d < 4; ++d) { unsigned w = 0u;
#pragma unroll
            for (int q = 0; q < 4; ++q) w |= ((unsigned)(int)rintf(sp[(16 * j + 4 * d + q) * 33] * iv) & 0xffu) << (8 * q);
            o[d] = w; }
        *(g8::u32x4*)(Q + (size_t)(n0 + n) * 1024 + 64 * kc + 16 * j) = o; }
    __syncthreads();
}
__device__ __forceinline__ void quant_w1_item(const float* W, int N, signed char* Q, float* sbo, LAS float* scr, int nb, int lane) {
    const int n0 = 32 * nb;
    float4 m4 = make_float4(0.f, 0.f, 0.f, 0.f);
    const float* wp = W + (size_t)(lane >> 3) * N + n0 + 4 * (lane & 7);
#pragma unroll 1
    for (int kb = 0; kb < 16; ++kb) {
#pragma unroll
        for (int i = 0; i < 8; ++i) { const float4 v = *(const float4*)(wp + (size_t)i * 8 * N); m4.x = fmaxf(m4.x, fabsf(v.x)); m4.y = fmaxf(m4.y, fabsf(v.y)); m4.z = fmaxf(m4.z, fabsf(v.z)); m4.w = fmaxf(m4.w, fabsf(v.w)); }
        wp += (size_t)64 * N; }
#pragma unroll
    for (int o = 8; o < 64; o <<= 1) { m4.x = fmaxf(m4.x, __shfl_xor(m4.x, o)); m4.y = fmaxf(m4.y, __shfl_xor(m4.y, o)); m4.z = fmaxf(m4.z, __shfl_xor(m4.z, o)); m4.w = fmaxf(m4.w, __shfl_xor(m4.w, o)); }
    float mx; { const int src = (lane & 31) >> 2, cmp = lane & 3; const float a = __shfl(m4.x, src), b = __shfl(m4.y, src), c2 = __shfl(m4.z, src), d = __shfl(m4.w, src); mx = cmp == 0 ? a : cmp == 1 ? b : cmp == 2 ? c2 : d; }
    mx = fmaxf(mx, 1e-30f);
    const float inv = 127.0f / mx;
    if (lane < 32) sbo[n0 + lane] = mx * (1.0f / 127.0f);
    const int c = lane & 7;
    wp = W + (size_t)(lane >> 3) * N + n0 + 4 * (lane & 7);
#pragma unroll 1
    for (int kb = 0; kb < 16; ++kb) { const int k0 = 64 * kb;
#pragma unroll
        for (int i = 0; i < 8; ++i) { const float4 v = ldnt4(wp + (size_t)i * 8 * N); LAS float* d = scr + (8 * i + (lane >> 3)) * 33 + 4 * (lane & 7); d[0] = v.x; d[1] = v.y; d[2] = v.z; d[3] = v.w; }
        wp += (size_t)64 * N;
        WSYNC();
#pragma unroll
        for (int j = 0; j < 4; ++j) { const int n = (lane >> 3) + 8 * j; const LAS float* sp = scr + (8 * c) * 33 + n; const float iv = __shfl(inv, n);
            unsigned lo = 0u, hi = 0u;
#pragma unroll
            for (int q = 0; q < 4; ++q) { lo |= ((unsigned)(int)rintf(sp[q * 33] * iv) & 0xffu) << (8 * q); hi |= ((unsigned)(int)rintf(sp[(q + 4) * 33] * iv) & 0xffu) << (8 * q); }
            g8::u32x2 o; o.x = lo; o.y = hi; *(g8::u32x2*)(Q + (size_t)(n0 + n) * 1024 + k0 + 8 * c) = o; }
        WSYNC(); }
}
__device__ __forceinline__ void transpose_item_f8(const float* W, int K, int N, unsigned char* WT, float scale, LAS float* scr, int item, int lane) {
    const int nblk = N / 32, kb = item / nblk, nb = item % nblk, k0 = 64 * kb, n0 = 32 * nb;
#pragma unroll
    for (int i = 0; i < 8; ++i) { const int kk = 8 * i + (lane >> 3); const float4 v = ldnt4(W + (size_t)(k0 + kk) * N + n0 + 4 * (lane & 7));
        LAS float* d = scr + kk * 33 + 4 * (lane & 7); d[0] = v.x; d[1] = v.y; d[2] = v.z; d[3] = v.w; }
    WSYNC();
    const int c = lane & 7;
#pragma unroll
    for (int j = 0; j < 4; ++j) { const int n = (lane >> 3) + 8 * j; const LAS float* sp = scr + (8 * c) * 33 + n;
        unsigned lo = 0u, hi = 0u;
        lo = __builtin_amdgcn_cvt_pk_fp8_f32(sp[0 * 33] * scale, sp[1 * 33] * scale, lo, false); lo = __builtin_amdgcn_cvt_pk_fp8_f32(sp[2 * 33] * scale, sp[3 * 33] * scale, lo, true);
        hi = __builtin_amdgcn_cvt_pk_fp8_f32(sp[4 * 33] * scale, sp[5 * 33] * scale, hi, false); hi = __builtin_amdgcn_cvt_pk_fp8_f32(sp[6 * 33] * scale, sp[7 * 33] * scale, hi, true);
        g8::u32x2 o; o.x = lo; o.y = hi; *(g8::u32x2*)(WT + (size_t)(n0 + n) * K + k0 + 8 * c) = o; }
    WSYNC();
}
__device__ __forceinline__ float bf2f(unsigned short h) { return __uint_as_float((unsigned)h << 16); }
__device__ __forceinline__ void ln_wave(float4 (&v)[4], const float* g, const float* bta, int lane) {
    float s = 0.f;
#pragma unroll
    for (int j = 0; j < 4; ++j) s += (v[j].x + v[j].y) + (v[j].z + v[j].w);
    const float mean = wave_sum(s) * (1.f / D); float s2 = 0.f;
#pragma unroll
    for (int j = 0; j < 4; ++j) { v[j].x -= mean; v[j].y -= mean; v[j].z -= mean; v[j].w -= mean; s2 += (v[j].x * v[j].x + v[j].y * v[j].y) + (v[j].z * v[j].z + v[j].w * v[j].w); }
    const float rstd = 1.f / sqrtf(wave_sum(s2) * (1.f / D) + LN_EPS);
#pragma unroll
    for (int j = 0; j < 4; ++j) { const float4 gg = *(const float4*)(g + 4 * lane + 256 * j), bb = *(const float4*)(bta + 4 * lane + 256 * j);
        v[j].x = v[j].x * rstd * gg.x + bb.x; v[j].y = v[j].y * rstd * gg.y + bb.y; v[j].z = v[j].z * rstd * gg.z + bb.z; v[j].w = v[j].w * rstd * gg.w + bb.w; }
}


__device__ __forceinline__ float dot64_bf16(const unsigned short* kp, const LAS float* qv) {
    float s = 0.f;
#pragma unroll
    for (int c = 0; c < 8; ++c) { const g8::u32x4 kk = *(const g8::u32x4*)(kp + c * 8); const f32x4 q0 = *(const LAS f32x4*)(qv + c * 8), q1 = *(const LAS f32x4*)(qv + c * 8 + 4);
        s += __uint_as_float(kk.x << 16) * q0[0] + __uint_as_float(kk.x & 0xffff0000u) * q0[1] + __uint_as_float(kk.y << 16) * q0[2] + __uint_as_float(kk.y & 0xffff0000u) * q0[3]
           + __uint_as_float(kk.z << 16) * q1[0] + __uint_as_float(kk.z & 0xffff0000u) * q1[1] + __uint_as_float(kk.w << 16) * q1[2] + __uint_as_float(kk.w & 0xffff0000u) * q1[3]; }
    return s;
}
__device__ __forceinline__ unsigned short f2bf(float f) { return (unsigned short)(g8::cvt_pk_bf16(f, 0.f) & 0xffffu); }


namespace attn2 {
using bf16=__hip_bfloat16;
using bf16x8=__attribute__((ext_vector_type(8)))short;
using s16x4=__attribute__((ext_vector_type(4)))short;
using f32x16=__attribute__((ext_vector_type(16)))float;
using u32x4=__attribute__((ext_vector_type(4)))unsigned;
constexpr int SEQ=2048,D=64,PQ=3072,PO=1024;
constexpr int NW=8,QBLK=32,QB=QBLK*NW,KVBLK=64,NQB=SEQ/QB;
__device__ __forceinline__ int crow(int r,int hi){return (r&3)+8*(r>>2)+4*hi;}
#define SBAR() __builtin_amdgcn_sched_barrier(0)
__device__ __forceinline__ void cmask(f32x16&p0,f32x16&p1,int jb,int qrel,int hi){
  const float NEG=-INFINITY; int kb=64*jb+4*hi;
  #pragma unroll
  for(int r=0;r<16;++r){int kv=kb+(r&3)+8*(r>>2); if(kv>qrel)p0[r]=NEG; if(kv+32>qrel)p1[r]=NEG;}
}

constexpr int NSLOT=3, SLOTB=8192;
constexpr int LDS_K=0, LDS_V=NSLOT*SLOTB, LDS_WS=2*NSLOT*SLOTB, LDS_OST=LDS_WS+NW*64*4, LDS_BYTES=LDS_OST+NW*4096;
constexpr float C2=0.125f*1.4426950408889634f;
__device__ __forceinline__ void glds16(const void*gsrc,unsigned lds_dst){unsigned keep;
  asm volatile("s_mov_b32 %0, m0\n\ts_mov_b32 m0, %2\n\ts_nop 0\n\tglobal_load_lds_dwordx4 %1, off\n\ts_mov_b32 m0, %0":"=&s"(keep):"v"(gsrc),"s"(lds_dst):"memory");}
__device__ __forceinline__ float max3f(float a,float b,float c){float r;asm("v_max3_f32 %0, %1, %2, %3":"=v"(r):"v"(a),"v"(b),"v"(c));return r;}
__device__ __forceinline__ float max2f(float a,float b){float r;asm("v_max_f32_e32 %0, %1, %2":"=v"(r):"v"(a),"v"(b));return r;}
__device__ __forceinline__ float fadd_s(float a,float b){float r;asm("v_add_f32_e32 %0, %1, %2":"=v"(r):"v"(a),"v"(b));return r;}
__device__ __forceinline__ float fsub_s(float a,float b){float r;asm("v_sub_f32_e32 %0, %1, %2":"=v"(r):"v"(a),"v"(b));return r;}
typedef float f32x4_t __attribute__((ext_vector_type(4)));
__device__ __forceinline__ float bfs(short h){return __uint_as_float(((unsigned)(unsigned short)h)<<16);}
typedef float f32x2_t __attribute__((ext_vector_type(2))); typedef __bf16 bf16x2_t __attribute__((ext_vector_type(2)));
__device__ __forceinline__ unsigned cvtpk_s(float lo,float hi){f32x2_t v={lo,hi};bf16x2_t b=__builtin_convertvector(v,bf16x2_t);return __builtin_bit_cast(unsigned,b);}
#define WAIT_BAR(N) asm volatile("s_waitcnt vmcnt(" #N ") lgkmcnt(0)\n\ts_barrier":::"memory")

__device__ __forceinline__ void qkt(f32x16&p0,f32x16&p1,const char*Kslot,const bf16x8*qr,int r32,int hi){ const f32x16 negm=f32x16{};
  const char*kb=Kslot+hi*1024+r32*16;
  #pragma unroll
  for(int d0=0;d0<4;++d0){
    const bf16x8 b0=*reinterpret_cast<const bf16x8*>(kb+d0*2048);
    const bf16x8 b1=*reinterpret_cast<const bf16x8*>(kb+d0*2048+512);
    if(d0==0){p0=__builtin_amdgcn_mfma_f32_32x32x16_bf16(b0,qr[0],negm,0,0,0);p1=__builtin_amdgcn_mfma_f32_32x32x16_bf16(b1,qr[0],negm,0,0,0);}
    else{p0=__builtin_amdgcn_mfma_f32_32x32x16_bf16(b0,qr[d0],p0,0,0,0);p1=__builtin_amdgcn_mfma_f32_32x32x16_bf16(b1,qr[d0],p1,0,0,0);}}
}
typedef __attribute__((address_space(3))) const char* lds_cptr;
typedef short v4i16_t __attribute__((ext_vector_type(4)));
__device__ __forceinline__ void kload8(bf16x8*kf,lds_cptr kp){
  kf[0]=*(const __attribute__((address_space(3))) bf16x8*)(kp);      kf[1]=*(const __attribute__((address_space(3))) bf16x8*)(kp+512);
  kf[2]=*(const __attribute__((address_space(3))) bf16x8*)(kp+2048); kf[3]=*(const __attribute__((address_space(3))) bf16x8*)(kp+2560);
  kf[4]=*(const __attribute__((address_space(3))) bf16x8*)(kp+4096); kf[5]=*(const __attribute__((address_space(3))) bf16x8*)(kp+4608);
  kf[6]=*(const __attribute__((address_space(3))) bf16x8*)(kp+6144); kf[7]=*(const __attribute__((address_space(3))) bf16x8*)(kp+6656);
}
__device__ __forceinline__ void kload2(bf16x8*kf,lds_cptr kp,int j){ kf[2*j]=*(const __attribute__((address_space(3))) bf16x8*)(kp+j*2048); kf[2*j+1]=*(const __attribute__((address_space(3))) bf16x8*)(kp+j*2048+512); }
__device__ __forceinline__ s16x4 vtr(lds_cptr p){ return __builtin_bit_cast(s16x4,__builtin_amdgcn_ds_read_tr16_b64_v4i16((__attribute__((address_space(3))) v4i16_t*)p)); }
__device__ __forceinline__ float rowmax(const f32x16&p0,const f32x16&p1){
  float a=max3f(p0[0],p0[1],p1[0]),b=max3f(p0[2],p0[3],p1[1]);a=max3f(a,p1[2],p1[3]);
  #pragma unroll
  for(int r=4;r<16;r+=4){a=max3f(a,p0[r],p0[r+1]);b=max3f(b,p0[r+2],p0[r+3]);a=max3f(a,p1[r],p1[r+1]);b=max3f(b,p1[r+2],p1[r+3]);}
  const float m=max2f(a,b);
  auto rr=__builtin_amdgcn_permlane32_swap(__float_as_uint(m),__float_as_uint(m),false,false);
  return max2f(__uint_as_float(rr[0]),__uint_as_float(rr[1]));
}
__device__ __forceinline__ void pv(f32x16*o,int vb,bf16x8 pa0,bf16x8 pa1,bf16x8 pa2,bf16x8 pa3){
  #pragma unroll
  for(int d0=0;d0<2;++d0){s16x4 lo[4],hi[4];
    #pragma unroll
    for(int ks=0;ks<4;++ks){
      asm volatile("ds_read_b64_tr_b16 %0,%1 offset:%c2":"=&v"(lo[ks]):"v"(vb),"i"(d0*4096+ks*1024):"memory");
      asm volatile("ds_read_b64_tr_b16 %0,%1 offset:%c2":"=&v"(hi[ks]):"v"(vb),"i"(d0*4096+ks*1024+512):"memory");}
    asm volatile("s_waitcnt lgkmcnt(0)":::"memory");SBAR();
    #define PK(k) (bf16x8){lo[k][0],lo[k][1],lo[k][2],lo[k][3],hi[k][0],hi[k][1],hi[k][2],hi[k][3]}
    o[d0]=__builtin_amdgcn_mfma_f32_32x32x16_bf16(pa0,PK(0),o[d0],0,0,0);
    o[d0]=__builtin_amdgcn_mfma_f32_32x32x16_bf16(pa1,PK(1),o[d0],0,0,0);
    o[d0]=__builtin_amdgcn_mfma_f32_32x32x16_bf16(pa2,PK(2),o[d0],0,0,0);
    o[d0]=__builtin_amdgcn_mfma_f32_32x32x16_bf16(pa3,PK(3),o[d0],0,0,0);
    #undef PK
  }
}

#ifndef ATTN_STORE16
#define ATTN_STORE16(p,v) (*(u32x4*)(p)=(v))
#endif
template<int THRL> __device__ __forceinline__ void attn_unit(int b,int qb,const bool MOBA,const bf16*Qp,const bf16*__restrict__ Kp,const bf16*__restrict__ Vp,bf16*Op,const float*kmean_bh,char*shm){
  int tid_=threadIdx.x; asm volatile("":"+v"(tid_));
  const int tid=tid_,lane=tid&63,r32=lane&31,hi=lane>>5; const int wid=__builtin_amdgcn_readfirstlane(tid>>6);
  const long rowbase=(long)b*SEQ; const int q0=qb*QB;
  const bf16*Qw=Qp+(rowbase+q0+wid*QBLK)*PQ;
  const bf16*Kh=Kp+rowbase*PQ,*Vh=Vp+rowbase*PQ;
  const unsigned lds0=(unsigned)(uintptr_t)shm;
  float*wsf=(float*)(shm+LDS_WS)+wid*64;
  const bf16*ksrc=Kh+(long)lane*PQ+wid*8;
  const bf16*vsrc=Vh+(long)(16*(wid&3)+(lane>>2))*PQ+(wid>>2)*32+(lane&3)*8;
  const unsigned kdst=lds0+LDS_K+wid*1024, vdst=lds0+LDS_V+wid*1024;
  #define TILE(t) (((t)<4)?(NT-4+(t)):((t)-4))
  #define DMA_K(t,slot) glds16(ksrc+(long)TILE(t)*KVBLK*PQ,(unsigned)__builtin_amdgcn_readfirstlane(kdst+(slot)))
  #define DMA_V(t,slot) glds16(vsrc+(long)TILE(t)*KVBLK*PQ,(unsigned)__builtin_amdgcn_readfirstlane(vdst+(slot)))
  const int vb0=(int)(lds0+LDS_V)+((lane>>4)&1)*32+(lane&3)*8+(4*hi+((lane&15)>>2))*64;
  const char*Kbase=shm+LDS_K; bf16x8 kf[8];
  const lds_cptr shm3=(lds_cptr)shm; const lds_cptr kp0=shm3+LDS_K+hi*1024+r32*16; const lds_cptr vp0=shm3+LDS_V+((lane>>4)&1)*32+(lane&3)*8+(4*hi+((lane&15)>>2))*64;
  const int NT=(q0+QB)/KVBLK;
  DMA_K(0,0);DMA_V(0,0);DMA_K(1,SLOTB);
  bf16x8 qr[4];
  #pragma unroll
  for(int d0=0;d0<4;++d0)qr[d0]=*reinterpret_cast<const bf16x8*>(&Qw[(long)r32*PQ+d0*16+hi*8]);
  unsigned selmask=0xffu;
  if(MOBA&&qb>=4){ float g[8];
    #pragma unroll
    for(int n=0;n<8;++n){ g[n]=-INFINITY; if(n<qb){ float s=0.f; const float*km=kmean_bh+n*64+hi*8;
        #pragma unroll
        for(int d0=0;d0<4;++d0){ const f32x4_t k0=*reinterpret_cast<const f32x4_t*>(km+d0*16),k1=*reinterpret_cast<const f32x4_t*>(km+d0*16+4); const bf16x8 qq=qr[d0];
          s+=bfs(qq[0])*k0[0]+bfs(qq[1])*k0[1]+bfs(qq[2])*k0[2]+bfs(qq[3])*k0[3]+bfs(qq[4])*k1[0]+bfs(qq[5])*k1[1]+bfs(qq[6])*k1[2]+bfs(qq[7])*k1[3]; }
        auto rr=__builtin_amdgcn_permlane32_swap(__float_as_uint(s),__float_as_uint(s),false,false); g[n]=__uint_as_float(rr[0])+__uint_as_float(rr[1]); } }
    selmask=0u;
    #pragma unroll
    for(int r=0;r<3;++r){ int best=-1; float bv=0.f;
      #pragma unroll
      for(int n=0;n<8;++n) if(n<qb&&!((selmask>>n)&1u)&&(best<0||g[n]>bv)){best=n;bv=g[n];}
      selmask|=1u<<best; } }
  float mhat=0.f,l_reg=0.f;f32x16 o[2];o[0]=f32x16{};o[1]=f32x16{};
  const int qrel=wid*QBLK+r32;
  const int jw=wid>>1;
  #define CMASK_SUB(P0,P1,t,SUB) do{ SUB=mhat; if((t)<4){ if((t)==jw)cmask(P0,P1,(t),qrel,hi); else if((t)>jw)SUB=INFINITY; } \
      else if(MOBA&&qb>=4){ if(!((selmask>>(((t)-4)>>2))&1u))SUB=INFINITY; } }while(0)
  bool resc=false;
  #define START(P0,P1) do{ const float rm=rowmax(P0,P1); resc=false; \
    { const float dl=(__builtin_fabsf(rm)>(float)THRL)?rm:0.f; mhat=dl;     \
      if(__any(dl!=0.f)){ _Pragma("unroll") for(int r=0;r<16;++r){P0[r]=fsub_s(P0[r],dl);P1[r]=fsub_s(P1[r],dl);} } \
    } \
    _Pragma("unroll") for(int r=0;r<16;++r)P0[r]=__builtin_amdgcn_exp2f(P0[r]); }while(0)
  #define RESC() do{ if(resc){ asm volatile("s_waitcnt lgkmcnt(0)":::"memory"); \
      _Pragma("unroll") for(int d_=0;d_<2;++d_) _Pragma("unroll") for(int r=0;r<16;++r)o[d_][r]*=wsf[crow(r,hi)]; } }while(0)
  f32x16 pA0,pA1,pB0,pB1;
  int sl_prev=0,sl_cur=0,sl_next=SLOTB;
  #define ROT() do{sl_prev=sl_cur;sl_cur=sl_next;sl_next=(sl_next==(NSLOT-1)*SLOTB)?0:sl_next+SLOTB;}while(0)
  DMA_K(2,2*SLOTB);
  WAIT_BAR(3);
  qkt(pA0,pA1,Kbase,qr,r32,hi);asm volatile("s_nop 15\n\ts_nop 7":"+v"(pA0),"+v"(pA1));if(jw==0)cmask(pA0,pA1,0,qrel,hi);
  START(pA0,pA1);
  _Pragma("unroll") for(int r=0;r<16;++r)pA1[r]=__builtin_amdgcn_exp2f(pA1[r]);
  WAIT_BAR(0);
  DMA_K(3,0);DMA_V(1,SLOTB);
  ROT();
  kload8(kf,kp0+sl_cur);
  WAIT_BAR(2);
  s16x4 vlo[8],vhi[8]; u32x4 pw0,pw1,pw2,pw3;
  #define PKW(P,B) cvtpk_s(P[B],P[B+1])
  #define PAF(k) __builtin_bit_cast(bf16x8,pw##k)
  #define VFR(i) (bf16x8){vlo[i][0],vlo[i][1],vlo[i][2],vlo[i][3],vhi[i][0],vhi[i][1],vhi[i][2],vhi[i][3]}
  #define PIN(x) asm volatile("":"+v"(x))
  #define MX3(a,b,c) __builtin_fmaxf(__builtin_fmaxf((a),(b)),(c))
  #define GAPA(MF,A0,A1,A2,A3,W0,W1,PW) do{ MF; sacc+=A0; sacc+=A1; sacc+=A2; sacc+=A3; PIN(sacc); W0; W1; PIN(PW); SBAR(); }while(0)
  #define EX(v) __builtin_amdgcn_exp2f(v)
  #define GAPB(MF,X,B) do{ MF; X[B]=EX(X[B]); X[B+1]=EX(X[B+1]); X[B+2]=EX(X[B+2]); X[B+3]=EX(X[B+3]); PIN(X); SBAR(); }while(0)
  #define VRD(i) do{ vlo[i]=vtr(vp_+(((i)>>2)*4096+((i)&3)*1024)); vhi[i]=vtr(vp_+(((i)>>2)*4096+((i)&3)*1024+512)); }while(0)
  #define KRD(G,j) do{ if(G){ kload2(kf,kp0+sl_next,j); SBAR(); } }while(0)
  #define STEP(C0,C1,P0,P1,t,GK,GV,GL) do{ SBAR(); \
    const lds_cptr vp_=vp0+sl_prev; \
    VRD(0); SBAR(); float sacc=(P0[0]+P0[1]); \
    GAPA(C0=__builtin_amdgcn_mfma_f32_32x32x16_bf16(kf[0],qr[0],f32x16{},0,0,0), P0[2],P0[3],P0[4],P0[5],     pw0[0]=PKW(P0,0), pw0[1]=PKW(P0,2), pw0); \
    VRD(4); SBAR(); GAPA(C1=__builtin_amdgcn_mfma_f32_32x32x16_bf16(kf[1],qr[0],f32x16{},0,0,0), P0[6],P0[7],P0[8],P0[9],     pw0[2]=PKW(P0,4), pw0[3]=PKW(P0,6), pw0); \
    VRD(1); SBAR(); GAPA(C0=__builtin_amdgcn_mfma_f32_32x32x16_bf16(kf[2],qr[1],C0,0,0,0),   P0[10],P0[11],P0[12],P0[13], pw1[0]=PKW(P0,8), pw1[1]=PKW(P0,10), pw1); \
    VRD(5); SBAR(); GAPA(C1=__builtin_amdgcn_mfma_f32_32x32x16_bf16(kf[3],qr[1],C1,0,0,0),   P0[14],P0[15],P1[0],P1[1],   pw1[2]=PKW(P0,12),pw1[3]=PKW(P0,14), pw1); \
    VRD(2); SBAR(); GAPA(C0=__builtin_amdgcn_mfma_f32_32x32x16_bf16(kf[4],qr[2],C0,0,0,0),   P1[2],P1[3],P1[4],P1[5],     pw2[0]=PKW(P1,0), pw2[1]=PKW(P1,2), pw2); \
    VRD(6); SBAR(); GAPA(C1=__builtin_amdgcn_mfma_f32_32x32x16_bf16(kf[5],qr[2],C1,0,0,0),   P1[6],P1[7],P1[8],P1[9],     pw2[2]=PKW(P1,4), pw2[3]=PKW(P1,6), pw2); \
    VRD(3); SBAR(); GAPA(C0=__builtin_amdgcn_mfma_f32_32x32x16_bf16(kf[6],qr[3],C0,0,0,0),   P1[10],P1[11],P1[12],P1[13], pw3[0]=PKW(P1,8), pw3[1]=PKW(P1,10), pw3); \
    VRD(7); SBAR(); GAPA(C1=__builtin_amdgcn_mfma_f32_32x32x16_bf16(kf[7],qr[3],C1,0,0,0),   P1[14],P1[15],0.f,0.f,       pw3[2]=PKW(P1,12),pw3[3]=PKW(P1,14), pw3); \
    l_reg+=sacc; \
    if(GK){DMA_K((t)+3,sl_cur);} if(GV){DMA_V((t)+1,sl_next);} \
    { float sub_; CMASK_SUB(C0,C1,t,sub_); \
    if(__any(sub_!=0.f)){ _Pragma("unroll") for(int r=0;r<16;++r){C0[r]=fsub_s(C0[r],sub_);C1[r]=fsub_s(C1[r],sub_);} } }   \
    { float a=MX3(C0[0],C0[1],C1[0]),b=MX3(C0[2],C0[3],C1[1]); a=MX3(a,C1[2],C1[3]); \
      _Pragma("unroll") for(int r=4;r<16;r+=4){a=MX3(a,C0[r],C0[r+1]);b=MX3(b,C0[r+2],C0[r+3]);a=MX3(a,C1[r],C1[r+1]);b=MX3(b,C1[r+2],C1[r+3]);} \
      float rm=__builtin_fmaxf(a,b); { auto rr=__builtin_amdgcn_permlane32_swap(__float_as_uint(rm),__float_as_uint(rm),false,false); rm=__builtin_fmaxf(__uint_as_float(rr[0]),__uint_as_float(rr[1])); } \
      resc=false; \
      if(__builtin_expect(__any(rm>(float)THRL),0)){ const float dl=__builtin_fmaxf(rm,0.f); mhat+=dl; \
        _Pragma("unroll") for(int r=0;r<16;++r){C0[r]-=dl;C1[r]-=dl;} \
        const float f=__builtin_amdgcn_exp2f(-dl); l_reg*=f; if(hi==0)wsf[r32]=f; resc=true; } } \
    SBAR(); \
    GAPB(o[0]=__builtin_amdgcn_mfma_f32_32x32x16_bf16(PAF(0),VFR(0),o[0],0,0,0), C0,0); \
    GAPB(o[1]=__builtin_amdgcn_mfma_f32_32x32x16_bf16(PAF(0),VFR(4),o[1],0,0,0), C0,4); \
    KRD(GL,0); GAPB(o[0]=__builtin_amdgcn_mfma_f32_32x32x16_bf16(PAF(1),VFR(1),o[0],0,0,0), C0,8); \
    KRD(GL,1); GAPB(o[1]=__builtin_amdgcn_mfma_f32_32x32x16_bf16(PAF(1),VFR(5),o[1],0,0,0), C0,12); \
    KRD(GL,2); GAPB(o[0]=__builtin_amdgcn_mfma_f32_32x32x16_bf16(PAF(2),VFR(2),o[0],0,0,0), C1,0); \
    KRD(GL,3); GAPB(o[1]=__builtin_amdgcn_mfma_f32_32x32x16_bf16(PAF(2),VFR(6),o[1],0,0,0), C1,4); \
    GAPB(o[0]=__builtin_amdgcn_mfma_f32_32x32x16_bf16(PAF(3),VFR(3),o[0],0,0,0), C1,8); \
    GAPB(o[1]=__builtin_amdgcn_mfma_f32_32x32x16_bf16(PAF(3),VFR(7),o[1],0,0,0), C1,12); \
    }while(0)
  int t=1;
  for(;t+5<NT;t+=2){
    STEP(pB0,pB1,pA0,pA1,t,true,true,true);     WAIT_BAR(2); RESC(); ROT();
    STEP(pA0,pA1,pB0,pB1,t+1,true,true,true);   WAIT_BAR(2); RESC(); ROT();
  }
  #define ENDW(tt) do{ if((tt)+3<NT){WAIT_BAR(2);} else if((tt)+2<NT){WAIT_BAR(1);} else {WAIT_BAR(0);} }while(0)
  for(;t+1<NT;t+=2){
    STEP(pB0,pB1,pA0,pA1,t,(t+3<NT),(t+1<NT),(t+1<NT));       ENDW(t);   RESC(); ROT();
    STEP(pA0,pA1,pB0,pB1,t+1,(t+4<NT),(t+2<NT),(t+2<NT));     ENDW(t+1); RESC(); ROT();
  }
  STEP(pB0,pB1,pA0,pA1,NT-1,false,false,false); RESC();
  { float sacc=pB0[0]+pB0[1]; _Pragma("unroll") for(int r=2;r<16;++r)sacc+=pB0[r]; _Pragma("unroll") for(int r=0;r<16;++r)sacc+=pB1[r]; l_reg+=sacc;
    pw0=(u32x4){PKW(pB0,0),PKW(pB0,2),PKW(pB0,4),PKW(pB0,6)};pw1=(u32x4){PKW(pB0,8),PKW(pB0,10),PKW(pB0,12),PKW(pB0,14)};pw2=(u32x4){PKW(pB1,0),PKW(pB1,2),PKW(pB1,4),PKW(pB1,6)};pw3=(u32x4){PKW(pB1,8),PKW(pB1,10),PKW(pB1,12),PKW(pB1,14)};
    SBAR(); pv(o,vb0+sl_cur,PAF(0),PAF(1),PAF(2),PAF(3)); }
  #undef PKW
  #undef PAF
  #undef VFR
  #undef PIN
  #undef MX3
  #undef GAPA
  #undef GAPB
  #undef EX
  #undef VRD
  #undef KRD
  #undef STEP
  #undef ENDW
  {auto rr=__builtin_amdgcn_permlane32_swap(__float_as_uint(l_reg),__float_as_uint(l_reg),false,false);l_reg=__uint_as_float(rr[0])+__uint_as_float(rr[1]);}
  if(hi==0)wsf[32+r32]=l_reg;asm volatile("s_waitcnt lgkmcnt(0)":::"memory");
  float rli[16];
  #pragma unroll
  for(int r=0;r<16;++r)rli[r]=__builtin_amdgcn_rcpf(wsf[32+crow(r,hi)]);
  bf16*Ow=Op+(rowbase+q0+wid*QBLK)*PO;
  { bf16*stg=(bf16*)(shm+LDS_OST)+wid*2048;
    #pragma unroll
    for(int r=0;r<16;++r){const int orow=crow(r,hi);
      #pragma unroll
      for(int d0=0;d0<2;++d0)stg[orow*64+d0*32+r32]=__float2bfloat16(o[d0][r]*rli[r]);}
    asm volatile("s_waitcnt lgkmcnt(0)":::"memory");
    #pragma unroll
    for(int i=0;i<4;++i){const int row=i*8+(lane>>3),ch=lane&7; const u32x4 v=*(const u32x4*)(stg+row*64+ch*8); ATTN_STORE16(Ow+(long)row*PO+ch*8,v);} }
  asm volatile("s_waitcnt lgkmcnt(0)\n\ts_barrier":::"memory");
  #undef DMA_K
  #undef TILE
  #undef DMA_V
  #undef CMASK_SUB
  #undef START
  #undef RESC
  #undef ROT
}
constexpr int ATTN_LDS_BYTES=LDS_BYTES;
#undef SBAR
#undef WAIT_BAR
}
__device__ __forceinline__ void attn_phase(char* lds, const unsigned short* projb_, unsigned short* tmpb_, unsigned short* mixb_, const float* kmean, int G, int blk,
                                           const float* lq1, const float* lk1, const float* lq2, const float* lk2, const float* subln_g) {
    using attn2::bf16;
    const bf16* projb = (const bf16*)projb_; bf16* tmpb = (bf16*)tmpb_; bf16* mixb = (bf16*)mixb_;
    const int vcu = (G % 8 == 0) ? (blk % 8) * (G / 8) + blk / 8 : blk;
    for (int it = vcu; it < 1536; it += G) {
        const bool moba = it >= 512; const int q = moba ? it - 512 : it;
        const int s = q & 3, h = moba ? (q >> 2) & 7 : (q >> 2) & 3, b = moba ? q >> 5 : q >> 4, nun = moba ? 2 : 8;
        const float* km = kmean + (size_t)((b * 8 + (moba ? h : 0)) * 8) * 64;
        for (int k = 0; k < nun; ++k) {
            const int u = moba ? k : k >> 2, cv = k & 3, c = cv >> 1, vh = cv & 1, qb = u ? s : 7 - s;
            const int qcol = moba ? 1536 + h * 64 : h * 128 + c * 64, kcol = moba ? 2048 + h * 64 : 512 + h * 128 + c * 64, vcol = moba ? 2560 + h * 64 : 1024 + h * 128 + vh * 64;
            bf16* op = moba ? mixb + 512 + h * 64 : tmpb + (h * 2 + c) * 128 + vh * 64;
            attn2::attn_unit<8>(b, qb, moba, projb + qcol, projb + kcol, projb + vcol, op, km, lds);
            if (!moba && cv == 3) {
                const int lane = threadIdx.x & 63, wave = threadIdx.x >> 6, tk = lane >> 4, sg = lane & 15;
                float l4[4] = {lq1[lane], lk1[lane], lq2[lane], lk2[lane]}; float gg[8];
#pragma unroll
                for (int i = 0; i < 8; ++i) gg[i] = subln_g[sg * 8 + i] * 0.8f;
                asm volatile("s_waitcnt vmcnt(0)" : "+v"(l4[0]), "+v"(l4[1]), "+v"(l4[2]), "+v"(l4[3]) :: "memory"); __syncthreads();
                float lam; { const float a = wave_sum(l4[0] * l4[1]), b2 = wave_sum(l4[2] * l4[3]); lam = expf(a) - expf(b2) + 0.2f; }
                const unsigned short* tb = tmpb_; unsigned short* mb = mixb_;
                g8::u32x4 ua[8], ub[8];
#pragma unroll
                for (int g = 0; g < 8; ++g) { const size_t r = (size_t)b * SEQ + qb * 256 + wave * 4 + 32 * g + tk;
                    const unsigned short* p1 = tb + r * D + (h * 2) * 128 + sg * 8; const unsigned short* p2 = tb + r * D + (h * 2 + 1) * 128 + sg * 8;
                    asm volatile("global_load_dwordx4 %0, %1, off sc0 sc1" : "=v"(ua[g]) : "v"(p1) : "memory");
                    asm volatile("global_load_dwordx4 %0, %1, off sc0 sc1" : "=v"(ub[g]) : "v"(p2) : "memory"); }
                asm volatile("s_waitcnt vmcnt(0)" : "+v"(ua[0]), "+v"(ua[1]), "+v"(ua[2]), "+v"(ua[3]), "+v"(ua[4]), "+v"(ua[5]), "+v"(ua[6]), "+v"(ua[7]), "+v"(ub[0]), "+v"(ub[1]), "+v"(ub[2]), "+v"(ub[3]), "+v"(ub[4]), "+v"(ub[5]), "+v"(ub[6]), "+v"(ub[7]) :: "memory");
#pragma unroll
                for (int g = 0; g < 8; ++g) { const size_t r = (size_t)b * SEQ + qb * 256 + wave * 4 + 32 * g + tk;
                    unsigned u1[4], u2[4];
#pragma unroll
                    for (int i = 0; i < 4; ++i) { u1[i] = ua[g][i]; u2[i] = ub[g][i]; }
                    float a[8];
#pragma unroll
                    for (int i = 0; i < 4; ++i) { a[2 * i] = __uint_as_float(u1[i] << 16) - lam * __uint_as_float(u2[i] << 16); a[2 * i + 1] = __uint_as_float(u1[i] & 0xffff0000u) - lam * __uint_as_float(u2[i] & 0xffff0000u); }
                    float ss = 0.f;
#pragma unroll
                    for (int i = 0; i < 8; ++i) ss += a[i] * a[i];
                    ss += __shfl_xor(ss, 1); ss += __shfl_xor(ss, 2); ss += __shfl_xor(ss, 4); ss += __shfl_xor(ss, 8);
                    const float rr = 1.0f / sqrtf(ss * (1.0f / 128.0f) + 1e-5f);
                    g8::u32x4 o;
#pragma unroll
                    for (int i = 0; i < 4; ++i) o[i] = g8::cvt_pk_bf16(a[2 * i] * rr * gg[2 * i], a[2 * i + 1] * rr * gg[2 * i + 1]);
                    *(g8::u32x4*)(mb + r * D + h * 128 + sg * 8) = o; }
            }
        }
    }
}

struct Args { const float* in[26]; float* out; unsigned char* ws; int ph_lo, ph_hi; };
constexpr int LDS_BYTES = 163840, MISC_OFF = 144 * 1024 - 256, XS_OFF = 131072, GOFF_OFF = 140 * 1024, STG_OFF = 147456;
constexpr int NPH = 14;

__global__ void __launch_bounds__(NTHR, 2) fwd(Args args) {
    extern __shared__ __attribute__((aligned(16))) unsigned char lds_arr[];
    LAS unsigned char* lds = (LAS unsigned char*)lds_arr;
    volatile LAS unsigned* MISC = (volatile LAS unsigned*)(lds + MISC_OFF);
#define PH_VARS const int tid = threadIdx.x, lane = tid & 63, wave = __builtin_amdgcn_readfirstlane(tid >> 6); \
    const int gw = blockIdx.x * NWAVES + wave, NGW = gridDim.x * NWAVES; const int gt = blockIdx.x * NTHR + tid, NGT = gridDim.x * NTHR; (void)lane; (void)gw; (void)NGW; (void)gt; (void)NGT;
#define PTRS \
    unsigned char* ws = (unsigned char*)KA->ws; \
    unsigned* ctl = (unsigned*)(ws + WS_CTL); \
    const float* x = (const float*)KA->in[0]; const float* mem = (const float*)KA->in[1]; const float* w_in = (const float*)KA->in[2]; \
    const float* lq1 = (const float*)KA->in[3]; const float* lk1 = (const float*)KA->in[4]; const float* lq2 = (const float*)KA->in[5]; const float* lk2 = (const float*)KA->in[6]; \
    const float* subln_g = (const float*)KA->in[7]; const float* w_out = (const float*)KA->in[8]; const float* ln1_g = (const float*)KA->in[9]; const float* ln1_b = (const float*)KA->in[10]; \
    const float* mem_g = (const float*)KA->in[11]; const float* mem_b = (const float*)KA->in[12]; const float* w_q = (const float*)KA->in[13]; const float* w_kv = (const float*)KA->in[14]; \
    const float* w_o = (const float*)KA->in[15]; const float* ln2_g = (const float*)KA->in[16]; const float* ln2_b = (const float*)KA->in[17]; const float* w_router = (const float*)KA->in[18]; \
    const float* b_router = (const float*)KA->in[19]; const float* w_mlp1 = (const float*)KA->in[20]; const float* b_mlp1 = (const float*)KA->in[21]; const float* w_mlp2 = (const float*)KA->in[22]; \
    const float* b_mlp2 = (const float*)KA->in[23]; const float* ln3_g = (const float*)KA->in[24]; const float* ln3_b = (const float*)KA->in[25]; \
    float* out = (float*)KA->out; \
    float* ropec = (float*)(ws + WS_ROPE); float* ropes = ropec + SEQ * 8; \
    float* kmean = (float*)(ws + WS_KMEAN); \
    int* topi = (int*)(ws + WS_TOPI); float* topw = (float*)(ws + WS_TOPW); int* list = (int*)(ws + WS_LIST); float* wpos = (float*)(ws + WS_WPOS); int* posof = (int*)(ws + WS_POSOF); \
    bf* wint = (bf*)(ws + WS_WINT); bf* woutt = (bf*)(ws + WS_WOUTT); bf* wqb = (bf*)(ws + WS_WQB); bf* wkvt = (bf*)(ws + WS_WKVT); bf* wot = (bf*)(ws + WS_WOT); bf* w1t = (bf*)(ws + WS_W1T); bf* w2t = (bf*)(ws + WS_W2T); \
    bf* xb = (bf*)(ws + WS_XB); bf* projb = (bf*)(ws + WS_PROJ); bf* memn = (bf*)(ws + WS_MEMN); bf* kvmb = (bf*)(ws + WS_KVM); bf* gtb = (bf*)(ws + WS_GT); bf* vwtb = (bf*)(ws + WS_VWT); \
    bf* h1b = (bf*)(ws + WS_H1B); bf* t2b = (bf*)(ws + WS_OUT2); bf* pb = (bf*)(ws + WS_P); bf* h2b = (bf*)(ws + WS_H2B); \
    bf* mixb = (bf*)out + (size_t)T * D; \
    float* t2 = out; long long* lnst = (long long*)(ws + WS_LNZ); long long* gcs = (long long*)(ws + WS_LNZ + 1024 * 1024); long long* gbf = (long long*)(ws + WS_LNZ + 1280 * 1024); bf* hidb = (bf*)out; signed char* w1q = (signed char*)(ws + WS_W1T); unsigned char* w2q = (unsigned char*)(ws + WS_W2T); unsigned char* hid8 = (unsigned char*)out; signed char* h2q = (signed char*)(ws + WS_H2Q); float* sa = (float*)(ws + WS_SA); float* sbw = (float*)(ws + WS_SB); float* sapos = (float*)(ws + WS_SAPOS); float* sxr = (float*)(ws + WS_SX); float* swin = (float*)(ws + WS_SWIN); signed char* xq = (signed char*)(ws + WS_XB); \
    unsigned* cnt = ctl + CW_CNT; unsigned* fill = ctl + CW_FILL; \
    const int G = (int)gridDim.x, cB = (int)blockIdx.x; (void)ctl; (void)cnt; (void)fill; (void)G; (void)cB;
    typedef unsigned short bf;
    const volatile __attribute__((address_space(4))) Args* const KA = (const volatile __attribute__((address_space(4))) Args*)__builtin_amdgcn_kernarg_segment_ptr();
    unsigned* const ctl0 = (unsigned*)((unsigned char*)KA->ws + WS_CTL);
    if (threadIdx.x < 64) MISC[threadIdx.x] = 0u;
    __syncthreads();
    const int lo = KA->ph_lo, hi = KA->ph_hi;
    XcdBarrier bar; bar.bar = ctl0 + CW_BAR; bar.x = 0; bar.st = MISC + 8;
    if (hi - lo > 1) bar = xcd_barrier_post(ctl0 + CW_BAR, MISC + 8);
#define OPQ(x) ({ int _v = (x); asm volatile("" : "+s"(_v)); _v; })
#define IN(k) (OPQ(lo) <= (k) && (k) < OPQ(hi))
#define SEAM(k) do { if (IN(k) && IN((k) + 1)) xcd_barrier(bar); } while (0)

    if (IN(0)) {
        PH_VARS
        PTRS
        for (int i = gt; i < SEQ * 8; i += NGT) { double s, c; sincos_d((double)(i >> 3) * INV_FREQ[i & 7], s, c); ropec[i] = (float)c; ropes[i] = (float)s; }
        for (int r = gw; r < TM; r += NGW) { float4 v[4];
#pragma unroll
            for (int j = 0; j < 4; ++j) v[j] = *(const float4*)(mem + (size_t)r * D + 4 * lane + 256 * j);
            ln_wave(v, mem_g, mem_b, lane);
#pragma unroll
            for (int j = 0; j < 4; ++j) { g8::u32x2 w; w.x = g8::cvt_pk_bf16(v[j].x, v[j].y); w.y = g8::cvt_pk_bf16(v[j].z, v[j].w); *(g8::u32x2*)(memn + (size_t)r * D + 4 * lane + 256 * j) = w; } }
        for (int r = gw; r < T; r += NGW) { float4 v[4];
#pragma unroll
            for (int j = 0; j < 4; ++j) v[j] = ldnt4(x + (size_t)r * D + 4 * lane + 256 * j);
            float am = 0.f;
#pragma unroll
            for (int j = 0; j < 4; ++j) am = fmaxf(am, fmaxf(fmaxf(fabsf(v[j].x), fabsf(v[j].y)), fmaxf(fabsf(v[j].z), fabsf(v[j].w))));
            am = fmaxf(wave_max(am), 1e-30f); const float iv = 127.0f / am; if (lane == 0) sxr[r] = am * (1.0f / 127.0f);
#pragma unroll
            for (int j = 0; j < 4; ++j) { const unsigned q = ((unsigned)(int)rintf(v[j].x * iv) & 0xffu) | (((unsigned)(int)rintf(v[j].y * iv) & 0xffu) << 8) | (((unsigned)(int)rintf(v[j].z * iv) & 0xffu) << 16) | (((unsigned)(int)rintf(v[j].w * iv) & 0xffu) << 24);
                *(unsigned*)(xq + (size_t)r * D + 4 * lane + 256 * j) = q; } }
        for (size_t i = (size_t)gt; i < (size_t)D * D / 8; i += (size_t)NGT) { const float* src = w_q + i * 8; bf* dst = wqb + i * 8;
            const float4 a = *(const float4*)src, b = *(const float4*)(src + 4);
            g8::u32x4 w; w.x = g8::cvt_pk_bf16(a.x, a.y); w.y = g8::cvt_pk_bf16(a.z, a.w); w.z = g8::cvt_pk_bf16(b.x, b.y); w.w = g8::cvt_pk_bf16(b.z, b.w); *(g8::u32x4*)dst = w; }
        LAS float* scr = (LAS float*)lds + wave * (64 * 33);
        constexpr int I_IN = NPROJ / 32  , I_SQ = (D / 64) * (D / 32), I_KV = (D / 64) * (2 * D / 32), I2 = (DFF / 64) * (D / 32);
        constexpr int I1Q = 2 * DFF / 32;
        constexpr int NIT = I_SQ + I_KV + I_SQ + NEXP * I2;
        for (int it = gw; it < NIT; it += NGW) { int r = it;
            const float* W; unsigned short* WT; int K_, N_, q; bool quant = false, f8 = false, quant_in = false; int qe = 0;
            if (r < I_SQ) { W = w_out; WT = woutt; K_ = D; N_ = D; q = r; }
            else if ((r -= I_SQ) < I_KV) { W = w_kv; WT = wkvt; K_ = D; N_ = 2 * D; q = r; }
            else if ((r -= I_KV) < I_SQ) { W = w_o; WT = wot; K_ = D; N_ = D; q = r; }
            else { r -= I_SQ; qe = r / I2; q = r - qe * I2; W = w_mlp2 + (size_t)qe * DFF * D; WT = nullptr; K_ = DFF; N_ = D; f8 = true; }
            (void)quant; (void)quant_in;
            if (f8) transpose_item_f8(W, K_, N_, w2q + (size_t)qe * D * DFF, g8::W2_SCALE, scr, q, lane);
            else transpose_item(W, K_, N_, WT, scr, q, lane); }
        __syncthreads();
        { lfloat* stage = (lfloat*)lds; lfloat* red = stage + 1024 * 33;
          for (int it = blockIdx.x; it < I_IN + NEXP * I1Q; it += gridDim.x) {
              if (it < I_IN) quant_w1_block(w_in, NPROJ, (signed char*)wint, swin, stage, red, it, tid);
              else { const int r = it - I_IN, qe = r / I1Q, q = r - qe * I1Q; quant_w1_block(w_mlp1 + (size_t)qe * D * 2 * DFF, 2 * DFF, w1q + (size_t)qe * 2 * DFF * D, sbw + (size_t)qe * 2 * DFF, stage, red, q, tid); } } }
    }
    SEAM(0);
    if (IN(1)) {
        PTRS
        { g8::DenseOrder S; S.init(T, NPROJ, D / 2, G, cB); g8::EpiProj E{projb, ropec, ropes, lds + STG_OFF, sxr, swin, lds + XS_OFF}; int kq = D / 2; asm volatile("" : "+s"(kq)); g8::gemm_phase<g8::EpiProj, g8::DenseOrder, false>(lds, (const bf*)xq, D / 2, (const bf*)wint, D / 2, kq, nullptr, S, E); }
        { g8::DenseOrder S; S.init(TM, 2 * D, D, G, cB); g8::EpiPlainB E{kvmb, 2 * D, lds + STG_OFF}; g8::gemm_phase<g8::EpiPlainB, g8::DenseOrder, false>(lds, memn, D, wkvt, D, D, nullptr, S, E); }
    }
    SEAM(1);
    if (IN(2)) {
        PH_VARS
        PTRS
        int k256 = 256; asm volatile("" : "+s"(k256));
        { g8::GtOrder S{G, cB}; g8::EpiGT E{gtb, ln1_g, ln1_b, gcs, gbf, lds + STG_OFF}; g8::gemm_phase<g8::EpiGT, g8::GtOrder, false>(lds, kvmb, 2 * D, wqb, D, k256, nullptr, S, E); }
        { g8::VwtOrder S{G, cB}; g8::EpiPlainB E{vwtb, D, lds + STG_OFF}; g8::gemm_phase<g8::EpiPlainB, g8::VwtOrder, false>(lds, wot, D, kvmb, 2 * D, k256, nullptr, S, E); }
        for (int it = gw; it < BATCH * 8 * 8; it += NGW) { const int n = it & 7, h = (it >> 3) & 7, b = it >> 6;
            const bf* kp = projb + ((size_t)b * SEQ + n * 256) * NPROJ + 2048 + h * 64 + lane; float s = 0.f;
            for (int j = 0; j < 256; ++j) s += bf2f(kp[(size_t)j * NPROJ]);
            kmean[((b * 8 + h) * 8 + n) * 64 + lane] = s * (1.0f / 256.0f); }
    }
    SEAM(2);
    if (IN(3)) { PTRS attn_phase((char*)lds_arr, projb, (bf*)out, mixb, kmean, G, cB, lq1, lk1, lq2, lk2, subln_g); }
    if (IN(3) && IN(5)) xcd_barrier(bar);
    if (IN(5)) { PTRS g8::DenseOrder S; S.init(T, D, D, G, cB); g8::EpiResidStats E{h1b, x, lnst, ALPHA}; g8::gemm_phase<g8::EpiResidStats, g8::DenseOrder, false>(lds, mixb, D, woutt, D, D, nullptr, S, E); }
    if (IN(5) && IN(7)) xcd_barrier(bar);
    if (IN(7)) { PTRS g8::BatchOrder S; S.init(T, D, D, G, cB); S.bbatch_rows = D; g8::EpiSoftmaxP E{pb, lds + XS_OFF, lds + STG_OFF, lnst, gcs, gbf}; g8::gemm_phase<g8::EpiSoftmaxP, g8::BatchOrder, false>(lds, h1b, D, gtb, D, D, nullptr, S, E); }
    SEAM(7);
    if (IN(8)) { PTRS g8::BatchOrder S; S.init(T, D, D, G, cB); S.bbatch_rows = D; g8::EpiPlainB E{t2b, D, lds + STG_OFF}; g8::gemm_phase<g8::EpiPlainB, g8::BatchOrder, false>(lds, pb, D, vwtb, D, D, nullptr, S, E); }
    SEAM(8);
    if (IN(9)) {
        PH_VARS
        PTRS
        lfloat* xs = (lfloat*)lds; lfloat* red = (lfloat*)(lds + 32 * 1028 * 4); LAS int* chist = (LAS int*)(lds + 32 * 1028 * 4 + 2 * 32 * 33 * 4);
        if (tid < NEXP) chist[tid] = 0;
        __syncthreads();
        const int rh = wave & 1, eh = (wave >> 1) & 1, kh = wave >> 2, li = lane & 15, hq = lane >> 4;
        float Bw[128];
        { const float* wp = w_router + (size_t)(512 * kh + 128 * hq) * NEXP + 16 * eh + li;
#pragma unroll
          for (int s2 = 0; s2 < 128; ++s2) Bw[s2] = wp[(size_t)s2 * NEXP]; }
        for (int rb = blockIdx.x; rb < T / 32; rb += gridDim.x) {
#pragma unroll 1
            for (int rp = 0; rp < 4; rp += 2) {
            g8::u32x2 pin[2][4], pc[2][4]; float s1[2], s2[2];
#pragma unroll
            for (int rr = 0; rr < 2; ++rr) { const size_t r = (size_t)rb * 32 + 4 * wave + rp + rr;
                const long long* sp = lnst + 2 * r; asm volatile("" : "+v"(sp));
                s1[rr] = fx_get(sp); s2[rr] = fx_get(sp + 1);
#pragma unroll
                for (int j = 0; j < 4; ++j) { pin[rr][j] = *(const g8::u32x2*)(h1b + r * D + 4 * lane + 256 * j); pc[rr][j] = *(const g8::u32x2*)(t2b + r * D + 4 * lane + 256 * j); } }
#pragma unroll
            for (int rr = 0; rr < 2; ++rr) asm volatile("" : "+v"(pin[rr][0]), "+v"(pin[rr][1]), "+v"(pin[rr][2]), "+v"(pin[rr][3]), "+v"(pc[rr][0]), "+v"(pc[rr][1]), "+v"(pc[rr][2]), "+v"(pc[rr][3]), "+v"(s1[rr]), "+v"(s2[rr]));
#pragma unroll
            for (int rr = 0; rr < 2; ++rr) { const int row = 4 * wave + rp + rr; const size_t r = (size_t)rb * 32 + row; float4 v[4];
                const float mean1 = s1[rr] * (1.0f / 1024.0f), rstd1 = 1.0f / sqrtf(fmaxf(s2[rr] * (1.0f / 1024.0f) - mean1 * mean1, 0.f) + LN_EPS);
#pragma unroll
                for (int j = 0; j < 4; ++j) { const g8::u32x2 p = pin[rr][j], c = pc[rr][j]; const float4 gg = *(const float4*)(ln1_g + 4 * lane + 256 * j), bb = *(const float4*)(ln1_b + 4 * lane + 256 * j);
                    v[j].x = ((__uint_as_float(p.x << 16) - mean1) * rstd1 * gg.x + bb.x) * ALPHA + __uint_as_float(c.x << 16);
                    v[j].y = ((__uint_as_float(p.x & 0xffff0000u) - mean1) * rstd1 * gg.y + bb.y) * ALPHA + __uint_as_float(c.x & 0xffff0000u);
                    v[j].z = ((__uint_as_float(p.y << 16) - mean1) * rstd1 * gg.z + bb.z) * ALPHA + __uint_as_float(c.y << 16);
                    v[j].w = ((__uint_as_float(p.y & 0xffff0000u) - mean1) * rstd1 * gg.w + bb.w) * ALPHA + __uint_as_float(c.y & 0xffff0000u); }
                ln_wave(v, ln2_g, ln2_b, lane);
#pragma unroll
                for (int j = 0; j < 4; ++j) { g8::u32x2 w; w.x = g8::cvt_pk_bf16(v[j].x, v[j].y); w.y = g8::cvt_pk_bf16(v[j].z, v[j].w); *(g8::u32x2*)(h2b + r * D + 4 * lane + 256 * j) = w;
                    *(LAS f32x4*)&xs[row * 1028 + 4 * lane + 256 * j] = (f32x4){v[j].x, v[j].y, v[j].z, v[j].w}; }
                { float am = 0.f;
#pragma unroll
                  for (int j = 0; j < 4; ++j) am = fmaxf(am, fmaxf(fmaxf(fabsf(v[j].x), fabsf(v[j].y)), fmaxf(fabsf(v[j].z), fabsf(v[j].w))));
                  am = fmaxf(wave_max(am), 1e-30f); const float iv = 127.0f / am; if (lane == 0) sa[r] = am * (1.0f / 127.0f);
#pragma unroll
                  for (int j = 0; j < 4; ++j) { const unsigned q = ((unsigned)(int)rintf(v[j].x * iv) & 0xffu) | (((unsigned)(int)rintf(v[j].y * iv) & 0xffu) << 8) | (((unsigned)(int)rintf(v[j].z * iv) & 0xffu) << 16) | (((unsigned)(int)rintf(v[j].w * iv) & 0xffu) << 24);
                      *(unsigned*)(h2q + r * D + 4 * lane + 256 * j) = q; } } }
            }
            __syncthreads();
            f32x4 acc = {0.f, 0.f, 0.f, 0.f};
            { const lfloat* xp = xs + (16 * rh + li) * 1028 + 512 * kh + 128 * hq;
#pragma unroll
              for (int s4 = 0; s4 < 32; ++s4) { const f32x4 a4 = *(const LAS f32x4*)(xp + 4 * s4);
#pragma unroll
                  for (int u = 0; u < 4; ++u) acc = __builtin_amdgcn_mfma_f32_16x16x4f32(a4[u], Bw[4 * s4 + u], acc, 0, 0, 0); } }
#pragma unroll
            for (int q = 0; q < 4; ++q) red[(kh * 32 + 16 * rh + 4 * hq + q) * 33 + 16 * eh + li] = acc[q];
            __syncthreads();
            if (wave == 0 && lane < 32) { const size_t r = (size_t)rb * 32 + lane; float l32[NEXP];
#pragma unroll
                for (int e = 0; e < NEXP; ++e) l32[e] = red[lane * 33 + e] + red[(32 + lane) * 33 + e] + b_router[e];
                int bi[4]; float bv[4]; unsigned used = 0u;
#pragma unroll
                for (int k = 0; k < 4; ++k) { int best = -1; float bval = 0.f;
#pragma unroll
                    for (int e = 0; e < NEXP; ++e) if (!((used >> e) & 1u) && (best < 0 || l32[e] > bval)) { best = e; bval = l32[e]; }
                    used |= 1u << best; bi[k] = best; bv[k] = bval; }
                const float e0 = 1.0f, e1 = expf(bv[1] - bv[0]), e2 = expf(bv[2] - bv[0]), e3 = expf(bv[3] - bv[0]), inv = 1.0f / (e0 + e1 + e2 + e3);
                *(int4*)(topi + r * 4) = make_int4(bi[0], bi[1], bi[2], bi[3]); *(float4*)(topw + r * 4) = make_float4(e0 * inv, e1 * inv, e2 * inv, e3 * inv);
                __hip_atomic_fetch_add(&chist[bi[0]], 1, __ATOMIC_RELAXED, __HIP_MEMORY_SCOPE_WORKGROUP); __hip_atomic_fetch_add(&chist[bi[1]], 1, __ATOMIC_RELAXED, __HIP_MEMORY_SCOPE_WORKGROUP);
                __hip_atomic_fetch_add(&chist[bi[2]], 1, __ATOMIC_RELAXED, __HIP_MEMORY_SCOPE_WORKGROUP); __hip_atomic_fetch_add(&chist[bi[3]], 1, __ATOMIC_RELAXED, __HIP_MEMORY_SCOPE_WORKGROUP); }
            __syncthreads();
        }
        if (tid < NEXP) { const int n = chist[tid]; if (n) atomicAdd(&cnt[tid], (unsigned)n); }
    }
    SEAM(9);
    LAS int* goff = (LAS int*)(lds + GOFF_OFF);
    if (hi > 10) { const int tid = threadIdx.x; unsigned* cnt = ctl0 + CW_CNT; __syncthreads(); if (tid < 1) { int a = 0; for (int e = 0; e < NEXP; ++e) { goff[tid * 33 + e] = a; a += (int)__hip_atomic_load(&cnt[tid * NEXP + e], __ATOMIC_RELAXED, __HIP_MEMORY_SCOPE_AGENT); } goff[tid * 33 + 32] = a; } __syncthreads(); }
    if (IN(10)) {
        PH_VARS
        PTRS
        LAS int* hist = (LAS int*)lds; LAS int* base = hist + 32;
        for (int ch = blockIdx.x; ch < T / 256; ch += gridDim.x) {
            if (tid < 32) hist[tid] = 0;
            __syncthreads();
            const int t = ch * 256 + tid; int ee[4] = {0, 0, 0, 0}, loc[4] = {0, 0, 0, 0}; float ww[4] = {0.f, 0.f, 0.f, 0.f};
            if (tid < 256) { const int4 e4 = *(const int4*)(topi + (size_t)t * 4); const float4 w4 = *(const float4*)(topw + (size_t)t * 4);
                ee[0] = e4.x; ee[1] = e4.y; ee[2] = e4.z; ee[3] = e4.w; ww[0] = w4.x; ww[1] = w4.y; ww[2] = w4.z; ww[3] = w4.w;
#pragma unroll
                for (int k = 0; k < 4; ++k) loc[k] = __hip_atomic_fetch_add(&hist[ee[k]], 1, __ATOMIC_RELAXED, __HIP_MEMORY_SCOPE_WORKGROUP); }
            __syncthreads();
            if (tid < 32) { const int n = hist[tid]; base[tid] = goff[tid] + (n ? (int)atomicAdd(&fill[tid], (unsigned)n) : 0); }
            __syncthreads();
            if (tid < 256) { int pp[4]; const float sat = sa[t];
#pragma unroll
                for (int k = 0; k < 4; ++k) { const int pos = base[ee[k]] + loc[k]; list[pos] = t; wpos[pos] = ww[k]; sapos[pos] = sat; pp[k] = pos; }
                *(int4*)(posof + (size_t)t * 4) = make_int4(pp[0], pp[1], pp[2], pp[3]); }
            __syncthreads();
        }
    }
    SEAM(10);
    {
        PTRS
        bf* out2_p = (bf*)(ws + WS_OUT2);
        if (IN(11)) { g8::MoeOrder S{goff, 8, G, cB, D / 2, 0, 0, -1, 0}; g8::EpiSwigluI8 E{hid8, b_mlp1, sapos, sbw};
            g8::gemm_phase<g8::EpiSwigluI8, g8::MoeOrder, true>(lds, (const bf*)h2q, D / 2, (const bf*)w1q, D / 2, D / 2, list, S, E); }
        SEAM(11);
        if (IN(12)) { g8::MoeOrder S{goff, 4, G, cB, DFF / 2, 0, 0, -1, 0}; g8::EpiMoe2F8 E{out2_p, b_mlp2, wpos, lds + STG_OFF};
            int kq = DFF / 2; asm volatile("" : "+s"(kq));
            g8::gemm_phase<g8::EpiMoe2F8, g8::MoeOrder, false>(lds, (const bf*)hid8, DFF / 2, (const bf*)w2q, DFF / 2, kq, nullptr, S, E); }
        SEAM(12);
    }
    if (IN(13)) {
        PH_VARS
        PTRS
        const bf* o0 = (const bf*)(ws + WS_OUT2); const bf* o1 = o0; const bf* o2 = o0; const bf* o3 = o0;
        for (int r = gw; r < T; r += NGW) { float4 v[4]; const int4 ps = *(const int4*)(posof + (size_t)r * 4);
#pragma unroll
            for (int j = 0; j < 4; ++j) { const int c = 4 * lane + 256 * j;
                const g8::u32x2 hh = __builtin_nontemporal_load((const g8::u32x2*)(h2b + (size_t)r * D + c)), a0 = __builtin_nontemporal_load((const g8::u32x2*)(o0 + (size_t)ps.x * D + c)), a1 = __builtin_nontemporal_load((const g8::u32x2*)(o1 + (size_t)ps.y * D + c)),
                                a2 = __builtin_nontemporal_load((const g8::u32x2*)(o2 + (size_t)ps.z * D + c)), a3 = __builtin_nontemporal_load((const g8::u32x2*)(o3 + (size_t)ps.w * D + c));
#define LO(u) __uint_as_float((u) << 16)
#define HI(u) __uint_as_float((u) & 0xffff0000u)
                v[j].x = ALPHA * LO(hh.x) + ((LO(a0.x) + LO(a1.x)) + (LO(a2.x) + LO(a3.x)));
                v[j].y = ALPHA * HI(hh.x) + ((HI(a0.x) + HI(a1.x)) + (HI(a2.x) + HI(a3.x)));
                v[j].z = ALPHA * LO(hh.y) + ((LO(a0.y) + LO(a1.y)) + (LO(a2.y) + LO(a3.y)));
                v[j].w = ALPHA * HI(hh.y) + ((HI(a0.y) + HI(a1.y)) + (HI(a2.y) + HI(a3.y)));
#undef LO
#undef HI
            }
            ln_wave(v, ln3_g, ln3_b, lane);
#pragma unroll
            for (int j = 0; j < 4; ++j) stnt4(out + (size_t)r * D + 4 * lane + 256 * j, v[j]); }
    }
#undef IN
#undef SEAM
}

extern "C" void kernel_launch(void* const* d_in, const int* in_sizes, int n_in, void* d_out, int out_size, void* d_ws, size_t ws_size, hipStream_t stream) {
    static int grid = 0;
    if (grid == 0) {
        if (n_in != 26 || out_size != T * D || ws_size < WS_END) { fprintf(stderr, "kernel_launch: unexpected shapes (n_in %d out %d ws %zu)\n", n_in, out_size, ws_size); grid = -1; return; }
        int dev = 0, cus = 0, per_cu = 0;
        if (hipGetDevice(&dev) != hipSuccess || hipDeviceGetAttribute(&cus, hipDeviceAttributeMultiprocessorCount, dev) != hipSuccess) { grid = -1; return; }
        if (hipFuncSetAttribute((const void*)fwd, hipFuncAttributeMaxDynamicSharedMemorySize, LDS_BYTES) != hipSuccess) { fprintf(stderr, "kernel_launch: hipFuncSetAttribute failed\n"); grid = -1; return; }
        if (hipOccupancyMaxActiveBlocksPerMultiprocessor(&per_cu, (const void*)fwd, NTHR, LDS_BYTES) != hipSuccess || per_cu < 1) fprintf(stderr, "kernel_launch: occupancy query reports %d\n", per_cu);
        (void)hipGetLastError();
        grid = cus;
    }
    if (grid < 0) return;
    (void)hipMemsetAsync((char*)d_ws + WS_CTL, 0, CTL_ZERO_BYTES, stream);
    (void)hipMemsetAsync((char*)d_ws + WS_LNZ, 0, LNZ_BYTES, stream);
    Args a{};
    for (int i = 0; i < 26; ++i) a.in[i] = (const float*)d_in[i];
    a.out = (float*)d_out; a.ws = (unsigned char*)d_ws;
#if ONE_LAUNCH
#ifdef EXP_PREFIX
    a.ph_lo = 0; a.ph_hi = EXP_PREFIX + 1; hipLaunchKernelGGL(fwd, dim3(grid), dim3(NTHR), LDS_BYTES, stream, a);
    (void)hipMemsetAsync((char*)d_ws + WS_CTL, 0, CTL_ZERO_BYTES, stream); (void)hipMemsetAsync((char*)d_ws + WS_LNZ, 0, LNZ_BYTES, stream);
#endif
#ifndef EXP_LIST
    a.ph_lo = 0; a.ph_hi = NPH;
    hipLaunchKernelGGL(fwd, dim3(grid), dim3(NTHR), LDS_BYTES, stream, a);
#else
    { const int reps[] = {EXP_LIST}; int lo = 0;
      for (unsigned i = 0; i <= sizeof(reps) / sizeof(int); ++i) { const int hi = (i < sizeof(reps) / sizeof(int)) ? reps[i] + 1 : NPH;
          if (i) (void)hipMemsetAsync((char*)d_ws + WS_CTL + CW_BAR * 4, 0, (CW_CNT - CW_BAR) * 4, stream);
          a.ph_lo = lo; a.ph_hi = hi; hipLaunchKernelGGL(fwd, dim3(grid), dim3(NTHR), LDS_BYTES, stream, a); lo = hi - 1; } }
#endif
#else
    for (int p = 0; p < NPH; ++p) { a.ph_lo = p; a.ph_hi = p + 1; hipLaunchKernelGGL(fwd, dim3(grid), dim3(NTHR), LDS_BYTES, stream, a); }
#endif
}
```

```cpp
#include <hip/hip_runtime.h>
#include <hip/hip_bf16.h>
#include <cmath>
#include <cstdio>
#include <cstdint>

#ifndef ONE_LAUNCH
#define ONE_LAUNCH 1
#endif

constexpr int BATCH = 32, SEQ = 2048, D = 1024, T = BATCH * SEQ;
constexpr int MEML = 256, TM = BATCH * MEML;
constexpr int NPROJ = 3072;
constexpr int NEXP = 32, TOPK = 4, DFF = 1024;
constexpr float ALPHA = 1.189207115002721f;
constexpr float LN_EPS = 1e-5f;
constexpr int NTHR = 512, NWAVES = 8;

#define GAS __attribute__((address_space(1)))
#define LAS __attribute__((address_space(3)))
typedef LAS float lfloat;
typedef float f32x4 __attribute__((ext_vector_type(4)));
#define WSYNC() asm volatile("s_waitcnt lgkmcnt(0)" ::: "memory")

constexpr size_t MiB = 1u << 20;
constexpr size_t WS_CTL = 0, CTL_ZERO_BYTES = 128 * 1024;
constexpr size_t WS_ROPE = 1 * MiB;
constexpr size_t WS_KMEAN = 2 * MiB;
constexpr size_t WS_LNZ = 10 * MiB, LNZ_BYTES = 2 * MiB;
constexpr float FXS = 16777216.0f, FXI = 1.0f / 16777216.0f;
__device__ __forceinline__ void fx_add(long long* p, float v) { atomicAdd((unsigned long long*)p, (unsigned long long)(long long)rintf(v * FXS)); }
__device__ __forceinline__ float fx_get(const long long* p) { const int2 v = *(const int2*)p; return ((float)v.y * 4294967296.0f + (float)(unsigned)v.x) * FXI; }
constexpr size_t WS_SX = 13 * MiB, WS_SWIN = 14 * MiB;
constexpr size_t WS_SAPOS = 12 * MiB;
constexpr size_t WS_SA = 8 * MiB, WS_SB = 9 * MiB;
constexpr size_t WS_H2Q = 96 * MiB;
constexpr size_t WS_TOPI = 3 * MiB, WS_TOPW = 4 * MiB, WS_LIST = 5 * MiB, WS_WPOS = 6 * MiB, WS_POSOF = 7 * MiB;
constexpr size_t WS_WINT = 16 * MiB, WS_WOUTT = 22 * MiB, WS_WQB = 24 * MiB, WS_WKVT = 26 * MiB, WS_WOT = 30 * MiB, WS_W1T = 32 * MiB, WS_W2T = 160 * MiB;
constexpr size_t WS_XB = 224 * MiB;
constexpr size_t WS_PROJ = 352 * MiB;
constexpr size_t WS_MEMN = 736 * MiB, WS_KVM = 752 * MiB;
constexpr size_t WS_GT = 784 * MiB, WS_VWT = 848 * MiB;
constexpr size_t WS_H1B = 224 * MiB;
constexpr size_t WS_P = 608 * MiB;
constexpr size_t WS_H2B = 224 * MiB;
constexpr size_t WS_OUT2 = 352 * MiB;
constexpr size_t WS_END = 912 * MiB;
constexpr int CW_BAR = 4096, CW_CNT = 8192, CW_FILL = 8448, CW_CHUNK = 16384;
constexpr float C2Q = 0.125f * 1.4426950408889634f;
constexpr float C2M = 0.0625f * 1.4426950408889634f;

#define XB_TMO      128
#define XB_XCNT(j)  (256  + 64 * (j))
#define XB_XSUB(j)  (1280 + 64 * (j))
#define XB_XGEN(j)  (2304 + 64 * (j))
#define XB_TOP      3328
#define XB_TOPGEN   3392
#define XCD_BAR_WORDS 3456
#define XB_SPIN_CAP (1u << 24)

__device__ __forceinline__ unsigned xb_ld(unsigned* p)              { return __hip_atomic_load(p, __ATOMIC_RELAXED, __HIP_MEMORY_SCOPE_AGENT); }
__device__ __forceinline__ unsigned xb_add(unsigned* p, unsigned v) { return __hip_atomic_fetch_add(p, v, __ATOMIC_RELAXED, __HIP_MEMORY_SCOPE_AGENT); }
__device__ __forceinline__ unsigned xb_xcc_id() { return (unsigned)__builtin_amdgcn_s_getreg((3 << 11) | 20) & 0xFu; }
#define XB_SPIN(cond, bar) do { unsigned _sp = 0; while (cond) { __builtin_amdgcn_s_sleep(1); \
    if ((++_sp & 255u) == 0u) { if (xb_ld(&(bar)[XB_TMO])) break; if (_sp > XB_SPIN_CAP) { atomicAdd(&(bar)[XB_TMO], 1u); break; } } } } while (0)

struct XcdBarrier { unsigned* bar; unsigned x; volatile LAS unsigned* st; };

__device__ __forceinline__ XcdBarrier xcd_barrier_post(unsigned* bar, volatile LAS unsigned* st) {
    XcdBarrier b; b.bar = bar; b.x = xb_xcc_id(); b.st = st;
    if (threadIdx.x == 0) (void)xb_add(&bar[XB_XCNT(b.x)], 1u);
    return b;
}
__device__ __forceinline__ void xcd_barrier_complete(unsigned* bar, unsigned x, unsigned& nloc, unsigned& nx) {
    const unsigned G = gridDim.x * gridDim.y * gridDim.z;
    unsigned sum, cnt, mine, sp = 0u;
    for (;;) {
        sum = 0u; cnt = 0u; mine = 0u;
#pragma unroll
        for (unsigned j = 0; j < 16; ++j) { const unsigned c = xb_ld(&bar[XB_XCNT(j)]); sum += c; cnt += (c > 0u) ? 1u : 0u; mine = (j == x) ? c : mine; }
        if (sum == G) break;
        __builtin_amdgcn_s_sleep(1);
        if ((++sp & 255u) == 0u) { if (xb_ld(&bar[XB_TMO])) break; if (sp > XB_SPIN_CAP) { atomicAdd(&bar[XB_TMO], 1u); break; } }
    }
    nloc = mine > 0u ? mine : 1u; nx = cnt > 0u ? cnt : 1u;
}
__device__ __forceinline__ void xcd_barrier(const XcdBarrier& b) {
    asm volatile("s_waitcnt vmcnt(0)" ::: "memory");
    __syncthreads();
    if (threadIdx.x == 0) {
        unsigned* bar = b.bar;
        __builtin_amdgcn_s_waitcnt(0);
        unsigned nloc = b.st[0], nx = b.st[1];
        if (nloc == 0u) { xcd_barrier_complete(bar, b.x, nloc, nx); b.st[0] = nloc; b.st[1] = nx; }
        const unsigned old = xb_add(&bar[XB_XSUB(b.x)], 1u);
        const unsigned gen = old / nloc;
        if (old + 1u == (gen + 1u) * nloc) {
            __builtin_amdgcn_fence(__ATOMIC_RELEASE, "agent");
            asm volatile("s_waitcnt vmcnt(0)" ::: "memory");
            const unsigned og = xb_add(&bar[XB_TOP], 1u);
            const unsigned tg = og / nx;
            if (og + 1u == (tg + 1u) * nx) xb_add(&bar[XB_TOPGEN], 1u);
            else XB_SPIN(xb_ld(&bar[XB_TOPGEN]) == tg, bar);
            __builtin_amdgcn_fence(__ATOMIC_ACQUIRE, "agent");
            xb_add(&bar[XB_XGEN(b.x)], 1u);
            asm volatile("s_waitcnt vmcnt(0)" ::: "memory");
        } else {
            XB_SPIN(xb_ld(&bar[XB_XGEN(b.x)]) == gen, bar);
            __builtin_amdgcn_fence(__ATOMIC_ACQUIRE, "agent");
            asm volatile("s_waitcnt vmcnt(0)" ::: "memory");
        }
    }
    __syncthreads();
}

__device__ __forceinline__ float wave_sum(float v) {
#pragma unroll
    for (int o = 1; o < 64; o <<= 1) v += __shfl_xor(v, o);
    return v;
}
__device__ __forceinline__ float wave_max(float v) {
#pragma unroll
    for (int o = 1; o < 64; o <<= 1) v = fmaxf(v, __shfl_xor(v, o));
    return v;
}
__device__ __forceinline__ void sincos_d(double a, double& s, double& c) {
    const double TWO_PI_HI = 6.283185307179586232, TWO_PI_LO = 2.4492935982947064e-16;
    const double k = rint(a / TWO_PI_HI);
    double r = (a - k * TWO_PI_HI) - k * TWO_PI_LO;
    const double r2 = r * r;
    double ts = 1.0, tc = 1.0;
#pragma unroll
    for (int n = 16; n >= 1; --n) {
        ts = 1.0 - ts * r2 / (double)((2 * n) * (2 * n + 1));
        tc = 1.0 - tc * r2 / (double)((2 * n - 1) * (2 * n));
    }
    s = r * ts; c = tc;
}
__constant__ double INV_FREQ[8] = {1.0, 0.19392274474868576, 0.03760603093086393, 0.007292664737217109,
                                   0.001414213562373095, 0.0002742481756762073, 5.318295896944988e-05, 1.031338537721246e-05};

namespace g8 {
typedef unsigned short bf16_t;
typedef short bf16x8 __attribute__((ext_vector_type(8)));
typedef unsigned u32x4 __attribute__((ext_vector_type(4)));
typedef unsigned u32x2 __attribute__((ext_vector_type(2)));
typedef int i32x4 __attribute__((ext_vector_type(4)));
constexpr int BM = 256, BK = 64, HALF = 128, HTB = HALF * BK * 2, STAGE_BYTES = 8 * HTB, NXCD = 8, WGM = 8;
__host__ __device__ __forceinline__ int lds_byte(int r, int c) { const int st = (r >> 4) * 2 + (c >> 5), rr = r & 15, cc = c & 31, ob = rr * 64 + cc * 2; return st * 1024 + (ob ^ (((ob >> 9) & 1) << 5)); }
__host__ __device__ __forceinline__ void stage_rc(int b, int& R, int& C) { const int st = b / 1024, sb = b % 1024, swz = sb ^ (((sb >> 9) & 1) << 5); R = (st >> 1) * 16 + swz / 64; C = (st & 1) * 32 + (swz % 64) / 2; }
__host__ __device__ __forceinline__ int perm32(int rho) { const int n = rho >> 4, i = rho & 15; return 8 * (i >> 2) + 4 * n + (i & 3); }
__device__ __forceinline__ unsigned cvt_pk_bf16(float lo, float hi) { unsigned r; asm volatile("v_cvt_pk_bf16_f32 %0, %1, %2" : "=v"(r) : "v"(lo), "v"(hi)); return r; }

struct Unit { int arow0, nrows, acol0, orow0, ocol0, aux; size_t boff; };

struct DenseOrder {
    int nM, nN, nwg, G, c, ldb, nr = 0; bool rev = false;
    __device__ void init(int M, int N, int ldb_, int G_, int c_) { nM = M / BM; nN = N / BM; nwg = nM * nN; G = G_; c = c_; ldb = ldb_; nr = (nwg - c + G - 1) / G; }
    __device__ bool tile(int i, int& pm, int& pn) const {
        if ((long)i * G + c >= nwg) return false;
        const long L = (long)(rev ? nr - 1 - i : i) * G + c;
        int wgid = (int)L; { const int q = nwg / NXCD, r = nwg % NXCD, xcd = wgid % NXCD, off = wgid / NXCD; wgid = (xcd < r ? xcd * (q + 1) : r * (q + 1) + (xcd - r) * q) + off; }
        const int nig = WGM * nN, gid = wgid / nig, fm = gid * WGM, gsz = (nM - fm) < WGM ? (nM - fm) : WGM;
        pm = fm + ((wgid % nig) % gsz); pn = (wgid % nig) / gsz; return true;
    }
    __device__ bool next(int i, Unit& u) const { int pm, pn; if (!tile(i, pm, pn)) return false;
        u.arow0 = pm * BM; u.nrows = BM; u.acol0 = 0; u.orow0 = pm * BM; u.ocol0 = pn * BM; u.aux = 0; u.boff = (size_t)pn * BM * ldb; return true; }
};
struct MoeOrder {
    const LAS int* goff; int nct, G, c, ldb;
    mutable int e_ = 0, base_ = 0, lo_ = -1, hi_ = 0;
    __device__ __forceinline__ int g(int e) const { return __builtin_amdgcn_readfirstlane(goff[e]); }
    __device__ bool next(int i, Unit& u) const {
        const int L = i * G + c;
        if (lo_ < 0) { lo_ = g(0); hi_ = g(1); }
        for (;;) { if (e_ >= 32) return false; const int n = ((hi_ - lo_ + 255) >> 8) * nct; if (L < base_ + n) break; base_ += n; ++e_; lo_ = hi_; hi_ = e_ < 32 ? g(e_ + 1) : hi_; }
        const int li = L - base_, rt = li / nct, ct = li - rt * nct;
        u.arow0 = lo_ + rt * BM; u.nrows = min(BM, hi_ - u.arow0); u.acol0 = 0; u.orow0 = u.arow0; u.ocol0 = ct * BM; u.aux = e_;
        u.boff = ((size_t)e_ * nct + ct) * BM * ldb; return true; }
};

__device__ __forceinline__ f32x4 mma_bf16(bf16x8 b, bf16x8 a, f32x4 c) { return __builtin_amdgcn_mfma_f32_16x16x32_bf16(b, a, c, 0, 0, 0); }
__device__ __forceinline__ i32x4 mma_bf16(bf16x8, bf16x8, i32x4 c) { return c; }
__device__ __forceinline__ i32x4 mma_i8(bf16x8 b, bf16x8 a, i32x4 c) { return __builtin_amdgcn_mfma_i32_16x16x64_i8(__builtin_bit_cast(i32x4, b), __builtin_bit_cast(i32x4, a), c, 0, 0, 0); }
__device__ __forceinline__ f32x4 mma_i8(bf16x8, bf16x8, f32x4 c) { return c; }
typedef int i32x8 __attribute__((ext_vector_type(8)));
__device__ __forceinline__ f32x4 mma_f8(i32x8 b, i32x8 a, f32x4 c) { const int one = 127; asm volatile("v_mfma_scale_f32_16x16x128_f8f6f4 %0, %1, %2, %0, %3, %3 op_sel_hi:[0,0,0]" : "+v"(c) : "v"(b), "v"(a), "v"(one)); return c; }
__device__ __forceinline__ i32x4 mma_f8(i32x8, i32x8, i32x4 c) { return c; }
template <class Epi, class Sched, bool GATHER>
__device__ __forceinline__ void gemm_phase(LAS unsigned char* lds, const bf16_t* A, int lda, const bf16_t* Bt, int ldb, int K, const int* list, const Sched& S, const Epi& E) {
    int tid_ = threadIdx.x; asm volatile("" : "+v"(tid_));
    const int tid = tid_, wid = __builtin_amdgcn_readfirstlane(tid >> 6), lane = tid & 63, wr = wid >> 2, wc = wid & 3, fr = lane & 15, fq = lane >> 4;
    const int nt = K / BK;
    unsigned voffB[2];
#pragma unroll
    for (int i = 0; i < 2; ++i) { int R, C; stage_rc(tid * 16 + i * 8192, R, C); const int Rb = 64 * (R >> 5) + (Epi::PERM ? perm32(R & 31) : (R & 31));   voffB[i] = (unsigned)(Rb * ldb + C) * 2u; }
    const size_t kstep = (size_t)(BK * 2);
    const size_t hstepB = (size_t)32 * ldb * 2;
    const unsigned ldsw = (unsigned)wid * 1024u;
    const int aoff = lds_byte(wr * 64 + fr, fq * 8), boff = lds_byte(wc * 32 + fr, fq * 8);
#define G8_MKRAW(V, U) do { _Pragma("unroll") for (int _h = 0; _h < 2; ++_h) _Pragma("unroll") for (int _i = 0; _i < 2; ++_i) { int _R, _C; stage_rc(tid * 16 + _i * 8192, _R, _C); int _r = 128 * _h + _R; _r = _r < (U).nrows ? _r : (U).nrows - 1; \
            V[_h][_i] = GATHER ? (unsigned)list[(U).arow0 + _r] : (unsigned)((U).arow0 + _r); } } while (0)
#define G8_MKCONV(V, U) do { _Pragma("unroll") for (int _h = 0; _h < 2; ++_h) _Pragma("unroll") for (int _i = 0; _i < 2; ++_i) { int _R, _C; stage_rc(tid * 16 + _i * 8192, _R, _C); V[_h][_i] = (V[_h][_i] * (unsigned)lda + (unsigned)((U).acol0 + _C)) * 2u; } } while (0)
#define G8_MKOFF(V, U) do { G8_MKRAW(V, U); G8_MKCONV(V, U); } while (0)
#define G8_SA(b, h) (((b) * 2 + (h)) * HTB)
#define G8_SB(b, h) ((4 + (b) * 2 + (h)) * HTB)
#define G8_STAGE_B(bufoff, gbase) do { _Pragma("unroll") for (int _i = 0; _i < 2; ++_i) \
        __builtin_amdgcn_global_load_lds((const unsigned*)((const char*)(gbase) + voffB[_i]), (LAS unsigned*)(lds + (bufoff) + ldsw + _i * 8192), 16, 0, 0); } while (0)
#define G8_STAGE_A(bufoff, kb, V, h) do { _Pragma("unroll") for (int _i = 0; _i < 2; ++_i) \
        __builtin_amdgcn_global_load_lds((const unsigned*)((const char*)A + (kb) + V[h][_i]), (LAS unsigned*)(lds + (bufoff) + ldsw + _i * 8192), 16, 0, 0); } while (0)
#define G8_STAGE_A2(bufoff, kb, h) do { _Pragma("unroll") for (int _i = 0; _i < 2; ++_i) \
        __builtin_amdgcn_global_load_lds((const unsigned*)((const char*)A + (kb) + (last ? vN[h][_i] : vC[h][_i])), (LAS unsigned*)(lds + (bufoff) + ldsw + _i * 8192), 16, 0, 0); } while (0)
#define G8_LDA(dst, b, h) do { if constexpr (Epi::F8) { _Pragma("unroll") for (int m = 0; m < 4; ++m) { const i32x4 _l = *(const LAS i32x4*)(lds + G8_SA(b, h) + aoff + m * 2048), _h = *(const LAS i32x4*)(lds + G8_SA(b, h) + aoff + m * 2048 + 1024); dst##8[m] = __builtin_shufflevector(_l, _h, 0, 1, 2, 3, 4, 5, 6, 7); } } \
        else { _Pragma("unroll") for (int m = 0; m < 4; ++m) _Pragma("unroll") for (int k = 0; k < 2; ++k) dst[m][k] = *(const LAS bf16x8*)(lds + G8_SA(b, h) + aoff + m * 2048 + k * 1024); } } while (0)
#define G8_LDB(dst, b, h) do { if constexpr (Epi::F8) { _Pragma("unroll") for (int n = 0; n < 2; ++n) { const i32x4 _l = *(const LAS i32x4*)(lds + G8_SB(b, h) + boff + n * 2048), _h = *(const LAS i32x4*)(lds + G8_SB(b, h) + boff + n * 2048 + 1024); dst##8[n] = __builtin_shufflevector(_l, _h, 0, 1, 2, 3, 4, 5, 6, 7); } } \
        else { _Pragma("unroll") for (int n = 0; n < 2; ++n) _Pragma("unroll") for (int k = 0; k < 2; ++k) dst[n][k] = *(const LAS bf16x8*)(lds + G8_SB(b, h) + boff + n * 2048 + k * 1024); } } while (0)
#define G8_MMA(ai, bj, At, Bt_) do { __builtin_amdgcn_s_setprio(1); _Pragma("unroll") for (int m = 0; m < 4; ++m) _Pragma("unroll") for (int n = 0; n < 2; ++n) { \
        if constexpr (Epi::F8) acc[ai][bj][m][n] = mma_f8(Bt_##8[n], At##8[m], acc[ai][bj][m][n]); \
        else { _Pragma("unroll") for (int k = 0; k < 2; ++k) { if constexpr (Epi::I8) acc[ai][bj][m][n] = mma_i8(Bt_[n][k], At[m][k], acc[ai][bj][m][n]); else acc[ai][bj][m][n] = mma_bf16(Bt_[n][k], At[m][k], acc[ai][bj][m][n]); } } } \
        __builtin_amdgcn_s_setprio(0); } while (0)
#define G8_WAIT_V(n) asm volatile("s_waitcnt vmcnt(" #n ")" ::: "memory")
#define G8_WAIT_L(n) asm volatile("s_waitcnt lgkmcnt(" #n ")" ::: "memory")
#define G8_BAR __builtin_amdgcn_s_barrier()
#define G8_SCHED __builtin_amdgcn_sched_barrier(0)
    Unit cur, nxt; int ui = 0;
    if (!S.next(0, cur)) return;
    typedef typename Epi::acc_t acc_t;
    acc_t acc[2][2][4][2];
#pragma unroll
    for (int a = 0; a < 2; ++a)
#pragma unroll
        for (int b = 0; b < 2; ++b)
#pragma unroll
            for (int m = 0; m < 4; ++m)
#pragma unroll
                for (int n = 0; n < 2; ++n) acc[a][b][m][n] = (acc_t){0, 0, 0, 0};
    bf16x8 At[4][2], B0[2][2], B1[2][2];
    i32x8 At8[4], B08[2], B18[2];
    (void)At; (void)B0; (void)B1; (void)At8; (void)B08; (void)B18;
    unsigned vC[2][2], vN[2][2];
    G8_MKOFF(vC, cur);
    const char* cB = (const char*)Bt + cur.boff * 2;
    G8_STAGE_B(G8_SB(0, 0), cB); G8_STAGE_B(G8_SB(0, 1), cB + hstepB); G8_STAGE_A(G8_SA(0, 0), 0, vC, 0); G8_STAGE_A(G8_SA(0, 1), 0, vC, 1);
    if (wr == 1) G8_BAR;
    G8_WAIT_V(2); G8_BAR;
    G8_STAGE_B(G8_SB(1, 0), cB + kstep); G8_STAGE_A(G8_SA(1, 0), kstep, vC, 0); G8_STAGE_B(G8_SB(1, 1), cB + hstepB + kstep);
    G8_WAIT_V(6); G8_BAR;
    for (;;) {
        const bool has_next = S.next(ui + 1, nxt);
        const int tconv = (GATHER && nt > 2) ? 2 : 0;
        if (has_next) { if (GATHER) { G8_MKRAW(vN, nxt); } else { G8_MKOFF(vN, nxt); } } else {
#pragma unroll
            for (int h = 0; h < 2; ++h)
#pragma unroll
                for (int i = 0; i < 2; ++i) vN[h][i] = vC[h][i]; }
        const char* nB = has_next ? (const char*)Bt + nxt.boff * 2 : cB;
        for (int t = 0; t < nt; t += 2) {
            const bool last = (t == nt - 2);
            const size_t kb1 = (size_t)(t + 1) * kstep;
            const size_t kb2 = last ? 0 : (size_t)(t + 2) * kstep, kb3 = kb2 + kstep;
            const char* b2 = last ? nB : cB + (size_t)(t + 2) * kstep; const char* b3 = b2 + kstep;
            G8_LDB(B0, 0, 0); G8_LDB(B1, 0, 1); G8_SCHED; G8_LDA(At, 0, 0); G8_STAGE_A(G8_SA(1, 1), kb1, vC, 1);
            if (GATHER) { if (t == tconv && has_next) { G8_MKCONV(vN, nxt); } }
            G8_WAIT_V(8); G8_WAIT_L(0); G8_BAR; G8_MMA(0, 0, At, B0); G8_MMA(0, 1, At, B1); G8_BAR; G8_SCHED;
            G8_LDA(At, 0, 1); G8_STAGE_B(G8_SB(0, 0), b2); G8_STAGE_B(G8_SB(0, 1), b2 + hstepB); G8_STAGE_A2(G8_SA(0, 0), kb2, 0);
            G8_WAIT_V(8); G8_WAIT_L(0); G8_BAR; G8_MMA(1, 0, At, B0); G8_MMA(1, 1, At, B1); G8_BAR; G8_SCHED;
            G8_LDB(B0, 1, 0); G8_LDB(B1, 1, 1); G8_SCHED; G8_LDA(At, 1, 0); G8_STAGE_A2(G8_SA(0, 1), kb2, 1);
            G8_WAIT_V(8); G8_WAIT_L(0); G8_BAR; G8_MMA(0, 0, At, B0); G8_MMA(0, 1, At, B1); G8_BAR; G8_SCHED;
            G8_LDA(At, 1, 1); G8_STAGE_B(G8_SB(1, 0), b3); G8_STAGE_B(G8_SB(1, 1), b3 + hstepB); G8_STAGE_A2(G8_SA(1, 0), kb3, 0);
            G8_WAIT_V(8); G8_WAIT_L(0); G8_BAR; G8_MMA(1, 0, At, B0); G8_MMA(1, 1, At, B1); G8_BAR; G8_SCHED;
        }
        if (wr == 0) G8_BAR;
        if constexpr (Epi::F8) asm volatile("s_nop 15\n\ts_nop 7" ::: "memory");
        E(acc, cur, wr, wc, fr, fq);
        if (!has_next) break;
#pragma unroll
        for (int a = 0; a < 2; ++a)
#pragma unroll
            for (int b = 0; b < 2; ++b)
#pragma unroll
                for (int m = 0; m < 4; ++m)
#pragma unroll
                    for (int n = 0; n < 2; ++n) acc[a][b][m][n] = (acc_t){0, 0, 0, 0};
        cur = nxt; cB = nB; ++ui;
#pragma unroll
        for (int h = 0; h < 2; ++h)
#pragma unroll
            for (int i = 0; i < 2; ++i) vC[h][i] = vN[h][i];
        if (wr == 1) G8_BAR;
    }
    G8_WAIT_V(0);
    G8_BAR;
#undef G8_MKOFF
#undef G8_MKRAW
#undef G8_MKCONV
#undef G8_SA
#undef G8_SB
#undef G8_STAGE_A
#undef G8_STAGE_A2
#undef G8_STAGE_B
#undef G8_LDA
#undef G8_LDB
#undef G8_MMA
#undef G8_WAIT_V
#undef G8_WAIT_L
#undef G8_BAR
#undef G8_SCHED
}

constexpr float HID_SCALE = 4.0f, W2_SCALE = 64.0f;
__device__ __forceinline__ void store_rows128(LAS unsigned char* stg, bf16_t* gp  , size_t ldc, u32x4 p0, u32x4 p1, int fr, int fq, int nvalid) {
    const int sw = fr & 7, lane = fr + 16 * fq, r0 = lane >> 3, c = lane & 7;
    *(LAS u32x4*)(stg + fr * 128 + ((fq ^ sw) << 4)) = p0;
    *(LAS u32x4*)(stg + fr * 128 + (((4 + fq) ^ sw) << 4)) = p1;
    const u32x4 o0 = *(const LAS u32x4*)(stg + r0 * 128 + ((c ^ (r0 & 7)) << 4)), o1 = *(const LAS u32x4*)(stg + (8 + r0) * 128 + ((c ^ (r0 & 7)) << 4));
    if (r0 < nvalid) *(u32x4*)(gp + (size_t)r0 * ldc + c * 8) = o0;
    if (8 + r0 < nvalid) *(u32x4*)(gp + (size_t)(8 + r0) * ldc + c * 8) = o1;
}
__device__ __forceinline__ float swiglu_f(float g, float l) {
    g = fminf(g, 7.0f); l = fminf(fmaxf(l, -7.0f), 7.0f);
    return g * __builtin_amdgcn_rcpf(1.0f + __expf(-1.702f * g)) * (l + 1.0f);
}
struct EpiSwigluB { typedef f32x4 acc_t; static constexpr bool I8 = false, F8 = false; static constexpr bool PERM = true;
    bf16_t* H; const float* b1;
    __device__ __forceinline__ void operator()(const f32x4 (&acc)[2][2][4][2], const Unit& u, int wr, int wc, int fr, int fq) const {
        const int col0 = u.ocol0 + wc * 64 + 8 * fq; const float* bp = b1 + (size_t)u.aux * 2048 + col0;
        f32x4 bv[2][2];
#pragma unroll
        for (int bj = 0; bj < 2; ++bj)
#pragma unroll
            for (int n = 0; n < 2; ++n) bv[bj][n] = *(const f32x4*)(bp + bj * 32 + 4 * n);
#pragma unroll
        for (int ai = 0; ai < 2; ++ai)
#pragma unroll
            for (int m = 0; m < 4; ++m) { const int r = ai * HALF + wr * 64 + m * 16 + fr; if (r < u.nrows) { bf16_t* rowp = H + (size_t)(u.orow0 + r) * 1024 + (col0 >> 1);
#pragma unroll
                for (int bj = 0; bj < 2; ++bj) { const f32x4 v0 = acc[ai][bj][m][0] + bv[bj][0], v1 = acc[ai][bj][m][1] + bv[bj][1];
                    u32x2 w; w.x = cvt_pk_bf16(swiglu_f(v0[0], v0[1]), swiglu_f(v0[2], v0[3])); w.y = cvt_pk_bf16(swiglu_f(v1[0], v1[1]), swiglu_f(v1[2], v1[3]));
                    *(u32x2*)(rowp + bj * 16) = w; } } }
    }
};
struct EpiSwigluI8 { typedef i32x4 acc_t; static constexpr bool I8 = true, F8 = false; static constexpr bool PERM = true;
    unsigned char* H; const float* b1; const float* sa; const float* sb;
    typedef float f2 __attribute__((ext_vector_type(2)));
    static __device__ __forceinline__ f2 swiglu2(f2 g, f2 l) {
        g.x = fminf(g.x, 7.0f); g.y = fminf(g.y, 7.0f); l.x = fminf(fmaxf(l.x, -7.0f), 7.0f); l.y = fminf(fmaxf(l.y, -7.0f), 7.0f);
        f2 t = g * (-1.702f * 1.4426950408889634f); t.x = __builtin_amdgcn_exp2f(t.x); t.y = __builtin_amdgcn_exp2f(t.y); t = t + 1.0f;
        f2 r; r.x = __builtin_amdgcn_rcpf(t.x); r.y = __builtin_amdgcn_rcpf(t.y);
        return (g * r) * (l * HID_SCALE + HID_SCALE); }
    __device__ __forceinline__ void operator()(const i32x4 (&acc)[2][2][4][2], const Unit& u, int wr, int wc, int fr, int fq) const {
        const int col0 = u.ocol0 + wc * 64 + 8 * fq; const float* bp = b1 + (size_t)u.aux * 2048 + col0; const float* sp = sb + (size_t)u.aux * 2048 + col0;
        f32x4 bv[2][2], sv[2][2]; float av[2][4];
#pragma unroll
        for (int bj = 0; bj < 2; ++bj)
#pragma unroll
            for (int n = 0; n < 2; ++n) { bv[bj][n] = *(const f32x4*)(bp + bj * 32 + 4 * n); sv[bj][n] = *(const f32x4*)(sp + bj * 32 + 4 * n); }
#pragma unroll
        for (int ai = 0; ai < 2; ++ai)
#pragma unroll
            for (int m = 0; m < 4; ++m) { const int r = ai * HALF + wr * 64 + m * 16 + fr; av[ai][m] = sa[u.orow0 + (r < u.nrows ? r : u.nrows - 1)]; }
#pragma unroll
        for (int ai = 0; ai < 2; ++ai) asm volatile("" : "+v"(av[ai][0]), "+v"(av[ai][1]), "+v"(av[ai][2]), "+v"(av[ai][3]));
#pragma unroll
        for (int ai = 0; ai < 2; ++ai)
#pragma unroll
            for (int m = 0; m < 4; ++m) { const int r = ai * HALF + wr * 64 + m * 16 + fr; if (r < u.nrows) { unsigned char* rowp = H + (size_t)(u.orow0 + r) * 1024 + (col0 >> 1); const float a = av[ai][m];
#pragma unroll
                for (int bj = 0; bj < 2; ++bj) { f32x4 c0, c1;
#pragma unroll
                    for (int q = 0; q < 4; ++q) { c0[q] = (float)acc[ai][bj][m][0][q]; c1[q] = (float)acc[ai][bj][m][1][q]; }
                    const f32x4 v0 = c0 * (sv[bj][0] * a) + bv[bj][0], v1 = c1 * (sv[bj][1] * a) + bv[bj][1];
                    const f2 h0 = swiglu2((f2){v0[0], v0[2]}, (f2){v0[1], v0[3]}), h1 = swiglu2((f2){v1[0], v1[2]}, (f2){v1[1], v1[3]});
                    unsigned w = 0u; w = __builtin_amdgcn_cvt_pk_fp8_f32(h0.x, h0.y, w, false); w = __builtin_amdgcn_cvt_pk_fp8_f32(h1.x, h1.y, w, true);
                    *(unsigned*)(rowp + bj * 16) = w; } } }
    }
};
struct EpiMoe2B { typedef f32x4 acc_t; static constexpr bool I8 = false, F8 = false; static constexpr bool PERM = true;
    bf16_t* O; const float* b2; const float* wpos;
    __device__ __forceinline__ void operator()(const f32x4 (&acc)[2][2][4][2], const Unit& u, int wr, int wc, int fr, int fq) const {
        const int col0 = u.ocol0 + wc * 64 + 8 * fq; const float* bp = b2 + (size_t)u.aux * 1024 + col0;
        f32x4 bv[2][2];
#pragma unroll
        for (int bj = 0; bj < 2; ++bj)
#pragma unroll
            for (int n = 0; n < 2; ++n) bv[bj][n] = *(const f32x4*)(bp + bj * 32 + 4 * n);
        float wv[2][4];
#pragma unroll
        for (int ai = 0; ai < 2; ++ai)
#pragma unroll
            for (int m = 0; m < 4; ++m) { const int r = ai * HALF + wr * 64 + m * 16 + fr; wv[ai][m] = wpos[u.orow0 + (r < u.nrows ? r : u.nrows - 1)]; }
#pragma unroll
        for (int ai = 0; ai < 2; ++ai) asm volatile("" : "+v"(wv[ai][0]), "+v"(wv[ai][1]), "+v"(wv[ai][2]), "+v"(wv[ai][3]));
#pragma unroll
        for (int ai = 0; ai < 2; ++ai)
#pragma unroll
            for (int m = 0; m < 4; ++m) { const int r = ai * HALF + wr * 64 + m * 16 + fr; if (r < u.nrows) { const float w = wv[ai][m]; bf16_t* rowp = O + (size_t)(u.orow0 + r) * 1024 + col0;
#pragma unroll
                for (int bj = 0; bj < 2; ++bj) { const f32x4 v0 = (acc[ai][bj][m][0] + bv[bj][0]) * w, v1 = (acc[ai][bj][m][1] + bv[bj][1]) * w;
                    u32x4 o; o.x = cvt_pk_bf16(v0[0], v0[1]); o.y = cvt_pk_bf16(v0[2], v0[3]); o.z = cvt_pk_bf16(v1[0], v1[1]); o.w = cvt_pk_bf16(v1[2], v1[3]);
                    *(u32x4*)(rowp + bj * 32) = o; } } }
    }
};

struct BatchOrder : DenseOrder { int bbatch_rows;
    __device__ bool next(int i, Unit& u) const { int pm, pn; if (!tile(i, pm, pn)) return false;
        u.arow0 = pm * BM; u.nrows = BM; u.acol0 = 0; u.orow0 = pm * BM; u.ocol0 = pn * BM; u.aux = 0; u.boff = ((size_t)(pm >> 3) * bbatch_rows + (size_t)pn * BM) * ldb; return true; } };
struct GtOrder { int G, c;
    __device__ bool next(int i, Unit& u) const { const int L = i * G + c; if (L >= 512) return false; const int h = L >> 7, b = (L >> 2) & 31, pn = L & 3;
        u.arow0 = b * 256; u.nrows = 256; u.acol0 = h * 256; u.boff = (size_t)pn * 256 * 1024 + h * 256; u.orow0 = b * 1024 + h * 256; u.ocol0 = pn * 256; u.aux = 0; return true; } };
struct VwtOrder { int G, c;
    __device__ bool next(int i, Unit& u) const { const int L = i * G + c; if (L >= 512) return false; const int b = L >> 4, h = (L >> 2) & 3, pm = L & 3;
        u.arow0 = pm * 256; u.nrows = 256; u.acol0 = h * 256; u.boff = (size_t)(b * 256) * 2048 + 1024 + h * 256; u.orow0 = b * 1024 + pm * 256; u.ocol0 = h * 256; u.aux = 0; return true; } };

struct EpiMoe2F8 { typedef f32x4 acc_t; static constexpr bool I8 = false, F8 = true; static constexpr bool PERM = true;
    bf16_t* O; const float* b2; const float* wpos; LAS unsigned char* stg;
    __device__ __forceinline__ void operator()(const f32x4 (&acc)[2][2][4][2], const Unit& u, int wr, int wc, int fr, int fq) const {
        const int col0 = u.ocol0 + wc * 64 + 8 * fq; const float* bp = b2 + (size_t)u.aux * 1024 + col0; const float is = 1.0f / (HID_SCALE * W2_SCALE);
        f32x4 bv[2][2];
#pragma unroll
        for (int bj = 0; bj < 2; ++bj)
#pragma unroll
            for (int n = 0; n < 2; ++n) bv[bj][n] = *(const f32x4*)(bp + bj * 32 + 4 * n);
        float wv[2][4];
#pragma unroll
        for (int ai = 0; ai < 2; ++ai)
#pragma unroll
            for (int m = 0; m < 4; ++m) { const int r = ai * HALF + wr * 64 + m * 16 + fr; wv[ai][m] = wpos[u.orow0 + (r < u.nrows ? r : u.nrows - 1)]; }
#pragma unroll
        for (int ai = 0; ai < 2; ++ai) asm volatile("" : "+v"(wv[ai][0]), "+v"(wv[ai][1]), "+v"(wv[ai][2]), "+v"(wv[ai][3]));
        LAS unsigned char* sw_ = stg + (wr * 4 + wc) * 2048;
#pragma unroll
        for (int ai = 0; ai < 2; ++ai)
#pragma unroll
            for (int m = 0; m < 4; ++m) { const int rg = ai * HALF + wr * 64 + m * 16; const float w = wv[ai][m]; u32x4 o[2];
#pragma unroll
                for (int bj = 0; bj < 2; ++bj) { const f32x4 v0 = (acc[ai][bj][m][0] * is + bv[bj][0]) * w, v1 = (acc[ai][bj][m][1] * is + bv[bj][1]) * w;
                    o[bj].x = cvt_pk_bf16(v0[0], v0[1]); o[bj].y = cvt_pk_bf16(v0[2], v0[3]); o[bj].z = cvt_pk_bf16(v1[0], v1[1]); o[bj].w = cvt_pk_bf16(v1[2], v1[3]); }
                store_rows128(sw_, O + (size_t)(u.orow0 + rg) * 1024 + u.ocol0 + wc * 64, 1024, o[0], o[1], fr, fq, u.nrows - rg); }
    }
};
struct EpiProj { typedef i32x4 acc_t; static constexpr bool I8 = true, F8 = false; static constexpr bool PERM = true;
    bf16_t* O; const float* ropec; const float* ropes; LAS unsigned char* stg; const float* sx; const float* sw; LAS unsigned char* tab;
    __device__ __forceinline__ void operator()(const i32x4 (&acc)[2][2][4][2], const Unit& u, int wr, int wc, int fr, int fq) const {
        const int region = u.ocol0 >> 9;
        const bool rope = (region != 2 && region != 5);
        const float sc = (region == 0 || region == 3) ? C2Q : 1.0f;
        const float sg = (fq == 0) ? -1.0f : 1.0f;
        const int tid = (wr * 4 + wc) * 64 + fr + 16 * fq;
        f32x4 swv[2][2]; float sxv[2][4];
#pragma unroll
        for (int bj = 0; bj < 2; ++bj)
#pragma unroll
            for (int n = 0; n < 2; ++n) swv[bj][n] = *(const f32x4*)(sw + u.ocol0 + wc * 64 + 8 * fq + bj * 32 + 4 * n) * sc;
#pragma unroll
        for (int ai = 0; ai < 2; ++ai)
#pragma unroll
            for (int m = 0; m < 4; ++m) sxv[ai][m] = sx[u.orow0 + ai * HALF + wr * 64 + m * 16 + fr];
#pragma unroll
        for (int ai = 0; ai < 2; ++ai) {
            if (rope) { const int trow = tid >> 2, tq = tid & 3, pos = (u.orow0 + ai * HALF + trow) & (SEQ - 1);
                const f32x4 tv = *(const f32x4*)((tq < 2 ? ropec : ropes) + pos * 8 + (tq & 1) * 4);
                *(LAS f32x4*)(tab + trow * 64 + tq * 16) = tv;
                asm volatile("s_waitcnt lgkmcnt(0)" ::: "memory"); __builtin_amdgcn_s_barrier(); asm volatile("" ::: "memory"); }
#pragma unroll
            for (int m = 0; m < 4; ++m) { f32x4 cs[4]; const float sxr_ = sxv[ai][m];
                if (rope) { const LAS unsigned char* tp = tab + (wr * 64 + m * 16 + fr) * 64;
                    cs[0] = *(const LAS f32x4*)(tp); cs[1] = *(const LAS f32x4*)(tp + 16); cs[2] = *(const LAS f32x4*)(tp + 32); cs[3] = *(const LAS f32x4*)(tp + 48); }
                u32x4 w[2];
#pragma unroll
                for (int bj = 0; bj < 2; ++bj) { f32x4 v0, v1;
#pragma unroll
                    for (int q = 0; q < 4; ++q) { v0[q] = (float)acc[ai][bj][m][0][q]; v1[q] = (float)acc[ai][bj][m][1][q]; }
                    v0 = v0 * (swv[bj][0] * sxr_); v1 = v1 * (swv[bj][1] * sxr_);
                    if (rope && bj == 0) { f32x4 p0, p1;
#pragma unroll
                        for (int e = 0; e < 4; ++e) { p0[e] = __shfl_xor(v0[e], 16); p1[e] = __shfl_xor(v1[e], 16); }
                        if (fq < 2) { v0 = v0 * cs[0] + p0 * (cs[2] * sg); v1 = v1 * cs[1] + p1 * (cs[3] * sg); } }
                    w[bj].x = cvt_pk_bf16(v0[0], v0[1]); w[bj].y = cvt_pk_bf16(v0[2], v0[3]); w[bj].z = cvt_pk_bf16(v1[0], v1[1]); w[bj].w = cvt_pk_bf16(v1[2], v1[3]); }
                store_rows128(stg + (wr * 4 + wc) * 2048, O + (size_t)(u.orow0 + ai * HALF + wr * 64 + m * 16) * NPROJ + u.ocol0 + wc * 64, (size_t)NPROJ, w[0], w[1], fr, fq, 16); }
            if (rope) { asm volatile("s_waitcnt lgkmcnt(0)" ::: "memory"); __builtin_amdgcn_s_barrier(); asm volatile("" ::: "memory"); }
        }
    }
};
struct EpiPlainB { typedef f32x4 acc_t; static constexpr bool I8 = false, F8 = false; static constexpr bool PERM = true;
    bf16_t* O; int ldc; LAS unsigned char* stg;
    __device__ __forceinline__ void operator()(const f32x4 (&acc)[2][2][4][2], const Unit& u, int wr, int wc, int fr, int fq) const {
        LAS unsigned char* sw_ = stg + (wr * 4 + wc) * 2048;
#pragma unroll
        for (int ai = 0; ai < 2; ++ai)
#pragma unroll
            for (int m = 0; m < 4; ++m) { u32x4 w[2];
#pragma unroll
                for (int bj = 0; bj < 2; ++bj) { const f32x4 v0 = acc[ai][bj][m][0], v1 = acc[ai][bj][m][1];
                    w[bj].x = cvt_pk_bf16(v0[0], v0[1]); w[bj].y = cvt_pk_bf16(v0[2], v0[3]); w[bj].z = cvt_pk_bf16(v1[0], v1[1]); w[bj].w = cvt_pk_bf16(v1[2], v1[3]); }
                store_rows128(sw_, O + (size_t)(u.orow0 + ai * HALF + wr * 64 + m * 16) * ldc + u.ocol0 + wc * 64, (size_t)ldc, w[0], w[1], fr, fq, 16); }
    }
};
struct EpiResidF { typedef f32x4 acc_t; static constexpr bool I8 = false, F8 = false; static constexpr bool PERM = false;
    float* O; const float* R; float alpha;
    __device__ __forceinline__ void operator()(const f32x4 (&acc)[2][2][4][2], const Unit& u, int wr, int wc, int fr, int fq) const {
        const int col0 = u.ocol0 + wc * 64 + 4 * fq;
#pragma unroll
        for (int ai = 0; ai < 2; ++ai) { f32x4 pre[4][2][2];
#pragma unroll
            for (int m = 0; m < 4; ++m) { const size_t off = (size_t)(u.orow0 + ai * HALF + wr * 64 + m * 16 + fr) * 1024 + col0;
#pragma unroll
                for (int bj = 0; bj < 2; ++bj)
#pragma unroll
                    for (int n = 0; n < 2; ++n) pre[m][bj][n] = *(const f32x4*)(R + off + bj * 32 + n * 16); }
#pragma unroll
            for (int m = 0; m < 4; ++m)
#pragma unroll
                for (int bj = 0; bj < 2; ++bj) asm volatile("" : "+v"(pre[m][bj][0]), "+v"(pre[m][bj][1]));
#pragma unroll
            for (int m = 0; m < 4; ++m) { const size_t off = (size_t)(u.orow0 + ai * HALF + wr * 64 + m * 16 + fr) * 1024 + col0;
#pragma unroll
                for (int bj = 0; bj < 2; ++bj)
#pragma unroll
                    for (int n = 0; n < 2; ++n) *(f32x4*)(O + off + bj * 32 + n * 16) = pre[m][bj][n] * alpha + acc[ai][bj][m][n]; }
            asm volatile("" ::: "memory"); }
    }
};
struct EpiResidStats { typedef f32x4 acc_t; static constexpr bool I8 = false, F8 = false; static constexpr bool PERM = false;
    bf16_t* Ob; const float* R; long long* st; float alpha;
    __device__ __forceinline__ void operator()(const f32x4 (&acc)[2][2][4][2], const Unit& u, int wr, int wc, int fr, int fq) const {
        const int col0 = u.ocol0 + wc * 64 + 4 * fq;
#pragma unroll
        for (int ai = 0; ai < 2; ++ai) { f32x4 pre[4][2][2];
#pragma unroll
            for (int m = 0; m < 4; ++m) { const size_t off = (size_t)(u.orow0 + ai * HALF + wr * 64 + m * 16 + fr) * 1024 + col0;
#pragma unroll
                for (int bj = 0; bj < 2; ++bj)
#pragma unroll
                    for (int n = 0; n < 2; ++n) pre[m][bj][n] = __builtin_nontemporal_load((const f32x4*)(R + off + bj * 32 + n * 16)); }
#pragma unroll
            for (int m = 0; m < 4; ++m)
#pragma unroll
                for (int bj = 0; bj < 2; ++bj) asm volatile("" : "+v"(pre[m][bj][0]), "+v"(pre[m][bj][1]));
#pragma unroll
            for (int m = 0; m < 4; ++m) { const int row = u.orow0 + ai * HALF + wr * 64 + m * 16 + fr; const size_t off = (size_t)row * 1024 + col0; float s1 = 0.f, s2 = 0.f;
#pragma unroll
                for (int bj = 0; bj < 2; ++bj)
#pragma unroll
                    for (int n = 0; n < 2; ++n) { const f32x4 v = pre[m][bj][n] * alpha + acc[ai][bj][m][n];
                        u32x2 w; w.x = cvt_pk_bf16(v[0], v[1]); w.y = cvt_pk_bf16(v[2], v[3]); *(u32x2*)(Ob + off + bj * 32 + n * 16) = w;
                        s1 += (v[0] + v[1]) + (v[2] + v[3]); s2 += (v[0] * v[0] + v[1] * v[1]) + (v[2] * v[2] + v[3] * v[3]); }
                s1 += __shfl_xor(s1, 16); s1 += __shfl_xor(s1, 32); s2 += __shfl_xor(s2, 16); s2 += __shfl_xor(s2, 32);
                if (fq == 0) { fx_add(st + 2 * (size_t)row, s1); fx_add(st + 2 * (size_t)row + 1, s2); } }
            asm volatile("" ::: "memory"); }
    }
};
struct EpiResidLN { typedef f32x4 acc_t; static constexpr bool I8 = false, F8 = false; static constexpr bool PERM = false;
    bf16_t* O; const bf16_t* R; const long long* st; const float* g; const float* bb; float alpha;
    __device__ __forceinline__ void operator()(const f32x4 (&acc)[2][2][4][2], const Unit& u, int wr, int wc, int fr, int fq) const {
        const int col0 = u.ocol0 + wc * 64 + 4 * fq;
        f32x4 gv[2][2], bv[2][2];
#pragma unroll
        for (int bj = 0; bj < 2; ++bj)
#pragma unroll
            for (int n = 0; n < 2; ++n) { gv[bj][n] = *(const f32x4*)(g + col0 + bj * 32 + n * 16); bv[bj][n] = *(const f32x4*)(bb + col0 + bj * 32 + n * 16); }
#pragma unroll
        for (int ai = 0; ai < 2; ++ai) { u32x2 pre[4][2][2]; float mu[4], rs[4];
#pragma unroll
            for (int m = 0; m < 4; ++m) { const int row = u.orow0 + ai * HALF + wr * 64 + m * 16 + fr; const size_t off = (size_t)row * 1024 + col0;
                mu[m] = fx_get(st + 2 * (size_t)row); rs[m] = fx_get(st + 2 * (size_t)row + 1);
#pragma unroll
                for (int bj = 0; bj < 2; ++bj)
#pragma unroll
                    for (int n = 0; n < 2; ++n) pre[m][bj][n] = *(const u32x2*)(R + off + bj * 32 + n * 16); }
#pragma unroll
            for (int m = 0; m < 4; ++m) { asm volatile("" : "+v"(mu[m]), "+v"(rs[m]));
#pragma unroll
                for (int bj = 0; bj < 2; ++bj) asm volatile("" : "+v"(pre[m][bj][0]), "+v"(pre[m][bj][1])); }
#pragma unroll
            for (int m = 0; m < 4; ++m) { const size_t off = (size_t)(u.orow0 + ai * HALF + wr * 64 + m * 16 + fr) * 1024 + col0;
                const float mean = mu[m] * (1.0f / 1024.0f), rstd = 1.0f / sqrtf(fmaxf(rs[m] * (1.0f / 1024.0f) - mean * mean, 0.f) + LN_EPS);
#pragma unroll
                for (int bj = 0; bj < 2; ++bj)
#pragma unroll
                    for (int n = 0; n < 2; ++n) { const u32x2 p = pre[m][bj][n]; const f32x4 t = {__uint_as_float(p.x << 16), __uint_as_float(p.x & 0xffff0000u), __uint_as_float(p.y << 16), __uint_as_float(p.y & 0xffff0000u)};
                        const f32x4 v = ((t - mean) * rstd * gv[bj][n] + bv[bj][n]) * alpha + acc[ai][bj][m][n];
                        u32x2 w; w.x = cvt_pk_bf16(v[0], v[1]); w.y = cvt_pk_bf16(v[2], v[3]); *(u32x2*)(O + off + bj * 32 + n * 16) = w; } }
            asm volatile("" ::: "memory"); }
    }
};
struct EpiGT { typedef f32x4 acc_t; static constexpr bool I8 = false, F8 = false; static constexpr bool PERM = true;
    bf16_t* O; const float* g; const float* bb; long long* cs; long long* bfs; LAS unsigned char* stg;
    __device__ __forceinline__ void operator()(const f32x4 (&acc)[2][2][4][2], const Unit& u, int wr, int wc, int fr, int fq) const {
        const int col0 = u.ocol0 + wc * 64 + 8 * fq;
        f32x4 gv[2][2], bv[2][2];
#pragma unroll
        for (int bj = 0; bj < 2; ++bj)
#pragma unroll
            for (int n = 0; n < 2; ++n) { gv[bj][n] = *(const f32x4*)(g + col0 + bj * 32 + 4 * n); bv[bj][n] = *(const f32x4*)(bb + col0 + bj * 32 + 4 * n); }
#pragma unroll
        for (int ai = 0; ai < 2; ++ai)
#pragma unroll
            for (int m = 0; m < 4; ++m) { const int row = u.orow0 + ai * HALF + wr * 64 + m * 16 + fr; float s1 = 0.f, s2 = 0.f; u32x4 wq[2];
#pragma unroll
                for (int bj = 0; bj < 2; ++bj) { const f32x4 a0 = acc[ai][bj][m][0], a1 = acc[ai][bj][m][1]; const f32x4 v0 = a0 * gv[bj][0], v1 = a1 * gv[bj][1], w0 = a0 * bv[bj][0], w1 = a1 * bv[bj][1];
                    wq[bj].x = cvt_pk_bf16(v0[0], v0[1]); wq[bj].y = cvt_pk_bf16(v0[2], v0[3]); wq[bj].z = cvt_pk_bf16(v1[0], v1[1]); wq[bj].w = cvt_pk_bf16(v1[2], v1[3]);
                    s1 += ((v0[0] + v0[1]) + (v0[2] + v0[3])) + ((v1[0] + v1[1]) + (v1[2] + v1[3])); s2 += ((w0[0] + w0[1]) + (w0[2] + w0[3])) + ((w1[0] + w1[1]) + (w1[2] + w1[3])); }
                store_rows128(stg + (wr * 4 + wc) * 2048, O + (size_t)(row - fr) * 1024 + u.ocol0 + wc * 64, 1024, wq[0], wq[1], fr, fq, 16);
                s1 += __shfl_xor(s1, 16); s1 += __shfl_xor(s1, 32); s2 += __shfl_xor(s2, 16); s2 += __shfl_xor(s2, 32);
                if (fq == 0) { fx_add(cs + row, s1); fx_add(bfs + row, s2); } }
    }
};
struct EpiSoftmaxP { typedef f32x4 acc_t; static constexpr bool I8 = false, F8 = false; static constexpr bool PERM = true;
    bf16_t* O; LAS unsigned char* xs; LAS unsigned char* stg; const long long* st; const long long* cs; const long long* bfs;
    __device__ __forceinline__ void operator()(const f32x4 (&acc)[2][2][4][2], const Unit& u, int wr, int wc, int fr, int fq) const {
        typedef float f32x2v __attribute__((ext_vector_type(2)));
        LAS f32x2v* X = (LAS f32x2v*)xs;
        f32x4 e[2][4][2][2]; float mw[2][4];
        const int cc0 = (u.orow0 >> 11) * 1024 + u.ocol0 + wc * 64 + 8 * fq;
        f32x4 cv[2][2], fv[2][2]; float mu[2][4], rs[2][4];
#pragma unroll
        for (int bj = 0; bj < 2; ++bj)
#pragma unroll
            for (int n = 0; n < 2; ++n)
#pragma unroll
                for (int q = 0; q < 4; ++q) { cv[bj][n][q] = fx_get(cs + cc0 + bj * 32 + 4 * n + q); fv[bj][n][q] = fx_get(bfs + cc0 + bj * 32 + 4 * n + q); }
#pragma unroll
        for (int ai = 0; ai < 2; ++ai)
#pragma unroll
            for (int m = 0; m < 4; ++m) { const size_t row = (size_t)(u.orow0 + ai * HALF + wr * 64 + m * 16 + fr); mu[ai][m] = fx_get(st + 2 * row); rs[ai][m] = fx_get(st + 2 * row + 1); }
#pragma unroll
        for (int ai = 0; ai < 2; ++ai) asm volatile("" : "+v"(mu[ai][0]), "+v"(mu[ai][1]), "+v"(mu[ai][2]), "+v"(mu[ai][3]), "+v"(rs[ai][0]), "+v"(rs[ai][1]), "+v"(rs[ai][2]), "+v"(rs[ai][3]));
#pragma unroll
        for (int ai = 0; ai < 2; ++ai)
#pragma unroll
            for (int m = 0; m < 4; ++m) { float mx = -INFINITY; const float mean = mu[ai][m] * (1.0f / 1024.0f), rstd = 1.0f / sqrtf(fmaxf(rs[ai][m] * (1.0f / 1024.0f) - mean * mean, 0.f) + LN_EPS);
#pragma unroll
                for (int bj = 0; bj < 2; ++bj)
#pragma unroll
                    for (int n = 0; n < 2; ++n) { const f32x4 v = ((acc[ai][bj][m][n] - cv[bj][n] * mean) * rstd + fv[bj][n]) * C2M; e[ai][m][bj][n] = v; mx = fmaxf(mx, fmaxf(fmaxf(v[0], v[1]), fmaxf(v[2], v[3]))); }
                mx = fmaxf(mx, __shfl_xor(mx, 16)); mx = fmaxf(mx, __shfl_xor(mx, 32)); float sm = 0.f;
#pragma unroll
                for (int bj = 0; bj < 2; ++bj)
#pragma unroll
                    for (int n = 0; n < 2; ++n) { f32x4 v = e[ai][m][bj][n];
#pragma unroll
                        for (int q = 0; q < 4; ++q) { v[q] = __builtin_amdgcn_exp2f(v[q] - mx); sm += v[q]; }
                        e[ai][m][bj][n] = v; }
                sm += __shfl_xor(sm, 16); sm += __shfl_xor(sm, 32); mw[ai][m] = mx;
                if (fq == 0) X[(ai * HALF + wr * 64 + m * 16 + fr) * 4 + wc] = (f32x2v){mx, sm}; }
        asm volatile("s_waitcnt lgkmcnt(0)" ::: "memory"); __builtin_amdgcn_s_barrier(); asm volatile("" ::: "memory");
        int fr_ = fr; asm volatile("" : "+v"(fr_));
        const int col0 = u.ocol0 + wc * 64 + 8 * fq;
#pragma unroll
        for (int ai = 0; ai < 2; ++ai)
#pragma unroll
            for (int m = 0; m < 4; ++m) { const int r = ai * HALF + wr * 64 + m * 16 + fr_;
                const f32x2v a = X[r * 4 + 0], b = X[r * 4 + 1], c = X[r * 4 + 2], d = X[r * 4 + 3];
                const float mt = fmaxf(fmaxf(a.x, b.x), fmaxf(c.x, d.x));
                const float st = a.y * __builtin_amdgcn_exp2f(a.x - mt) + b.y * __builtin_amdgcn_exp2f(b.x - mt) + c.y * __builtin_amdgcn_exp2f(c.x - mt) + d.y * __builtin_amdgcn_exp2f(d.x - mt);
                const float f = __builtin_amdgcn_exp2f(mw[ai][m] - mt) / st;
                u32x4 w[2];
#pragma unroll
                for (int bj = 0; bj < 2; ++bj) { const f32x4 v0 = e[ai][m][bj][0] * f, v1 = e[ai][m][bj][1] * f;
                    w[bj].x = cvt_pk_bf16(v0[0], v0[1]); w[bj].y = cvt_pk_bf16(v0[2], v0[3]); w[bj].z = cvt_pk_bf16(v1[0], v1[1]); w[bj].w = cvt_pk_bf16(v1[2], v1[3]); }
                store_rows128(stg + (wr * 4 + wc) * 2048, O + (size_t)(u.orow0 + r - fr) * 1024 + u.ocol0 + wc * 64, 1024, w[0], w[1], fr, fq, 16); }
    }
};
}


__device__ __forceinline__ float4 ldnt4(const float* p) { const f32x4 v = __builtin_nontemporal_load((const f32x4*)p); return make_float4(v[0], v[1], v[2], v[3]); }
__device__ __forceinline__ void stnt4(float* p, float4 v) { __builtin_nontemporal_store((f32x4){v.x, v.y, v.z, v.w}, (f32x4*)p); }
__device__ __forceinline__ void transpose_item(const float* W, int K, int N, unsigned short* WT, LAS float* scr, int item, int lane) {
    const int nblk = N / 32, kb = item / nblk, nb = item % nblk, k0 = 64 * kb, n0 = 32 * nb;
#pragma unroll
    for (int i = 0; i < 8; ++i) { const int kk = 8 * i + (lane >> 3); const float4 v = ldnt4(W + (size_t)(k0 + kk) * N + n0 + 4 * (lane & 7));
        LAS float* d = scr + kk * 33 + 4 * (lane & 7); d[0] = v.x; d[1] = v.y; d[2] = v.z; d[3] = v.w; }
    WSYNC();
    const int c = lane & 7;
#pragma unroll
    for (int j = 0; j < 4; ++j) { const int n = (lane >> 3) + 8 * j; const LAS float* sp = scr + (8 * c) * 33 + n;
        g8::u32x4 o; o.x = g8::cvt_pk_bf16(sp[0 * 33], sp[1 * 33]); o.y = g8::cvt_pk_bf16(sp[2 * 33], sp[3 * 33]); o.z = g8::cvt_pk_bf16(sp[4 * 33], sp[5 * 33]); o.w = g8::cvt_pk_bf16(sp[6 * 33], sp[7 * 33]);
        *(g8::u32x4*)(WT + (size_t)(n0 + n) * K + k0 + 8 * c) = o; }
    WSYNC();
}
__device__ __forceinline__ void quant_w1_load(const float* W, int N, int nb, int tid, float4 (&v)[16]) {
    const int lane = tid & 63, wave = tid >> 6, n0 = 32 * nb;
    const float* wp = W + (size_t)(128 * wave + (lane >> 3)) * N + n0 + 4 * (lane & 7);
#pragma unroll
    for (int i = 0; i < 16; ++i) v[i] = ldnt4(wp + (size_t)i * 8 * N);
}
__device__ __forceinline__ void quant_w1_stage(const float4 (&v)[16], LAS float* stage, LAS float* red, int tid) {
    const int lane = tid & 63, wave = tid >> 6;
    float4 m4 = make_float4(0.f, 0.f, 0.f, 0.f);
    LAS float* dp = stage + (128 * wave + (lane >> 3)) * 33 + 4 * (lane & 7);
#pragma unroll
    for (int i = 0; i < 16; ++i) { LAS float* d = dp + i * 8 * 33; d[0] = v[i].x; d[1] = v[i].y; d[2] = v[i].z; d[3] = v[i].w;
        m4.x = fmaxf(m4.x, fabsf(v[i].x)); m4.y = fmaxf(m4.y, fabsf(v[i].y)); m4.z = fmaxf(m4.z, fabsf(v[i].z)); m4.w = fmaxf(m4.w, fabsf(v[i].w)); }
#pragma unroll
    for (int o = 8; o < 64; o <<= 1) { m4.x = fmaxf(m4.x, __shfl_xor(m4.x, o)); m4.y = fmaxf(m4.y, __shfl_xor(m4.y, o)); m4.z = fmaxf(m4.z, __shfl_xor(m4.z, o)); m4.w = fmaxf(m4.w, __shfl_xor(m4.w, o)); }
    if (lane < 8) { LAS float* r = red + wave * 32 + 4 * lane; r[0] = m4.x; r[1] = m4.y; r[2] = m4.z; r[3] = m4.w; }
    __syncthreads();
}
__device__ __forceinline__ void quant_w1_emit(signed char* Q, float* sbo, const LAS float* stage, const LAS float* red, int nb, int tid) {
    const int n0 = 32 * nb, n = tid & 31, kc = tid >> 5;
    float mx = 0.f;
#pragma unroll
    for (int w = 0; w < 8; ++w) mx = fmaxf(mx, red[w * 32 + n]);
    mx = fmaxf(mx, 1e-30f);
    const float iv = 127.0f / mx;
    if (tid < 32) sbo[n0 + tid] = mx * (1.0f / 127.0f);
    const LAS float* sp = stage + (64 * kc) * 33 + n;
#pragma unroll
    for (int j = 0; j < 4; ++j) { g8::u32x4 o;
#pragma unroll
        for (int d = 0; d < 4; ++d) { unsigned w = 0u;
#pragma unroll
            for (int q = 0; q < 4; ++q) w |= ((unsigned)(int)rintf(sp[(16 * j + 4 * d + q) * 33] * iv) & 0xffu) << (8 * q);
            o[d] = w; }
        *(g8::u32x4*)(Q + (size_t)(n0 + n) * 1024 + 64 * kc + 16 * j) = o; }
    __syncthreads();
}
__device__ __forceinline__ void quant_w1_item(const float* W, int N, signed char* Q, float* sbo, LAS float* scr, int nb, int lane) {
    const int n0 = 32 * nb;
    float4 m4 = make_float4(0.f, 0.f, 0.f, 0.f);
    const float* wp = W + (size_t)(lane >> 3) * N + n0 + 4 * (lane & 7);
#pragma unroll 1
    for (int kb = 0; kb < 16; ++kb) {
#pragma unroll
        for (int i = 0; i < 8; ++i) { const float4 v = *(const float4*)(wp + (size_t)i * 8 * N); m4.x = fmaxf(m4.x, fabsf(v.x)); m4.y = fmaxf(m4.y, fabsf(v.y)); m4.z = fmaxf(m4.z, fabsf(v.z)); m4.w = fmaxf(m4.w, fabsf(v.w)); }
        wp += (size_t)64 * N; }
#pragma unroll
    for (int o = 8; o < 64; o <<= 1) { m4.x = fmaxf(m4.x, __shfl_xor(m4.x, o)); m4.y = fmaxf(m4.y, __shfl_xor(m4.y, o)); m4.z = fmaxf(m4.z, __shfl_xor(m4.z, o)); m4.w = fmaxf(m4.w, __shfl_xor(m4.w, o)); }
    float mx; { const int src = (lane & 31) >> 2, cmp = lane & 3; const float a = __shfl(m4.x, src), b = __shfl(m4.y, src), c2 = __shfl(m4.z, src), d = __shfl(m4.w, src); mx = cmp == 0 ? a : cmp == 1 ? b : cmp == 2 ? c2 : d; }
    mx = fmaxf(mx, 1e-30f);
    const float inv = 127.0f / mx;
    if (lane < 32) sbo[n0 + lane] = mx * (1.0f / 127.0f);
    const int c = lane & 7;
    wp = W + (size_t)(lane >> 3) * N + n0 + 4 * (lane & 7);
#pragma unroll 1
    for (int kb = 0; kb < 16; ++kb) { const int k0 = 64 * kb;
#pragma unroll
        for (int i = 0; i < 8; ++i) { const float4 v = ldnt4(wp + (size_t)i * 8 * N); LAS float* d = scr + (8 * i + (lane >> 3)) * 33 + 4 * (lane & 7); d[0] = v.x; d[1] = v.y; d[2] = v.z; d[3] = v.w; }
        wp += (size_t)64 * N;
        WSYNC();
#pragma unroll
        for (int j = 0; j < 4; ++j) { const int n = (lane >> 3) + 8 * j; const LAS float* sp = scr + (8 * c) * 33 + n; const float iv = __shfl(inv, n);
            unsigned lo = 0u, hi = 0u;
#pragma unroll
            for (int q = 0; q < 4; ++q) { lo |= ((unsigned)(int)rintf(sp[q * 33] * iv) & 0xffu) << (8 * q); hi |= ((unsigned)(int)rintf(sp[(q + 4) * 33] * iv) & 0xffu) << (8 * q); }
            g8::u32x2 o; o.x = lo; o.y = hi; *(g8::u32x2*)(Q + (size_t)(n0 + n) * 1024 + k0 + 8 * c) = o; }
        WSYNC(); }
}
__device__ __forceinline__ void transpose_item_f8(const float* W, int K, int N, unsigned char* WT, float scale, LAS float* scr, int item, int lane) {
    const int nblk = N / 32, kb = item / nblk, nb = item % nblk, k0 = 64 * kb, n0 = 32 * nb;
#pragma unroll
    for (int i = 0; i < 8; ++i) { const int kk = 8 * i + (lane >> 3); const float4 v = ldnt4(W + (size_t)(k0 + kk) * N + n0 + 4 * (lane & 7));
        LAS float* d = scr + kk * 33 + 4 * (lane & 7); d[0] = v.x; d[1] = v.y; d[2] = v.z; d[3] = v.w; }
    WSYNC();
    const int c = lane & 7;
#pragma unroll
    for (int j = 0; j < 4; ++j) { const int n = (lane >> 3) + 8 * j; const LAS float* sp = scr + (8 * c) * 33 + n;
        unsigned lo = 0u, hi = 0u;
        lo = __builtin_amdgcn_cvt_pk_fp8_f32(sp[0 * 33] * scale, sp[1 * 33] * scale, lo, false); lo = __builtin_amdgcn_cvt_pk_fp8_f32(sp[2 * 33] * scale, sp[3 * 33] * scale, lo, true);
        hi = __builtin_amdgcn_cvt_pk_fp8_f32(sp[4 * 33] * scale, sp[5 * 33] * scale, hi, false); hi = __builtin_amdgcn_cvt_pk_fp8_f32(sp[6 * 33] * scale, sp[7 * 33] * scale, hi, true);
        g8::u32x2 o; o.x = lo; o.y = hi; *(g8::u32x2*)(WT + (size_t)(n0 + n) * K + k0 + 8 * c) = o; }
    WSYNC();
}
__device__ __forceinline__ float bf2f(unsigned short h) { return __uint_as_float((unsigned)h << 16); }
__device__ __forceinline__ void ln_wave(float4 (&v)[4], const float* g, const float* bta, int lane) {
    float s = 0.f;
#pragma unroll
    for (int j = 0; j < 4; ++j) s += (v[j].x + v[j].y) + (v[j].z + v[j].w);
    const float mean = wave_sum(s) * (1.f / D); float s2 = 0.f;
#pragma unroll
    for (int j = 0; j < 4; ++j) { v[j].x -= mean; v[j].y -= mean; v[j].z -= mean; v[j].w -= mean; s2 += (v[j].x * v[j].x + v[j].y * v[j].y) + (v[j].z * v[j].z + v[j].w * v[j].w); }
    const float rstd = 1.f / sqrtf(wave_sum(s2) * (1.f / D) + LN_EPS);
#pragma unroll
    for (int j = 0; j < 4; ++j) { const float4 gg = *(const float4*)(g + 4 * lane + 256 * j), bb = *(const float4*)(bta + 4 * lane + 256 * j);
        v[j].x = v[j].x * rstd * gg.x + bb.x; v[j].y = v[j].y * rstd * gg.y + bb.y; v[j].z = v[j].z * rstd * gg.z + bb.z; v[j].w = v[j].w * rstd * gg.w + bb.w; }
}


__device__ __forceinline__ float dot64_bf16(const unsigned short* kp, const LAS float* qv) {
    float s = 0.f;
#pragma unroll
    for (int c = 0; c < 8; ++c) { const g8::u32x4 kk = *(const g8::u32x4*)(kp + c * 8); const f32x4 q0 = *(const LAS f32x4*)(qv + c * 8), q1 = *(const LAS f32x4*)(qv + c * 8 + 4);
        s += __uint_as_float(kk.x << 16) * q0[0] + __uint_as_float(kk.x & 0xffff0000u) * q0[1] + __uint_as_float(kk.y << 16) * q0[2] + __uint_as_float(kk.y & 0xffff0000u) * q0[3]
           + __uint_as_float(kk.z << 16) * q1[0] + __uint_as_float(kk.z & 0xffff0000u) * q1[1] + __uint_as_float(kk.w << 16) * q1[2] + __uint_as_float(kk.w & 0xffff0000u) * q1[3]; }
    return s;
}
__device__ __forceinline__ unsigned short f2bf(float f) { return (unsigned short)(g8::cvt_pk_bf16(f, 0.f) & 0xffffu); }


namespace attn2 {
using bf16=__hip_bfloat16;
using bf16x8=__attribute__((ext_vector_type(8)))short;
using s16x4=__attribute__((ext_vector_type(4)))short;
using f32x16=__attribute__((ext_vector_type(16)))float;
using u32x4=__attribute__((ext_vector_type(4)))unsigned;
constexpr int SEQ=2048,D=64,PQ=3072,PO=1024;
constexpr int NW=8,QBLK=32,QB=QBLK*NW,KVBLK=64,NQB=SEQ/QB;
__device__ __forceinline__ int crow(int r,int hi){return (r&3)+8*(r>>2)+4*hi;}
#define SBAR() __builtin_amdgcn_sched_barrier(0)
__device__ __forceinline__ void cmask(f32x16&p0,f32x16&p1,int jb,int qrel,int hi){
  const float NEG=-INFINITY; int kb=64*jb+4*hi;
  #pragma unroll
  for(int r=0;r<16;++r){int kv=kb+(r&3)+8*(r>>2); if(kv>qrel)p0[r]=NEG; if(kv+32>qrel)p1[r]=NEG;}
}

constexpr int NSLOT=3, SLOTB=8192;
constexpr int LDS_K=0, LDS_V=NSLOT*SLOTB, LDS_WS=2*NSLOT*SLOTB, LDS_OST=LDS_WS+NW*64*4, LDS_BYTES=LDS_OST+NW*4096;
constexpr float C2=0.125f*1.4426950408889634f;
__device__ __forceinline__ void glds16(const void*gsrc,unsigned lds_dst){unsigned keep;
  asm volatile("s_mov_b32 %0, m0\n\ts_mov_b32 m0, %2\n\ts_nop 0\n\tglobal_load_lds_dwordx4 %1, off\n\ts_mov_b32 m0, %0":"=&s"(keep):"v"(gsrc),"s"(lds_dst):"memory");}
__device__ __forceinline__ float max3f(float a,float b,float c){float r;asm("v_max3_f32 %0, %1, %2, %3":"=v"(r):"v"(a),"v"(b),"v"(c));return r;}
__device__ __forceinline__ float max2f(float a,float b){float r;asm("v_max_f32_e32 %0, %1, %2":"=v"(r):"v"(a),"v"(b));return r;}
__device__ __forceinline__ float fadd_s(float a,float b){float r;asm("v_add_f32_e32 %0, %1, %2":"=v"(r):"v"(a),"v"(b));return r;}
__device__ __forceinline__ float fsub_s(float a,float b){float r;asm("v_sub_f32_e32 %0, %1, %2":"=v"(r):"v"(a),"v"(b));return r;}
typedef float f32x4_t __attribute__((ext_vector_type(4)));
__device__ __forceinline__ float bfs(short h){return __uint_as_float(((unsigned)(unsigned short)h)<<16);}
typedef float f32x2_t __attribute__((ext_vector_type(2))); typedef __bf16 bf16x2_t __attribute__((ext_vector_type(2)));
__device__ __forceinline__ unsigned cvtpk_s(float lo,float hi){f32x2_t v={lo,hi};bf16x2_t b=__builtin_convertvector(v,bf16x2_t);return __builtin_bit_cast(unsigned,b);}
#define WAIT_BAR(N) asm volatile("s_waitcnt vmcnt(" #N ") lgkmcnt(0)\n\ts_barrier":::"memory")

__device__ __forceinline__ void qkt(f32x16&p0,f32x16&p1,const char*Kslot,const bf16x8*qr,int r32,int hi){ const f32x16 negm=f32x16{};
  const char*kb=Kslot+hi*1024+r32*16;
  #pragma unroll
  for(int d0=0;d0<4;++d0){
    const bf16x8 b0=*reinterpret_cast<const bf16x8*>(kb+d0*2048);
    const bf16x8 b1=*reinterpret_cast<const bf16x8*>(kb+d0*2048+512);
    if(d0==0){p0=__builtin_amdgcn_mfma_f32_32x32x16_bf16(b0,qr[0],negm,0,0,0);p1=__builtin_amdgcn_mfma_f32_32x32x16_bf16(b1,qr[0],negm,0,0,0);}
    else{p0=__builtin_amdgcn_mfma_f32_32x32x16_bf16(b0,qr[d0],p0,0,0,0);p1=__builtin_amdgcn_mfma_f32_32x32x16_bf16(b1,qr[d0],p1,0,0,0);}}
}
typedef __attribute__((address_space(3))) const char* lds_cptr;
typedef short v4i16_t __attribute__((ext_vector_type(4)));
__device__ __forceinline__ void kload8(bf16x8*kf,lds_cptr kp){
  kf[0]=*(const __attribute__((address_space(3))) bf16x8*)(kp);      kf[1]=*(const __attribute__((address_space(3))) bf16x8*)(kp+512);
  kf[2]=*(const __attribute__((address_space(3))) bf16x8*)(kp+2048); kf[3]=*(const __attribute__((address_space(3))) bf16x8*)(kp+2560);
  kf[4]=*(const __attribute__((address_space(3))) bf16x8*)(kp+4096); kf[5]=*(const __attribute__((address_space(3))) bf16x8*)(kp+4608);
  kf[6]=*(const __attribute__((address_space(3))) bf16x8*)(kp+6144); kf[7]=*(const __attribute__((address_space(3))) bf16x8*)(kp+6656);
}
__device__ __forceinline__ void kload2(bf16x8*kf,lds_cptr kp,int j){ kf[2*j]=*(const __attribute__((address_space(3))) bf16x8*)(kp+j*2048); kf[2*j+1]=*(const __attribute__((address_space(3))) bf16x8*)(kp+j*2048+512); }
__device__ __forceinline__ s16x4 vtr(lds_cptr p){ return __builtin_bit_cast(s16x4,__builtin_amdgcn_ds_read_tr16_b64_v4i16((__attribute__((address_space(3))) v4i16_t*)p)); }
__device__ __forceinline__ float rowmax(const f32x16&p0,const f32x16&p1){
  float a=max3f(p0[0],p0[1],p1[0]),b=max3f(p0[2],p0[3],p1[1]);a=max3f(a,p1[2],p1[3]);
  #pragma unroll
  for(int r=4;r<16;r+=4){a=max3f(a,p0[r],p0[r+1]);b=max3f(b,p0[r+2],p0[r+3]);a=max3f(a,p1[r],p1[r+1]);b=max3f(b,p1[r+2],p1[r+3]);}
  const float m=max2f(a,b);
  auto rr=__builtin_amdgcn_permlane32_swap(__float_as_uint(m),__float_as_uint(m),false,false);
  return max2f(__uint_as_float(rr[0]),__uint_as_float(rr[1]));
}
__device__ __forceinline__ void pv(f32x16*o,int vb,bf16x8 pa0,bf16x8 pa1,bf16x8 pa2,bf16x8 pa3){
  #pragma unroll
  for(int d0=0;d0<2;++d0){s16x4 lo[4],hi[4];
    #pragma unroll
    for(int ks=0;ks<4;++ks){
      asm volatile("ds_read_b64_tr_b16 %0,%1 offset:%c2":"=&v"(lo[ks]):"v"(vb),"i"(d0*4096+ks*1024):"memory");
      asm volatile("ds_read_b64_tr_b16 %0,%1 offset:%c2":"=&v"(hi[ks]):"v"(vb),"i"(d0*4096+ks*1024+512):"memory");}
    asm volatile("s_waitcnt lgkmcnt(0)":::"memory");SBAR();
    #define PK(k) (bf16x8){lo[k][0],lo[k][1],lo[k][2],lo[k][3],hi[k][0],hi[k][1],hi[k][2],hi[k][3]}
    o[d0]=__builtin_amdgcn_mfma_f32_32x32x16_bf16(pa0,PK(0),o[d0],0,0,0);
    o[d0]=__builtin_amdgcn_mfma_f32_32x32x16_bf16(pa1,PK(1),o[d0],0,0,0);
    o[d0]=__builtin_amdgcn_mfma_f32_32x32x16_bf16(pa2,PK(2),o[d0],0,0,0);
    o[d0]=__builtin_amdgcn_mfma_f32_32x32x16_bf16(pa3,PK(3),o[d0],0,0,0);
    #undef PK
  }
}

#ifndef ATTN_STORE16
#define ATTN_STORE16(p,v) (*(u32x4*)(p)=(v))
#endif
template<int THRL> __device__ __forceinline__ void attn_unit(int b,int qb,const bool MOBA,const bf16*Qp,const bf16*__restrict__ Kp,const bf16*__restrict__ Vp,bf16*Op,const float*kmean_bh,char*shm){
  int tid_=threadIdx.x; asm volatile("":"+v"(tid_));
  const int tid=tid_,lane=tid&63,r32=lane&31,hi=lane>>5; const int wid=__builtin_amdgcn_readfirstlane(tid>>6);
  const long rowbase=(long)b*SEQ; const int q0=qb*QB;
  const bf16*Qw=Qp+(rowbase+q0+wid*QBLK)*PQ;
  const bf16*Kh=Kp+rowbase*PQ,*Vh=Vp+rowbase*PQ;
  const unsigned lds0=(unsigned)(uintptr_t)shm;
  float*wsf=(float*)(shm+LDS_WS)+wid*64;
  const bf16*ksrc=Kh+(long)lane*PQ+wid*8;
  const bf16*vsrc=Vh+(long)(16*(wid&3)+(lane>>2))*PQ+(wid>>2)*32+(lane&3)*8;
  const unsigned kdst=lds0+LDS_K+wid*1024, vdst=lds0+LDS_V+wid*1024;
  #define TILE(t) (((t)<4)?(NT-4+(t)):((t)-4))
  #define DMA_K(t,slot) glds16(ksrc+(long)TILE(t)*KVBLK*PQ,(unsigned)__builtin_amdgcn_readfirstlane(kdst+(slot)))
  #define DMA_V(t,slot) glds16(vsrc+(long)TILE(t)*KVBLK*PQ,(unsigned)__builtin_amdgcn_readfirstlane(vdst+(slot)))
  const int vb0=(int)(lds0+LDS_V)+((lane>>4)&1)*32+(lane&3)*8+(4*hi+((lane&15)>>2))*64;
  const char*Kbase=shm+LDS_K; bf16x8 kf[8];
  const lds_cptr shm3=(lds_cptr)shm; const lds_cptr kp0=shm3+LDS_K+hi*1024+r32*16; const lds_cptr vp0=shm3+LDS_V+((lane>>4)&1)*32+(lane&3)*8+(4*hi+((lane&15)>>2))*64;
  const int NT=(q0+QB)/KVBLK;
  DMA_K(0,0);DMA_V(0,0);DMA_K(1,SLOTB);
  bf16x8 qr[4];
  #pragma unroll
  for(int d0=0;d0<4;++d0)qr[d0]=*reinterpret_cast<const bf16x8*>(&Qw[(long)r32*PQ+d0*16+hi*8]);
  unsigned selmask=0xffu;
  if(MOBA&&qb>=4){ float g[8];
    #pragma unroll
    for(int n=0;n<8;++n){ g[n]=-INFINITY; if(n<qb){ float s=0.f; const float*km=kmean_bh+n*64+hi*8;
        #pragma unroll
        for(int d0=0;d0<4;++d0){ const f32x4_t k0=*reinterpret_cast<const f32x4_t*>(km+d0*16),k1=*reinterpret_cast<const f32x4_t*>(km+d0*16+4); const bf16x8 qq=qr[d0];
          s+=bfs(qq[0])*k0[0]+bfs(qq[1])*k0[1]+bfs(qq[2])*k0[2]+bfs(qq[3])*k0[3]+bfs(qq[4])*k1[0]+bfs(qq[5])*k1[1]+bfs(qq[6])*k1[2]+bfs(qq[7])*k1[3]; }
        auto rr=__builtin_amdgcn_permlane32_swap(__float_as_uint(s),__float_as_uint(s),false,false); g[n]=__uint_as_float(rr[0])+__uint_as_float(rr[1]); } }
    selmask=0u;
    #pragma unroll
    for(int r=0;r<3;++r){ int best=-1; float bv=0.f;
      #pragma unroll
      for(int n=0;n<8;++n) if(n<qb&&!((selmask>>n)&1u)&&(best<0||g[n]>bv)){best=n;bv=g[n];}
      selmask|=1u<<best; } }
  float mhat=0.f,l_reg=0.f;f32x16 o[2];o[0]=f32x16{};o[1]=f32x16{};
  const int qrel=wid*QBLK+r32;
  const int jw=wid>>1;
  #define CMASK_SUB(P0,P1,t,SUB) do{ SUB=mhat; if((t)<4){ if((t)==jw)cmask(P0,P1,(t),qrel,hi); else if((t)>jw)SUB=INFINITY; } \
      else if(MOBA&&qb>=4){ if(!((selmask>>(((t)-4)>>2))&1u))SUB=INFINITY; } }while(0)
  bool resc=false;
  #define START(P0,P1) do{ const float rm=rowmax(P0,P1); resc=false; \
    { const float dl=(__builtin_fabsf(rm)>(float)THRL)?rm:0.f; mhat=dl;     \
      if(__any(dl!=0.f)){ _Pragma("unroll") for(int r=0;r<16;++r){P0[r]=fsub_s(P0[r],dl);P1[r]=fsub_s(P1[r],dl);} } \
    } \
    _Pragma("unroll") for(int r=0;r<16;++r)P0[r]=__builtin_amdgcn_exp2f(P0[r]); }while(0)
  #define RESC() do{ if(resc){ asm volatile("s_waitcnt lgkmcnt(0)":::"memory"); \
      _Pragma("unroll") for(int d_=0;d_<2;++d_) _Pragma("unroll") for(int r=0;r<16;++r)o[d_][r]*=wsf[crow(r,hi)]; } }while(0)
  f32x16 pA0,pA1,pB0,pB1;
  int sl_prev=0,sl_cur=0,sl_next=SLOTB;
  #define ROT() do{sl_prev=sl_cur;sl_cur=sl_next;sl_next=(sl_next==(NSLOT-1)*SLOTB)?0:sl_next+SLOTB;}while(0)
  DMA_K(2,2*SLOTB);
  WAIT_BAR(3);
  qkt(pA0,pA1,Kbase,qr,r32,hi);asm volatile("s_nop 15\n\ts_nop 7":"+v"(pA0),"+v"(pA1));if(jw==0)cmask(pA0,pA1,0,qrel,hi);
  START(pA0,pA1);
  _Pragma("unroll") for(int r=0;r<16;++r)pA1[r]=__builtin_amdgcn_exp2f(pA1[r]);
  WAIT_BAR(0);
  DMA_K(3,0);DMA_V(1,SLOTB);
  ROT();
  kload8(kf,kp0+sl_cur);
  WAIT_BAR(2);
  s16x4 vlo[8],vhi[8]; u32x4 pw0,pw1,pw2,pw3;
  #define PKW(P,B) cvtpk_s(P[B],P[B+1])
  #define PAF(k) __builtin_bit_cast(bf16x8,pw##k)
  #define VFR(i) (bf16x8){vlo[i][0],vlo[i][1],vlo[i][2],vlo[i][3],vhi[i][0],vhi[i][1],vhi[i][2],vhi[i][3]}
  #define PIN(x) asm volatile("":"+v"(x))
  #define MX3(a,b,c) __builtin_fmaxf(__builtin_fmaxf((a),(b)),(c))
  #define GAPA(MF,A0,A1,A2,A3,W0,W1,PW) do{ MF; sacc+=A0; sacc+=A1; sacc+=A2; sacc+=A3; PIN(sacc); W0; W1; PIN(PW); SBAR(); }while(0)
  #define EX(v) __builtin_amdgcn_exp2f(v)
  #define GAPB(MF,X,B) do{ MF; X[B]=EX(X[B]); X[B+1]=EX(X[B+1]); X[B+2]=EX(X[B+2]); X[B+3]=EX(X[B+3]); PIN(X); SBAR(); }while(0)
  #define VRD(i) do{ vlo[i]=vtr(vp_+(((i)>>2)*4096+((i)&3)*1024)); vhi[i]=vtr(vp_+(((i)>>2)*4096+((i)&3)*1024+512)); }while(0)
  #define KRD(G,j) do{ if(G){ kload2(kf,kp0+sl_next,j); SBAR(); } }while(0)
  #define STEP(C0,C1,P0,P1,t,GK,GV,GL) do{ SBAR(); \
    const lds_cptr vp_=vp0+sl_prev; \
    VRD(0); SBAR(); float sacc=(P0[0]+P0[1]); \
    GAPA(C0=__builtin_amdgcn_mfma_f32_32x32x16_bf16(kf[0],qr[0],f32x16{},0,0,0), P0[2],P0[3],P0[4],P0[5],     pw0[0]=PKW(P0,0), pw0[1]=PKW(P0,2), pw0); \
    VRD(4); SBAR(); GAPA(C1=__builtin_amdgcn_mfma_f32_32x32x16_bf16(kf[1],qr[0],f32x16{},0,0,0), P0[6],P0[7],P0[8],P0[9],     pw0[2]=PKW(P0,4), pw0[3]=PKW(P0,6), pw0); \
    VRD(1); SBAR(); GAPA(C0=__builtin_amdgcn_mfma_f32_32x32x16_bf16(kf[2],qr[1],C0,0,0,0),   P0[10],P0[11],P0[12],P0[13], pw1[0]=PKW(P0,8), pw1[1]=PKW(P0,10), pw1); \
    VRD(5); SBAR(); GAPA(C1=__builtin_amdgcn_mfma_f32_32x32x16_bf16(kf[3],qr[1],C1,0,0,0),   P0[14],P0[15],P1[0],P1[1],   pw1[2]=PKW(P0,12),pw1[3]=PKW(P0,14), pw1); \
    VRD(2); SBAR(); GAPA(C0=__builtin_amdgcn_mfma_f32_32x32x16_bf16(kf[4],qr[2],C0,0,0,0),   P1[2],P1[3],P1[4],P1[5],     pw2[0]=PKW(P1,0), pw2[1]=PKW(P1,2), pw2); \
    VRD(6); SBAR(); GAPA(C1=__builtin_amdgcn_mfma_f32_32x32x16_bf16(kf[5],qr[2],C1,0,0,0),   P1[6],P1[7],P1[8],P1[9],     pw2[2]=PKW(P1,4), pw2[3]=PKW(P1,6), pw2); \
    VRD(3); SBAR(); GAPA(C0=__builtin_amdgcn_mfma_f32_32x32x16_bf16(kf[6],qr[3],C0,0,0,0),   P1[10],P1[11],P1[12],P1[13], pw3[0]=PKW(P1,8), pw3[1]=PKW(P1,10), pw3); \
    VRD(7); SBAR(); GAPA(C1=__builtin_amdgcn_mfma_f32_32x32x16_bf16(kf[7],qr[3],C1,0,0,0),   P1[14],P1[15],0.f,0.f,       pw3[2]=PKW(P1,12),pw3[3]=PKW(P1,14), pw3); \
    l_reg+=sacc; \
    if(GK){DMA_K((t)+3,sl_cur);} if(GV){DMA_V((t)+1,sl_next);} \
    { float sub_; CMASK_SUB(C0,C1,t,sub_); \
    if(__any(sub_!=0.f)){ _Pragma("unroll") for(int r=0;r<16;++r){C0[r]=fsub_s(C0[r],sub_);C1[r]=fsub_s(C1[r],sub_);} } }   \
    { float a=MX3(C0[0],C0[1],C1[0]),b=MX3(C0[2],C0[3],C1[1]); a=MX3(a,C1[2],C1[3]); \
      _Pragma("unroll") for(int r=4;r<16;r+=4){a=MX3(a,C0[r],C0[r+1]);b=MX3(b,C0[r+2],C0[r+3]);a=MX3(a,C1[r],C1[r+1]);b=MX3(b,C1[r+2],C1[r+3]);} \
      float rm=__builtin_fmaxf(a,b); { auto rr=__builtin_amdgcn_permlane32_swap(__float_as_uint(rm),__float_as_uint(rm),false,false); rm=__builtin_fmaxf(__uint_as_float(rr[0]),__uint_as_float(rr[1])); } \
      resc=false; \
      if(__builtin_expect(__any(rm>(float)THRL),0)){ const float dl=__builtin_fmaxf(rm,0.f); mhat+=dl; \
        _Pragma("unroll") for(int r=0;r<16;++r){C0[r]-=dl;C1[r]-=dl;} \
        const float f=__builtin_amdgcn_exp2f(-dl); l_reg*=f; if(hi==0)wsf[r32]=f; resc=true; } } \
    SBAR(); \
    GAPB(o[0]=__builtin_amdgcn_mfma_f32_32x32x16_bf16(PAF(0),VFR(0),o[0],0,0,0), C0,0); \
    GAPB(o[1]=__builtin_amdgcn_mfma_f32_32x32x16_bf16(PAF(0),VFR(4),o[1],0,0,0), C0,4); \
    KRD(GL,0); GAPB(o[0]=__builtin_amdgcn_mfma_f32_32x32x16_bf16(PAF(1),VFR(1),o[0],0,0,0), C0,8); \
    KRD(GL,1); GAPB(o[1]=__builtin_amdgcn_mfma_f32_32x32x16_bf16(PAF(1),VFR(5),o[1],0,0,0), C0,12); \
    KRD(GL,2); GAPB(o[0]=__builtin_amdgcn_mfma_f32_32x32x16_bf16(PAF(2),VFR(2),o[0],0,0,0), C1,0); \
    KRD(GL,3); GAPB(o[1]=__builtin_amdgcn_mfma_f32_32x32x16_bf16(PAF(2),VFR(6),o[1],0,0,0), C1,4); \
    GAPB(o[0]=__builtin_amdgcn_mfma_f32_32x32x16_bf16(PAF(3),VFR(3),o[0],0,0,0), C1,8); \
    GAPB(o[1]=__builtin_amdgcn_mfma_f32_32x32x16_bf16(PAF(3),VFR(7),o[1],0,0,0), C1,12); \
    }while(0)
  int t=1;
  for(;t+5<NT;t+=2){
    STEP(pB0,pB1,pA0,pA1,t,true,true,true);     WAIT_BAR(2); RESC(); ROT();
    STEP(pA0,pA1,pB0,pB1,t+1,true,true,true);   WAIT_BAR(2); RESC(); ROT();
  }
  #define ENDW(tt) do{ if((tt)+3<NT){WAIT_BAR(2);} else if((tt)+2<NT){WAIT_BAR(1);} else {WAIT_BAR(0);} }while(0)
  for(;t+1<NT;t+=2){
    STEP(pB0,pB1,pA0,pA1,t,(t+3<NT),(t+1<NT),(t+1<NT));       ENDW(t);   RESC(); ROT();
    STEP(pA0,pA1,pB0,pB1,t+1,(t+4<NT),(t+2<NT),(t+2<NT));     ENDW(t+1); RESC(); ROT();
  }
  STEP(pB0,pB1,pA0,pA1,NT-1,false,false,false); RESC();
  { float sacc=pB0[0]+pB0[1]; _Pragma("unroll") for(int r=2;r<16;++r)sacc+=pB0[r]; _Pragma("unroll") for(int r=0;r<16;++r)sacc+=pB1[r]; l_reg+=sacc;
    pw0=(u32x4){PKW(pB0,0),PKW(pB0,2),PKW(pB0,4),PKW(pB0,6)};pw1=(u32x4){PKW(pB0,8),PKW(pB0,10),PKW(pB0,12),PKW(pB0,14)};pw2=(u32x4){PKW(pB1,0),PKW(pB1,2),PKW(pB1,4),PKW(pB1,6)};pw3=(u32x4){PKW(pB1,8),PKW(pB1,10),PKW(pB1,12),PKW(pB1,14)};
    SBAR(); pv(o,vb0+sl_cur,PAF(0),PAF(1),PAF(2),PAF(3)); }
  #undef PKW
  #undef PAF
  #undef VFR
  #undef PIN
  #undef MX3
  #undef GAPA
  #undef GAPB
  #undef EX
  #undef VRD
  #undef KRD
  #undef STEP
  #undef ENDW
  {auto rr=__builtin_amdgcn_permlane32_swap(__float_as_uint(l_reg),__float_as_uint(l_reg),false,false);l_reg=__uint_as_float(rr[0])+__uint_as_float(rr[1]);}
  if(hi==0)wsf[32+r32]=l_reg;asm volatile("s_waitcnt lgkmcnt(0)":::"memory");
  float rli[16];
  #pragma unroll
  for(int r=0;r<16;++r)rli[r]=__builtin_amdgcn_rcpf(wsf[32+crow(r,hi)]);
  bf16*Ow=Op+(rowbase+q0+wid*QBLK)*PO;
  { bf16*stg=(bf16*)(shm+LDS_OST)+wid*2048;
    #pragma unroll
    for(int r=0;r<16;++r){const int orow=crow(r,hi);
      #pragma unroll
      for(int d0=0;d0<2;++d0)stg[orow*64+d0*32+r32]=__float2bfloat16(o[d0][r]*rli[r]);}
    asm volatile("s_waitcnt lgkmcnt(0)":::"memory");
    #pragma unroll
    for(int i=0;i<4;++i){const int row=i*8+(lane>>3),ch=lane&7; const u32x4 v=*(const u32x4*)(stg+row*64+ch*8); ATTN_STORE16(Ow+(long)row*PO+ch*8,v);} }
  asm volatile("s_waitcnt lgkmcnt(0)\n\ts_barrier":::"memory");
  #undef DMA_K
  #undef TILE
  #undef DMA_V
  #undef CMASK_SUB
  #undef START
  #undef RESC
  #undef ROT
}
constexpr int ATTN_LDS_BYTES=LDS_BYTES;
#undef SBAR
#undef WAIT_BAR
}
struct Args;
__device__ __forceinline__ void attn_combine_ptrs(const float*& lq1, const float*& lk1, const float*& lq2, const float*& lk2, const float*& subln_g);
__device__ __forceinline__ void moe_weight_prep_ptrs(const float*& w_mlp1, const float*& w_mlp2, signed char*& w1q, float*& sbw, unsigned char*& w2q);
__device__ __forceinline__ void moe_weight_prep(LAS unsigned char* lds) {
    const float* w_mlp1; const float* w_mlp2; signed char* w1q; float* sbw; unsigned char* w2q; moe_weight_prep_ptrs(w_mlp1, w_mlp2, w1q, sbw, w2q);
    int tid_ = threadIdx.x; asm volatile("" : "+v"(tid_));
    const int tid = tid_, lane = tid & 63, wave = tid >> 6, gw = blockIdx.x * (NTHR / 64) + wave, NGW = gridDim.x * (NTHR / 64);
    constexpr int I1Q = 2 * DFF / 32, I2 = (DFF / 64) * (D / 32), NQ = NEXP * I1Q;
    __syncthreads();
    { LAS float* scr = (LAS float*)lds + wave * (64 * 33);
      for (int it = gw; it < NEXP * I2; it += NGW) { const int qe = it / I2, q = it - qe * I2; transpose_item_f8(w_mlp2 + (size_t)qe * DFF * D, DFF, D, w2q + (size_t)qe * D * DFF, g8::W2_SCALE, scr, q, lane); } }
    __syncthreads();
    { LAS float* stage = (LAS float*)lds; LAS float* red = stage + 1024 * 33; float4 v[16];
      { const int it0 = blockIdx.x; if (it0 < NQ) { const int qe = it0 / I1Q, nb = it0 - qe * I1Q; quant_w1_load(w_mlp1 + (size_t)qe * D * 2 * DFF, 2 * DFF, nb, tid, v); } }
#pragma unroll 1
      for (int it = blockIdx.x; it < NQ; it += gridDim.x) { const int qe = it / I1Q, nb = it - qe * I1Q;
          quant_w1_stage(v, stage, red, tid);
          { const int itn = it + gridDim.x; if (itn < NQ) { const int qn = itn / I1Q, nbn = itn - qn * I1Q; quant_w1_load(w_mlp1 + (size_t)qn * D * 2 * DFF, 2 * DFF, nbn, tid, v); } }
          quant_w1_emit(w1q + (size_t)qe * 2 * DFF * D, sbw + (size_t)qe * 2 * DFF, stage, red, nb, tid); } }
    __syncthreads();
}
__device__ __forceinline__ void attn_phase(char* lds, const unsigned short* projb_, unsigned short* tmpb_, unsigned short* mixb_, const float* kmean, int G, int blk) {
    using attn2::bf16;
    const bf16* projb = (const bf16*)projb_; bf16* tmpb = (bf16*)tmpb_; bf16* mixb = (bf16*)mixb_;
    const int vcu = (G % 8 == 0) ? (blk % 8) * (G / 8) + blk / 8 : blk;
    const int nitems = (1536 - vcu + G - 1) / G, kprep = blk % nitems;
    int kitem = 0;
    for (int it = vcu; it < 1536; it += G, ++kitem) {
        if (kitem == kprep) moe_weight_prep((LAS unsigned char*)lds);
        const bool moba = it >= 512; const int q = moba ? it - 512 : it;
        const int s = q & 3, h = moba ? (q >> 2) & 7 : (q >> 2) & 3, b = moba ? q >> 5 : q >> 4, nun = moba ? 2 : 8;
        const float* km = kmean + (size_t)((b * 8 + (moba ? h : 0)) * 8) * 64;
        for (int k = 0; k < nun; ++k) {
            const int u = moba ? k : k >> 2, cv = k & 3, c = cv >> 1, vh = cv & 1, qb = u ? s : 7 - s;
            const int qcol = moba ? 1536 + h * 64 : h * 128 + c * 64, kcol = moba ? 2048 + h * 64 : 512 + h * 128 + c * 64, vcol = moba ? 2560 + h * 64 : 1024 + h * 128 + vh * 64;
            bf16* op = moba ? mixb + 512 + h * 64 : tmpb + (h * 2 + c) * 128 + vh * 64;
            attn2::attn_unit<8>(b, qb, moba, projb + qcol, projb + kcol, projb + vcol, op, km, lds);
            if (!moba && cv == 3) {
                const int lane = threadIdx.x & 63, wave = threadIdx.x >> 6, tk = lane >> 4, sg = lane & 15;
                const float* lq1; const float* lk1; const float* lq2; const float* lk2; const float* subln_g; attn_combine_ptrs(lq1, lk1, lq2, lk2, subln_g);
                float l4[4] = {lq1[lane], lk1[lane], lq2[lane], lk2[lane]}; float gg[8];
#pragma unroll
                for (int i = 0; i < 8; ++i) gg[i] = subln_g[sg * 8 + i] * 0.8f;
                asm volatile("s_waitcnt vmcnt(0)" : "+v"(l4[0]), "+v"(l4[1]), "+v"(l4[2]), "+v"(l4[3]) :: "memory"); __syncthreads();
                float lam; { const float a = wave_sum(l4[0] * l4[1]), b2 = wave_sum(l4[2] * l4[3]); lam = expf(a) - expf(b2) + 0.2f; }
                const unsigned short* tb = tmpb_; unsigned short* mb = mixb_;
                g8::u32x4 ua[8], ub[8];
#pragma unroll
                for (int g = 0; g < 8; ++g) { const size_t r = (size_t)b * SEQ + qb * 256 + wave * 4 + 32 * g + tk;
                    const unsigned short* p1 = tb + r * D + (h * 2) * 128 + sg * 8; const unsigned short* p2 = tb + r * D + (h * 2 + 1) * 128 + sg * 8;
                    asm volatile("global_load_dwordx4 %0, %1, off sc0 sc1" : "=v"(ua[g]) : "v"(p1) : "memory");
                    asm volatile("global_load_dwordx4 %0, %1, off sc0 sc1" : "=v"(ub[g]) : "v"(p2) : "memory"); }
                asm volatile("s_waitcnt vmcnt(0)" : "+v"(ua[0]), "+v"(ua[1]), "+v"(ua[2]), "+v"(ua[3]), "+v"(ua[4]), "+v"(ua[5]), "+v"(ua[6]), "+v"(ua[7]), "+v"(ub[0]), "+v"(ub[1]), "+v"(ub[2]), "+v"(ub[3]), "+v"(ub[4]), "+v"(ub[5]), "+v"(ub[6]), "+v"(ub[7]) :: "memory");
#pragma unroll
                for (int g = 0; g < 8; ++g) { const size_t r = (size_t)b * SEQ + qb * 256 + wave * 4 + 32 * g + tk;
                    unsigned u1[4], u2[4];
#pragma unroll
                    for (int i = 0; i < 4; ++i) { u1[i] = ua[g][i]; u2[i] = ub[g][i]; }
                    float a[8];
#pragma unroll
                    for (int i = 0; i < 4; ++i) { a[2 * i] = __uint_as_float(u1[i] << 16) - lam * __uint_as_float(u2[i] << 16); a[2 * i + 1] = __uint_as_float(u1[i] & 0xffff0000u) - lam * __uint_as_float(u2[i] & 0xffff0000u); }
                    float ss = 0.f;
#pragma unroll
                    for (int i = 0; i < 8; ++i) ss += a[i] * a[i];
                    ss += __shfl_xor(ss, 1); ss += __shfl_xor(ss, 2); ss += __shfl_xor(ss, 4); ss += __shfl_xor(ss, 8);
                    const float rr = 1.0f / sqrtf(ss * (1.0f / 128.0f) + 1e-5f);
                    g8::u32x4 o;
#pragma unroll
                    for (int i = 0; i < 4; ++i) o[i] = g8::cvt_pk_bf16(a[2 * i] * rr * gg[2 * i], a[2 * i + 1] * rr * gg[2 * i + 1]);
                    *(g8::u32x4*)(mb + r * D + h * 128 + sg * 8) = o; }
            }
        }
    }
}

struct Args { const float* in[26]; float* out; unsigned char* ws; int ph_lo, ph_hi; };
__device__ __forceinline__ void attn_combine_ptrs(const float*& lq1, const float*& lk1, const float*& lq2, const float*& lk2, const float*& subln_g) {
    const volatile __attribute__((address_space(4))) Args* const KA = (const volatile __attribute__((address_space(4))) Args*)__builtin_amdgcn_kernarg_segment_ptr();
    lq1 = (const float*)KA->in[3]; lk1 = (const float*)KA->in[4]; lq2 = (const float*)KA->in[5]; lk2 = (const float*)KA->in[6]; subln_g = (const float*)KA->in[7]; }
__device__ __forceinline__ void moe_weight_prep_ptrs(const float*& w_mlp1, const float*& w_mlp2, signed char*& w1q, float*& sbw, unsigned char*& w2q) {
    const volatile __attribute__((address_space(4))) Args* const KA = (const volatile __attribute__((address_space(4))) Args*)__builtin_amdgcn_kernarg_segment_ptr();
    unsigned char* ws = (unsigned char*)KA->ws; w_mlp1 = (const float*)KA->in[20]; w_mlp2 = (const float*)KA->in[22];
    w1q = (signed char*)(ws + WS_W1T); sbw = (float*)(ws + WS_SB); w2q = (unsigned char*)(ws + WS_W2T); }
constexpr int LDS_BYTES = 163840, MISC_OFF = 144 * 1024 - 256, XS_OFF = 131072, GOFF_OFF = 140 * 1024, STG_OFF = 147456;
constexpr int NPH = 14;

__global__ void __launch_bounds__(NTHR, 2) fwd(Args args) {
    extern __shared__ __attribute__((aligned(16))) unsigned char lds_arr[];
    LAS unsigned char* lds = (LAS unsigned char*)lds_arr;
    volatile LAS unsigned* MISC = (volatile LAS unsigned*)(lds + MISC_OFF);
#define PH_VARS const int tid = threadIdx.x, lane = tid & 63, wave = __builtin_amdgcn_readfirstlane(tid >> 6); \
    const int gw = blockIdx.x * NWAVES + wave, NGW = gridDim.x * NWAVES; const int gt = blockIdx.x * NTHR + tid, NGT = gridDim.x * NTHR; (void)lane; (void)gw; (void)NGW; (void)gt; (void)NGT;
#define PTRS \
    unsigned char* ws = (unsigned char*)KA->ws; \
    unsigned* ctl = (unsigned*)(ws + WS_CTL); \
    const float* x = (const float*)KA->in[0]; const float* mem = (const float*)KA->in[1]; const float* w_in = (const float*)KA->in[2]; \
    const float* lq1 = (const float*)KA->in[3]; const float* lk1 = (const float*)KA->in[4]; const float* lq2 = (const float*)KA->in[5]; const float* lk2 = (const float*)KA->in[6]; \
    const float* subln_g = (const float*)KA->in[7]; const float* w_out = (const float*)KA->in[8]; const float* ln1_g = (const float*)KA->in[9]; const float* ln1_b = (const float*)KA->in[10]; \
    const float* mem_g = (const float*)KA->in[11]; const float* mem_b = (const float*)KA->in[12]; const float* w_q = (const float*)KA->in[13]; const float* w_kv = (const float*)KA->in[14]; \
    const float* w_o = (const float*)KA->in[15]; const float* ln2_g = (const float*)KA->in[16]; const float* ln2_b = (const float*)KA->in[17]; const float* w_router = (const float*)KA->in[18]; \
    const float* b_router = (const float*)KA->in[19]; const float* w_mlp1 = (const float*)KA->in[20]; const float* b_mlp1 = (const float*)KA->in[21]; const float* w_mlp2 = (const float*)KA->in[22]; \
    const float* b_mlp2 = (const float*)KA->in[23]; const float* ln3_g = (const float*)KA->in[24]; const float* ln3_b = (const float*)KA->in[25]; \
    float* out = (float*)KA->out; \
    float* ropec = (float*)(ws + WS_ROPE); float* ropes = ropec + SEQ * 8; \
    float* kmean = (float*)(ws + WS_KMEAN); \
    int* topi = (int*)(ws + WS_TOPI); float* topw = (float*)(ws + WS_TOPW); int* list = (int*)(ws + WS_LIST); float* wpos = (float*)(ws + WS_WPOS); int* posof = (int*)(ws + WS_POSOF); \
    bf* wint = (bf*)(ws + WS_WINT); bf* woutt = (bf*)(ws + WS_WOUTT); bf* wqb = (bf*)(ws + WS_WQB); bf* wkvt = (bf*)(ws + WS_WKVT); bf* wot = (bf*)(ws + WS_WOT); bf* w1t = (bf*)(ws + WS_W1T); bf* w2t = (bf*)(ws + WS_W2T); \
    bf* xb = (bf*)(ws + WS_XB); bf* projb = (bf*)(ws + WS_PROJ); bf* memn = (bf*)(ws + WS_MEMN); bf* kvmb = (bf*)(ws + WS_KVM); bf* gtb = (bf*)(ws + WS_GT); bf* vwtb = (bf*)(ws + WS_VWT); \
    bf* h1b = (bf*)(ws + WS_H1B); bf* t2b = (bf*)(ws + WS_OUT2); bf* pb = (bf*)(ws + WS_P); bf* h2b = (bf*)(ws + WS_H2B); \
    bf* mixb = (bf*)out + (size_t)T * D; \
    float* t2 = out; long long* lnst = (long long*)(ws + WS_LNZ); long long* gcs = (long long*)(ws + WS_LNZ + 1024 * 1024); long long* gbf = (long long*)(ws + WS_LNZ + 1280 * 1024); bf* hidb = (bf*)out; signed char* w1q = (signed char*)(ws + WS_W1T); unsigned char* w2q = (unsigned char*)(ws + WS_W2T); unsigned char* hid8 = (unsigned char*)out; signed char* h2q = (signed char*)(ws + WS_H2Q); float* sa = (float*)(ws + WS_SA); float* sbw = (float*)(ws + WS_SB); float* sapos = (float*)(ws + WS_SAPOS); float* sxr = (float*)(ws + WS_SX); float* swin = (float*)(ws + WS_SWIN); signed char* xq = (signed char*)(ws + WS_XB); \
    unsigned* cnt = ctl + CW_CNT; unsigned* fill = ctl + CW_FILL; \
    const int G = (int)gridDim.x, cB = (int)blockIdx.x; (void)ctl; (void)cnt; (void)fill; (void)G; (void)cB;
    typedef unsigned short bf;
    const volatile __attribute__((address_space(4))) Args* const KA = (const volatile __attribute__((address_space(4))) Args*)__builtin_amdgcn_kernarg_segment_ptr();
    unsigned* const ctl0 = (unsigned*)((unsigned char*)KA->ws + WS_CTL);
    if (threadIdx.x < 64) MISC[threadIdx.x] = 0u;
    __syncthreads();
    const int lo = KA->ph_lo, hi = KA->ph_hi;
    XcdBarrier bar; bar.bar = ctl0 + CW_BAR; bar.x = 0; bar.st = MISC + 8;
    if (hi - lo > 1) bar = xcd_barrier_post(ctl0 + CW_BAR, MISC + 8);
#define OPQ(x) ({ int _v = (x); asm volatile("" : "+s"(_v)); _v; })
#define IN(k) (OPQ(lo) <= (k) && (k) < OPQ(hi))
#define SEAM(k) do { if (IN(k) && IN((k) + 1)) xcd_barrier(bar); } while (0)

    if (IN(0)) {
        PH_VARS
        PTRS
        for (int i = gt; i < SEQ * 8; i += NGT) { double s, c; sincos_d((double)(i >> 3) * INV_FREQ[i & 7], s, c); ropec[i] = (float)c; ropes[i] = (float)s; }
        for (int i = gt; i < (int)(LNZ_BYTES / 16); i += NGT) *(g8::u32x4*)(ws + WS_LNZ + (size_t)i * 16) = (g8::u32x4){0u, 0u, 0u, 0u};
        for (int r = gw; r < TM; r += NGW) { float4 v[4];
#pragma unroll
            for (int j = 0; j < 4; ++j) v[j] = *(const float4*)(mem + (size_t)r * D + 4 * lane + 256 * j);
            ln_wave(v, mem_g, mem_b, lane);
#pragma unroll
            for (int j = 0; j < 4; ++j) { g8::u32x2 w; w.x = g8::cvt_pk_bf16(v[j].x, v[j].y); w.y = g8::cvt_pk_bf16(v[j].z, v[j].w); *(g8::u32x2*)(memn + (size_t)r * D + 4 * lane + 256 * j) = w; } }
        for (int r = gw; r < T; r += NGW) { float4 v[4];
#pragma unroll
            for (int j = 0; j < 4; ++j) v[j] = ldnt4(x + (size_t)r * D + 4 * lane + 256 * j);
            float am = 0.f;
#pragma unroll
            for (int j = 0; j < 4; ++j) am = fmaxf(am, fmaxf(fmaxf(fabsf(v[j].x), fabsf(v[j].y)), fmaxf(fabsf(v[j].z), fabsf(v[j].w))));
            am = fmaxf(wave_max(am), 1e-30f); const float iv = 127.0f / am; if (lane == 0) sxr[r] = am * (1.0f / 127.0f);
#pragma unroll
            for (int j = 0; j < 4; ++j) { const unsigned q = ((unsigned)(int)rintf(v[j].x * iv) & 0xffu) | (((unsigned)(int)rintf(v[j].y * iv) & 0xffu) << 8) | (((unsigned)(int)rintf(v[j].z * iv) & 0xffu) << 16) | (((unsigned)(int)rintf(v[j].w * iv) & 0xffu) << 24);
                *(unsigned*)(xq + (size_t)r * D + 4 * lane + 256 * j) = q; } }
        for (size_t i = (size_t)gt; i < (size_t)D * D / 8; i += (size_t)NGT) { const float* src = w_q + i * 8; bf* dst = wqb + i * 8;
            const float4 a = *(const float4*)src, b = *(const float4*)(src + 4);
            g8::u32x4 w; w.x = g8::cvt_pk_bf16(a.x, a.y); w.y = g8::cvt_pk_bf16(a.z, a.w); w.z = g8::cvt_pk_bf16(b.x, b.y); w.w = g8::cvt_pk_bf16(b.z, b.w); *(g8::u32x4*)dst = w; }
        LAS float* scr = (LAS float*)lds + wave * (64 * 33);
        constexpr int I_IN = NPROJ / 32  , I_SQ = (D / 64) * (D / 32), I_KV = (D / 64) * (2 * D / 32), I2 = (DFF / 64) * (D / 32);
        constexpr int I1Q = 2 * DFF / 32;
        constexpr int NIT = I_SQ + I_KV + I_SQ;
        for (int it = gw; it < NIT; it += NGW) { int r = it;
            const float* W; unsigned short* WT; int K_, N_, q; bool quant = false, f8 = false, quant_in = false; int qe = 0;
            if (r < I_SQ) { W = w_out; WT = woutt; K_ = D; N_ = D; q = r; }
            else if ((r -= I_SQ) < I_KV) { W = w_kv; WT = wkvt; K_ = D; N_ = 2 * D; q = r; }
            else { r -= I_KV; W = w_o; WT = wot; K_ = D; N_ = D; q = r; }
            (void)quant; (void)quant_in;
            (void)f8; (void)qe; transpose_item(W, K_, N_, WT, scr, q, lane); }
        __syncthreads();
        { lfloat* stage = (lfloat*)lds; lfloat* red = stage + 1024 * 33;
#define QITEM(it_, W_, N_, Q_, S_, nb_) do { if ((it_) < I_IN) { W_ = w_in; N_ = NPROJ; Q_ = (signed char*)wint; S_ = swin; nb_ = (it_); } \
              else { const int r_ = (it_) - I_IN, qe_ = r_ / I1Q; nb_ = r_ - qe_ * I1Q; W_ = w_mlp1 + (size_t)qe_ * D * 2 * DFF; N_ = 2 * DFF; Q_ = w1q + (size_t)qe_ * 2 * DFF * D; S_ = sbw + (size_t)qe_ * 2 * DFF; } } while (0)
          constexpr int NQ = I_IN; float4 v[16];
          { int it0 = blockIdx.x; if (it0 < NQ) { const float* W_; int N_, nb_; signed char* Q_; float* S_; QITEM(it0, W_, N_, Q_, S_, nb_); (void)Q_; (void)S_; quant_w1_load(W_, N_, nb_, tid, v); } }
          for (int it = blockIdx.x; it < NQ; it += gridDim.x) {
              const float* W_; int N_, nb_; signed char* Q_; float* S_; QITEM(it, W_, N_, Q_, S_, nb_);
              quant_w1_stage(v, stage, red, tid);
              { const int itn = it + gridDim.x; if (itn < NQ) { const float* Wn; int Nn, nbn; signed char* Qn; float* Sn; QITEM(itn, Wn, Nn, Qn, Sn, nbn); (void)Qn; (void)Sn; quant_w1_load(Wn, Nn, nbn, tid, v); } }
              quant_w1_emit(Q_, S_, stage, red, nb_, tid); }
#undef QITEM
        }
    }
    SEAM(0);
    if (IN(1)) {
        PTRS
        { g8::DenseOrder S; S.init(T, NPROJ, D / 2, G, cB); g8::EpiProj E{projb, ropec, ropes, lds + STG_OFF, sxr, swin, lds + XS_OFF}; int kq = D / 2; asm volatile("" : "+s"(kq)); g8::gemm_phase<g8::EpiProj, g8::DenseOrder, false>(lds, (const bf*)xq, D / 2, (const bf*)wint, D / 2, kq, nullptr, S, E); }
        { g8::DenseOrder S; S.init(TM, 2 * D, D, G, cB); g8::EpiPlainB E{kvmb, 2 * D, lds + STG_OFF}; g8::gemm_phase<g8::EpiPlainB, g8::DenseOrder, false>(lds, memn, D, wkvt, D, D, nullptr, S, E); }
    }
    SEAM(1);
    if (IN(2)) {
        PH_VARS
        PTRS
        int k256 = 256; asm volatile("" : "+s"(k256));
        { g8::GtOrder S{G, cB}; g8::EpiGT E{gtb, ln1_g, ln1_b, gcs, gbf, lds + STG_OFF}; g8::gemm_phase<g8::EpiGT, g8::GtOrder, false>(lds, kvmb, 2 * D, wqb, D, k256, nullptr, S, E); }
        { g8::VwtOrder S{G, cB}; g8::EpiPlainB E{vwtb, D, lds + STG_OFF}; g8::gemm_phase<g8::EpiPlainB, g8::VwtOrder, false>(lds, wot, D, kvmb, 2 * D, k256, nullptr, S, E); }
        for (int it = gw; it < BATCH * 8 * 8; it += NGW) { const int n = it & 7, h = (it >> 3) & 7, b = it >> 6;
            const bf* kp = projb + ((size_t)b * SEQ + n * 256 + (lane >> 3)) * NPROJ + 2048 + h * 64 + 8 * (lane & 7); float s[8];
#pragma unroll
            for (int i = 0; i < 8; ++i) s[i] = 0.f;
#pragma unroll 8
            for (int j = 0; j < 32; ++j) { const g8::u32x4 v = *(const g8::u32x4*)(kp + (size_t)j * 8 * NPROJ);
#pragma unroll
                for (int i = 0; i < 4; ++i) { s[2 * i] += __uint_as_float(v[i] << 16); s[2 * i + 1] += __uint_as_float(v[i] & 0xffff0000u); } }
#pragma unroll
            for (int i = 0; i < 8; ++i) { s[i] += __shfl_xor(s[i], 8); s[i] += __shfl_xor(s[i], 16); s[i] += __shfl_xor(s[i], 32); }
            if (lane < 8) { float* kd = kmean + ((b * 8 + h) * 8 + n) * 64 + 8 * lane;
                *(float4*)kd = make_float4(s[0] * (1.0f / 256.0f), s[1] * (1.0f / 256.0f), s[2] * (1.0f / 256.0f), s[3] * (1.0f / 256.0f));
                *(float4*)(kd + 4) = make_float4(s[4] * (1.0f / 256.0f), s[5] * (1.0f / 256.0f), s[6] * (1.0f / 256.0f), s[7] * (1.0f / 256.0f)); } }
    }
    SEAM(2);
    if (IN(3)) { PTRS attn_phase((char*)lds_arr, projb, (bf*)out, mixb, kmean, G, cB); }
    if (IN(3) && IN(5)) xcd_barrier(bar);
    if (IN(5)) { PTRS g8::DenseOrder S; S.init(T, D, D, G, cB); g8::EpiResidStats E{h1b, x, lnst, ALPHA}; g8::gemm_phase<g8::EpiResidStats, g8::DenseOrder, false>(lds, mixb, D, woutt, D, D, nullptr, S, E); }
    if (IN(5) && IN(7)) xcd_barrier(bar);
    if (IN(7)) { PTRS g8::BatchOrder S; S.init(T, D, D, G, cB); S.bbatch_rows = D; S.rev = true; g8::EpiSoftmaxP E{pb, lds + XS_OFF, lds + STG_OFF, lnst, gcs, gbf}; g8::gemm_phase<g8::EpiSoftmaxP, g8::BatchOrder, false>(lds, h1b, D, gtb, D, D, nullptr, S, E); }
    SEAM(7);
    if (IN(8)) { PTRS g8::BatchOrder S; S.init(T, D, D, G, cB); S.bbatch_rows = D; g8::EpiPlainB E{t2b, D, lds + STG_OFF}; g8::gemm_phase<g8::EpiPlainB, g8::BatchOrder, false>(lds, pb, D, vwtb, D, D, nullptr, S, E); }
    SEAM(8);
    if (IN(9)) {
        PH_VARS
        PTRS
        lfloat* xs = (lfloat*)lds; lfloat* red = (lfloat*)(lds + 32 * 1028 * 4); LAS int* chist = (LAS int*)(lds + 32 * 1028 * 4 + 2 * 32 * 33 * 4); LAS int* phist = chist + 32; unsigned* chunkcnt = ctl0 + CW_CHUNK;
        if (tid < NEXP) { chist[tid] = 0; phist[tid] = 0; }
        __syncthreads();
        const int rh = wave & 1, eh = (wave >> 1) & 1, kh = wave >> 2, li = lane & 15, hq = lane >> 4;
        float Bw[128];
        { const float* wp = w_router + (size_t)(512 * kh + 128 * hq) * NEXP + 16 * eh + li;
#pragma unroll
          for (int s2 = 0; s2 < 128; ++s2) Bw[s2] = wp[(size_t)s2 * NEXP]; }
        for (int rb = blockIdx.x; rb < T / 32; rb += gridDim.x) {
#pragma unroll 1
            for (int rp = 0; rp < 4; rp += 2) {
            g8::u32x2 pin[2][4], pc[2][4]; float s1[2], s2[2];
#pragma unroll
            for (int rr = 0; rr < 2; ++rr) { const size_t r = (size_t)rb * 32 + 4 * wave + rp + rr;
                const long long* sp = lnst + 2 * r; asm volatile("" : "+v"(sp));
                s1[rr] = fx_get(sp); s2[rr] = fx_get(sp + 1);
#pragma unroll
                for (int j = 0; j < 4; ++j) { pin[rr][j] = *(const g8::u32x2*)(h1b + r * D + 4 * lane + 256 * j); pc[rr][j] = *(const g8::u32x2*)(t2b + r * D + 4 * lane + 256 * j); } }
#pragma unroll
            for (int rr = 0; rr < 2; ++rr) asm volatile("" : "+v"(pin[rr][0]), "+v"(pin[rr][1]), "+v"(pin[rr][2]), "+v"(pin[rr][3]), "+v"(pc[rr][0]), "+v"(pc[rr][1]), "+v"(pc[rr][2]), "+v"(pc[rr][3]), "+v"(s1[rr]), "+v"(s2[rr]));
#pragma unroll
            for (int rr = 0; rr < 2; ++rr) { const int row = 4 * wave + rp + rr; const size_t r = (size_t)rb * 32 + row; float4 v[4];
                const float mean1 = s1[rr] * (1.0f / 1024.0f), rstd1 = 1.0f / sqrtf(fmaxf(s2[rr] * (1.0f / 1024.0f) - mean1 * mean1, 0.f) + LN_EPS);
#pragma unroll
                for (int j = 0; j < 4; ++j) { const g8::u32x2 p = pin[rr][j], c = pc[rr][j]; const float4 gg = *(const float4*)(ln1_g + 4 * lane + 256 * j), bb = *(const float4*)(ln1_b + 4 * lane + 256 * j);
                    v[j].x = ((__uint_as_float(p.x << 16) - mean1) * rstd1 * gg.x + bb.x) * ALPHA + __uint_as_float(c.x << 16);
                    v[j].y = ((__uint_as_float(p.x & 0xffff0000u) - mean1) * rstd1 * gg.y + bb.y) * ALPHA + __uint_as_float(c.x & 0xffff0000u);
                    v[j].z = ((__uint_as_float(p.y << 16) - mean1) * rstd1 * gg.z + bb.z) * ALPHA + __uint_as_float(c.y << 16);
                    v[j].w = ((__uint_as_float(p.y & 0xffff0000u) - mean1) * rstd1 * gg.w + bb.w) * ALPHA + __uint_as_float(c.y & 0xffff0000u); }
                ln_wave(v, ln2_g, ln2_b, lane);
#pragma unroll
                for (int j = 0; j < 4; ++j) { g8::u32x2 w; w.x = g8::cvt_pk_bf16(v[j].x, v[j].y); w.y = g8::cvt_pk_bf16(v[j].z, v[j].w); *(g8::u32x2*)(h2b + r * D + 4 * lane + 256 * j) = w;
                    *(LAS f32x4*)&xs[row * 1028 + 4 * lane + 256 * j] = (f32x4){v[j].x, v[j].y, v[j].z, v[j].w}; }
                { float am = 0.f;
#pragma unroll
                  for (int j = 0; j < 4; ++j) am = fmaxf(am, fmaxf(fmaxf(fabsf(v[j].x), fabsf(v[j].y)), fmaxf(fabsf(v[j].z), fabsf(v[j].w))));
                  am = fmaxf(wave_max(am), 1e-30f); const float iv = 127.0f / am; if (lane == 0) sa[r] = am * (1.0f / 127.0f);
#pragma unroll
                  for (int j = 0; j < 4; ++j) { const unsigned q = ((unsigned)(int)rintf(v[j].x * iv) & 0xffu) | (((unsigned)(int)rintf(v[j].y * iv) & 0xffu) << 8) | (((unsigned)(int)rintf(v[j].z * iv) & 0xffu) << 16) | (((unsigned)(int)rintf(v[j].w * iv) & 0xffu) << 24);
                      *(unsigned*)(h2q + r * D + 4 * lane + 256 * j) = q; } } }
            }
            __syncthreads();
            f32x4 acc = {0.f, 0.f, 0.f, 0.f};
            { const lfloat* xp = xs + (16 * rh + li) * 1028 + 512 * kh + 128 * hq;
#pragma unroll
              for (int s4 = 0; s4 < 32; ++s4) { const f32x4 a4 = *(const LAS f32x4*)(xp + 4 * s4);
#pragma unroll
                  for (int u = 0; u < 4; ++u) acc = __builtin_amdgcn_mfma_f32_16x16x4f32(a4[u], Bw[4 * s4 + u], acc, 0, 0, 0); } }
#pragma unroll
            for (int q = 0; q < 4; ++q) red[(kh * 32 + 16 * rh + 4 * hq + q) * 33 + 16 * eh + li] = acc[q];
            __syncthreads();
            if (wave == 0 && lane < 32) { const size_t r = (size_t)rb * 32 + lane; float l32[NEXP];
#pragma unroll
                for (int e = 0; e < NEXP; ++e) l32[e] = red[lane * 33 + e] + red[(32 + lane) * 33 + e] + b_router[e];
                int bi[4]; float bv[4]; unsigned used = 0u;
#pragma unroll
                for (int k = 0; k < 4; ++k) { int best = -1; float bval = 0.f;
#pragma unroll
                    for (int e = 0; e < NEXP; ++e) if (!((used >> e) & 1u) && (best < 0 || l32[e] > bval)) { best = e; bval = l32[e]; }
                    used |= 1u << best; bi[k] = best; bv[k] = bval; }
                const float e0 = 1.0f, e1 = expf(bv[1] - bv[0]), e2 = expf(bv[2] - bv[0]), e3 = expf(bv[3] - bv[0]), inv = 1.0f / (e0 + e1 + e2 + e3);
                *(int4*)(topi + r * 4) = make_int4(bi[0], bi[1], bi[2], bi[3]); *(float4*)(topw + r * 4) = make_float4(e0 * inv, e1 * inv, e2 * inv, e3 * inv);
                __hip_atomic_fetch_add(&chist[bi[0]], 1, __ATOMIC_RELAXED, __HIP_MEMORY_SCOPE_WORKGROUP); __hip_atomic_fetch_add(&chist[bi[1]], 1, __ATOMIC_RELAXED, __HIP_MEMORY_SCOPE_WORKGROUP);
                __hip_atomic_fetch_add(&chist[bi[2]], 1, __ATOMIC_RELAXED, __HIP_MEMORY_SCOPE_WORKGROUP); __hip_atomic_fetch_add(&chist[bi[3]], 1, __ATOMIC_RELAXED, __HIP_MEMORY_SCOPE_WORKGROUP);
                __hip_atomic_fetch_add(&phist[bi[0]], 1, __ATOMIC_RELAXED, __HIP_MEMORY_SCOPE_WORKGROUP); __hip_atomic_fetch_add(&phist[bi[1]], 1, __ATOMIC_RELAXED, __HIP_MEMORY_SCOPE_WORKGROUP);
                __hip_atomic_fetch_add(&phist[bi[2]], 1, __ATOMIC_RELAXED, __HIP_MEMORY_SCOPE_WORKGROUP); __hip_atomic_fetch_add(&phist[bi[3]], 1, __ATOMIC_RELAXED, __HIP_MEMORY_SCOPE_WORKGROUP); }
            __syncthreads();
            if (tid < NEXP) { const int n = phist[tid]; if (n) atomicAdd(&chunkcnt[(rb >> 3) * 32 + tid], (unsigned)n); phist[tid] = 0; }
        }
        if (tid < NEXP) { const int n = chist[tid]; if (n) atomicAdd(&cnt[tid], (unsigned)n); }
    }
    SEAM(9);
    LAS int* goff = (LAS int*)(lds + GOFF_OFF);
    if (hi > 10) { const int tid = threadIdx.x; unsigned* cnt = ctl0 + CW_CNT; __syncthreads(); if (tid < 1) { int a = 0; for (int e = 0; e < NEXP; ++e) { goff[tid * 33 + e] = a; a += (int)__hip_atomic_load(&cnt[tid * NEXP + e], __ATOMIC_RELAXED, __HIP_MEMORY_SCOPE_AGENT); } goff[tid * 33 + 32] = a; } __syncthreads(); }
    if (IN(10)) {
        PH_VARS
        PTRS
        LAS int* hist = (LAS int*)lds; LAS int* base = hist + 32; LAS int* psum = base + 32; const unsigned* chunkcnt = ctl0 + CW_CHUNK;
        for (int ch = blockIdx.x; ch < T / 256; ch += gridDim.x) {
            if (tid < 32) hist[tid] = 0;
            { const int e = tid & 31, part = tid >> 5; int sacc = 0; for (int c2 = part; c2 < ch; c2 += 16) sacc += (int)chunkcnt[c2 * 32 + e]; psum[part * 32 + e] = sacc; }
            __syncthreads();
            const int t = ch * 256 + tid; int ee[4] = {0, 0, 0, 0}, loc[4] = {0, 0, 0, 0}; float ww[4] = {0.f, 0.f, 0.f, 0.f};
            if (tid < 256) { const int4 e4 = *(const int4*)(topi + (size_t)t * 4); const float4 w4 = *(const float4*)(topw + (size_t)t * 4);
                ee[0] = e4.x; ee[1] = e4.y; ee[2] = e4.z; ee[3] = e4.w; ww[0] = w4.x; ww[1] = w4.y; ww[2] = w4.z; ww[3] = w4.w;
#pragma unroll
                for (int k = 0; k < 4; ++k) loc[k] = __hip_atomic_fetch_add(&hist[ee[k]], 1, __ATOMIC_RELAXED, __HIP_MEMORY_SCOPE_WORKGROUP); }
            __syncthreads();
            if (tid < 32) { int b0 = goff[tid];
#pragma unroll
                for (int p = 0; p < 16; ++p) b0 += psum[p * 32 + tid];
                base[tid] = b0; }
            __syncthreads();
            if (tid < 256) { int pp[4]; const float sat = sa[t];
#pragma unroll
                for (int k = 0; k < 4; ++k) { const int pos = base[ee[k]] + loc[k]; list[pos] = t; wpos[pos] = ww[k]; sapos[pos] = sat; pp[k] = pos; }
                *(int4*)(posof + (size_t)t * 4) = make_int4(pp[0], pp[1], pp[2], pp[3]); }
            __syncthreads();
        }
    }
    SEAM(10);
    {
        PTRS
        bf* out2_p = (bf*)(ws + WS_OUT2);
        if (IN(11)) { g8::MoeOrder S{goff, 8, G, cB, D / 2, 0, 0, -1, 0}; g8::EpiSwigluI8 E{hid8, b_mlp1, sapos, sbw};
            g8::gemm_phase<g8::EpiSwigluI8, g8::MoeOrder, true>(lds, (const bf*)h2q, D / 2, (const bf*)w1q, D / 2, D / 2, list, S, E); }
        SEAM(11);
        if (IN(12)) { g8::MoeOrder S{goff, 4, G, cB, DFF / 2, 0, 0, -1, 0}; g8::EpiMoe2F8 E{out2_p, b_mlp2, wpos, lds + STG_OFF};
            int kq = DFF / 2; asm volatile("" : "+s"(kq));
            g8::gemm_phase<g8::EpiMoe2F8, g8::MoeOrder, false>(lds, (const bf*)hid8, DFF / 2, (const bf*)w2q, DFF / 2, kq, nullptr, S, E); }
        SEAM(12);
    }
    if (IN(13)) {
        PH_VARS
        PTRS
        const bf* o0 = (const bf*)(ws + WS_OUT2); const bf* o1 = o0; const bf* o2 = o0; const bf* o3 = o0;
        for (int r = gw; r < T; r += NGW) { float4 v[4]; const int4 ps = *(const int4*)(posof + (size_t)r * 4);
#pragma unroll
            for (int j = 0; j < 4; ++j) { const int c = 4 * lane + 256 * j;
                const g8::u32x2 hh = __builtin_nontemporal_load((const g8::u32x2*)(h2b + (size_t)r * D + c)), a0 = __builtin_nontemporal_load((const g8::u32x2*)(o0 + (size_t)ps.x * D + c)), a1 = __builtin_nontemporal_load((const g8::u32x2*)(o1 + (size_t)ps.y * D + c)),
                                a2 = __builtin_nontemporal_load((const g8::u32x2*)(o2 + (size_t)ps.z * D + c)), a3 = __builtin_nontemporal_load((const g8::u32x2*)(o3 + (size_t)ps.w * D + c));
#define LO(u) __uint_as_float((u) << 16)
#define HI(u) __uint_as_float((u) & 0xffff0000u)
                v[j].x = ALPHA * LO(hh.x) + ((LO(a0.x) + LO(a1.x)) + (LO(a2.x) + LO(a3.x)));
                v[j].y = ALPHA * HI(hh.x) + ((HI(a0.x) + HI(a1.x)) + (HI(a2.x) + HI(a3.x)));
                v[j].z = ALPHA * LO(hh.y) + ((LO(a0.y) + LO(a1.y)) + (LO(a2.y) + LO(a3.y)));
                v[j].w = ALPHA * HI(hh.y) + ((HI(a0.y) + HI(a1.y)) + (HI(a2.y) + HI(a3.y)));
#undef LO
#undef HI
            }
            ln_wave(v, ln3_g, ln3_b, lane);
#pragma unroll
            for (int j = 0; j < 4; ++j) stnt4(out + (size_t)r * D + 4 * lane + 256 * j, v[j]); }
    }
#undef IN
#undef SEAM
}

extern "C" void kernel_launch(void* const* d_in, const int* in_sizes, int n_in, void* d_out, int out_size, void* d_ws, size_t ws_size, hipStream_t stream) {
    static int grid = 0;
    if (grid == 0) {
        if (n_in != 26 || out_size != T * D || ws_size < WS_END) { fprintf(stderr, "kernel_launch: unexpected shapes (n_in %d out %d ws %zu)\n", n_in, out_size, ws_size); grid = -1; return; }
        int dev = 0, cus = 0, per_cu = 0;
        if (hipGetDevice(&dev) != hipSuccess || hipDeviceGetAttribute(&cus, hipDeviceAttributeMultiprocessorCount, dev) != hipSuccess) { grid = -1; return; }
        if (hipFuncSetAttribute((const void*)fwd, hipFuncAttributeMaxDynamicSharedMemorySize, LDS_BYTES) != hipSuccess) { fprintf(stderr, "kernel_launch: hipFuncSetAttribute failed\n"); grid = -1; return; }
        if (hipOccupancyMaxActiveBlocksPerMultiprocessor(&per_cu, (const void*)fwd, NTHR, LDS_BYTES) != hipSuccess || per_cu < 1) fprintf(stderr, "kernel_launch: occupancy query reports %d\n", per_cu);
        (void)hipGetLastError();
        grid = cus;
    }
    if (grid < 0) return;
    (void)hipMemsetAsync((char*)d_ws + WS_CTL, 0, CTL_ZERO_BYTES, stream);
    Args a{};
    for (int i = 0; i < 26; ++i) a.in[i] = (const float*)d_in[i];
    a.out = (float*)d_out; a.ws = (unsigned char*)d_ws;
#if ONE_LAUNCH
#ifdef EXP_PREFIX
    a.ph_lo = 0; a.ph_hi = EXP_PREFIX + 1; hipLaunchKernelGGL(fwd, dim3(grid), dim3(NTHR), LDS_BYTES, stream, a);
    (void)hipMemsetAsync((char*)d_ws + WS_CTL, 0, CTL_ZERO_BYTES, stream); (void)hipMemsetAsync((char*)d_ws + WS_LNZ, 0, LNZ_BYTES, stream);
#endif
#ifndef EXP_LIST
    a.ph_lo = 0; a.ph_hi = NPH;
    hipLaunchKernelGGL(fwd, dim3(grid), dim3(NTHR), LDS_BYTES, stream, a);
#else
    { const int reps[] = {EXP_LIST}; int lo = 0;
      for (unsigned i = 0; i <= sizeof(reps) / sizeof(int); ++i) { const int hi = (i < sizeof(reps) / sizeof(int)) ? reps[i] + 1 : NPH;
          if (i) (void)hipMemsetAsync((char*)d_ws + WS_CTL + CW_BAR * 4, 0, (CW_CNT - CW_BAR) * 4, stream);
          a.ph_lo = lo; a.ph_hi = hi; hipLaunchKernelGGL(fwd, dim3(grid), dim3(NTHR), LDS_BYTES, stream, a); lo = hi - 1; } }
#endif
#else
    for (int p = 0; p < NPH; ++p) { a.ph_lo = p; a.ph_hi = p + 1; hipLaunchKernelGGL(fwd, dim3(grid), dim3(NTHR), LDS_BYTES, stream, a); }
#endif
}
```
